# Optimizing an MI355X kernel written in HIP

```python
import math
import jax
import jax.numpy as jnp
from jax import lax
import numpy as np

D_MODEL = 1024
BATCH = 8
SEQ = 4096
DEPTH = 2

GRID_W = 64
CTX_LEN = 256
EPS = 1e-6
F32 = jnp.float32

MLA_HEADS = 8
MLA_NOPE = 64
MLA_ROPE = 32
MLA_V = 64
MLA_Q_LORA = 256
MLA_KV_LORA = 128
MLA_SCALE = (MLA_NOPE + MLA_ROPE) ** -0.5
ROPE_BASE = 10000.0
Q_BLOCK = 128

GLA_HEADS = 4
GLA_DK = 256
GLA_DV = 512
GLA_HK = GLA_DK // GLA_HEADS
GLA_HV = GLA_DV // GLA_HEADS
GLA_GATE_RANK = 16
GLA_TAU = 16.0
GLA_CHUNK = 64

HY_WIDTH = 512
HY_ORDER = 2
HY_SHORT = 3
HY_BANDS = 16
HY_POS_DIM = 1 + 2 * HY_BANDS
HY_FILTER_HIDDEN = 64
HY_FAST_DECAY = 0.3
HY_SLOW_DECAY = 1.5
HY_DECAY_TARGET = 1e-2

N_BRANCH = 3
D_FF = 4 * D_MODEL
MLA_OUT = MLA_HEADS * MLA_V
IN_SIZES = (MLA_Q_LORA, MLA_KV_LORA, MLA_ROPE, GLA_DK, GLA_DK, GLA_DV, GLA_DV, GLA_GATE_RANK, GLA_GATE_RANK,
            (HY_ORDER + 1) * HY_WIDTH, N_BRANCH * D_MODEL)
D_IN = sum(IN_SIZES)

kernel_name = 'hybrid_mla_gla_hyena_dit_block'


def _split(z, sizes):
    parts, start = [], 0
    for s in sizes:
        parts.append(z[..., start:start + s])
        start += s
    return parts


def rmsnorm(x, g):
    xf = x.astype(F32)
    y = xf * lax.rsqrt(jnp.mean(xf * xf, axis=-1, keepdims=True) + EPS)
    return (y * g.astype(F32)).astype(x.dtype)


def modulate(h, shift, scale):
    return h * (1 + scale) + shift


def axial_rope_tables(rows):
    row = jnp.repeat(jnp.arange(rows, dtype=F32), GRID_W)
    col = jnp.tile(jnp.arange(GRID_W, dtype=F32), rows)
    a = MLA_ROPE // 4
    inv = ROPE_BASE ** (-jnp.arange(a, dtype=F32) / a)
    ang = jnp.concatenate([row[:, None] * inv, col[:, None] * inv], axis=-1)
    return jnp.cos(ang), jnp.sin(ang)


def apply_axial_rope(x, cos, sin):
    a = MLA_ROPE // 4
    cos = cos.astype(x.dtype)
    sin = sin.astype(x.dtype)

    def rot(u, cs, sn):
        u1, u2 = u[..., :a], u[..., a:]
        return jnp.concatenate([u1 * cs - u2 * sn, u1 * sn + u2 * cs], axis=-1)

    return jnp.concatenate([rot(x[..., :2 * a], cos[..., :a], sin[..., :a]),
                            rot(x[..., 2 * a:], cos[..., a:], sin[..., a:])], axis=-1)


def mla_queries(zq, q_norm, w_uq, rope):
    B, L = zq.shape[:2]
    q = (rmsnorm(zq, q_norm) @ w_uq).reshape(B, L, MLA_HEADS, MLA_NOPE + MLA_ROPE)
    q_nope, q_rope = q[..., :MLA_NOPE], q[..., MLA_NOPE:]
    if rope is not None:
        q_rope = apply_axial_rope(q_rope, rope[0][:, None, :], rope[1][:, None, :])
    return q_nope, q_rope


def mla_keys_values(zkv, zkr, kv_norm, w_ukv, rope):
    B, L = zkv.shape[:2]
    kv = (rmsnorm(zkv, kv_norm) @ w_ukv).reshape(B, L, MLA_HEADS, MLA_NOPE + MLA_V)
    k_rope = zkr
    if rope is not None:
        k_rope = apply_axial_rope(k_rope, rope[0], rope[1])
    return kv[..., :MLA_NOPE], k_rope, kv[..., MLA_NOPE:]


def mla_attend(qn, qr, kn, kr, v):
    s = jnp.einsum('bqhd,bkhd->bhqk', qn, kn) + jnp.einsum('bqhr,bkr->bhqk', qr, kr)
    p = jax.nn.softmax(s.astype(F32) * MLA_SCALE, axis=-1).astype(v.dtype)
    return jnp.einsum('bhqk,bkhd->bqhd', p, v)


def mla_latent_attention(qn, qr, kn, kr, v):
    B, L = qn.shape[:2]
    nb = L // Q_BLOCK

    def blocks(t):
        return jnp.moveaxis(t.reshape(B, nb, Q_BLOCK, *t.shape[2:]), 1, 0)

    o = lax.map(lambda qb: mla_attend(qb[0], qb[1], kn, kr, v), (blocks(qn), blocks(qr)))
    return jnp.moveaxis(o, 0, 1).reshape(B, L, MLA_OUT)


def gla_heads(q, k, v, a_f, a_b, w_a2, b_a):
    def heads(t):
        B, L, W = t.shape
        return t.reshape(B, L, GLA_HEADS, W // GLA_HEADS).transpose(0, 2, 1, 3).astype(F32)

    def log_gate(a, d):
        return jax.nn.log_sigmoid((a @ w_a2[d] + b_a[d]).astype(F32)) / GLA_TAU

    return (heads(q) * GLA_HK ** -0.5, heads(k), heads(v), heads(log_gate(a_f, 0)), heads(log_gate(a_b, 1)))


def gla_chunked(q, k, v, g, s0):
    B, H, L, _ = q.shape
    C = min(GLA_CHUNK, L)
    n = L // C
    mask = jnp.tril(jnp.ones((C, C), dtype=bool))

    def to_chunks(t):
        return jnp.moveaxis(t.reshape(B, H, n, C, t.shape[-1]), 2, 0)

    def step(S, inp):
        qc, kc, vc, gc = inp
        G = jnp.cumsum(gc, axis=2)
        o_inter = jnp.einsum('bhck,bhkv->bhcv', qc * jnp.exp(G), S)
        diff = G[:, :, :, None, :] - G[:, :, None, :, :]
        decay = jnp.exp(jnp.where(mask[:, :, None], diff, -jnp.inf))
        A = jnp.einsum('bhik,bhjk,bhijk->bhij', qc, kc, decay)
        o = o_inter + jnp.einsum('bhij,bhjv->bhiv', A, vc)
        G_last = G[:, :, -1:, :]
        S_new = jnp.exp(G_last[:, :, 0, :])[..., None] * S + jnp.einsum('bhck,bhcv->bhkv', kc * jnp.exp(G_last - G), vc)
        return S_new, o

    S_fin, o = lax.scan(step, s0, (to_chunks(q), to_chunks(k), to_chunks(v), to_chunks(g)))
    return jnp.moveaxis(o, 0, 2).reshape(B, H, L, v.shape[-1]), S_fin


def gla_bidirectional(lat, ctx, with_ctx_out):
    q, k, v, gf, gb = lat
    qc, kc, vc, gfc, gbc = ctx
    s0 = jnp.zeros((q.shape[0], GLA_HEADS, GLA_HK, GLA_HV), F32)

    def flip(t):
        return jnp.flip(t, axis=2)

    oc_f, s_f = gla_chunked(qc, kc, vc, gfc, s0)
    oc_b, s_b = gla_chunked(flip(qc), flip(kc), flip(vc), flip(gbc), s0)
    o_f, _ = gla_chunked(q, k, v, gf, s_f)
    o_b, _ = gla_chunked(flip(q), flip(k), flip(v), flip(gb), s_b)
    o_lat = o_f + flip(o_b)
    o_ctx = oc_f + flip(oc_b) if with_ctx_out else None
    return o_lat, o_ctx


def gla_output(o, r, out_norm):
    B, H, L, V = o.shape
    o = rmsnorm(o, out_norm).transpose(0, 2, 1, 3).reshape(B, L, H * V).astype(r.dtype)
    return o * jax.nn.silu(r)


def hyena_filters(L, w1, b1, w2, b2, w3, b3):
    pos = jnp.arange(L, dtype=F32)
    t = pos / max(L - 1, 1)
    f = jnp.linspace(1e-4, HY_BANDS - 1, HY_BANDS, dtype=F32)
    ang = (2.0 * math.pi / L) * pos[:, None] * f
    feat = jnp.concatenate([t[:, None], jnp.cos(ang), jnp.sin(ang)], axis=-1)
    hdn = jnp.sin(feat @ w1.astype(F32) + b1.astype(F32))
    hdn = jnp.sin(hdn @ w2.astype(F32) + b2.astype(F32))
    h = (hdn @ w3.astype(F32) + b3.astype(F32)).reshape(L, 2, HY_ORDER, HY_WIDTH)
    deltas = jnp.linspace(math.log(HY_DECAY_TARGET) / HY_FAST_DECAY, math.log(HY_DECAY_TARGET) / HY_SLOW_DECAY,
                          HY_WIDTH, dtype=F32)
    window = jnp.exp(-t[:, None] * jnp.abs(deltas))
    h = h * window[:, None, None, :]
    return h / jnp.sum(jnp.abs(h), axis=(0, 1), keepdims=True)


def short_conv(u, w, b):
    L = u.shape[1]
    pad = HY_SHORT // 2
    up = jnp.pad(u, ((0, 0), (pad, pad), (0, 0)))
    y = b
    for j in range(HY_SHORT):
        y = y + up[:, j:j + L] * w[j]
    return y


def bidir_long_conv(u, h_fwd, h_bwd):
    L = u.shape[1]
    k = jnp.concatenate([h_fwd, jnp.zeros_like(h_fwd[:1]), h_bwd[:0:-1]], axis=0)
    spec = jnp.fft.rfft(u.astype(F32), n=2 * L, axis=1) * jnp.fft.rfft(k, axis=0)[None]
    return jnp.fft.irfft(spec, n=2 * L, axis=1)[:, :L].astype(u.dtype)


def hyena_branch(z, short_w, short_b, filt, hy_bias):
    x1, x2, v = _split(short_conv(z, short_w, short_b), (HY_WIDTH,) * 3)
    y = v
    for n, gate in enumerate((x1, x2)):
        y = gate * (bidir_long_conv(y, filt[:, 0, n], filt[:, 1, n]) + hy_bias[n] * y)
    return y


def merge_branches(z_gate, y_mla, y_gla, y_hy, w_o_mla, w_o_gla, w_o_hy, w_out):
    g_mla, g_gla, g_hy = _split(jax.nn.sigmoid(z_gate), (D_MODEL,) * N_BRANCH)
    m = g_mla * (y_mla @ w_o_mla) + g_gla * (y_gla @ w_o_gla) + g_hy * (y_hy @ w_o_hy)
    return m @ w_out


def sqrelu_mlp(h, w1, w2):
    return jnp.square(jax.nn.relu(h @ w1)) @ w2


def token_mixer(hx, hc, rope, with_ctx_out, w_in, mla_q_norm, mla_w_uq, mla_kv_norm, mla_w_ukv,
                gla_w_a2, gla_b_a, gla_out_norm, hy_short_w, hy_short_b, hy_filter_w, hy_bias,
                w_o_mla, w_o_gla, w_o_hy, w_out):
    L, Lc = hx.shape[1], hc.shape[1]
    xq, xkv, xkr, xgq, xgk, xgv, xgr, xaf, xab, xhy, xgate = _split(hx @ w_in, IN_SIZES)
    cq, ckv, ckr, cgq, cgk, cgv, cgr, caf, cab, chy, cgate = _split(hc @ w_in, IN_SIZES)

    qn, qr = mla_queries(xq, mla_q_norm, mla_w_uq, rope)
    kn, kr, v = mla_keys_values(xkv, xkr, mla_kv_norm, mla_w_ukv, rope)
    knc, krc, vc = mla_keys_values(ckv, ckr, mla_kv_norm, mla_w_ukv, None)
    y_mla = mla_latent_attention(qn, qr, jnp.concatenate([knc, kn], axis=1),
                                 jnp.concatenate([krc, kr], axis=1), jnp.concatenate([vc, v], axis=1))

    o_gla, o_gla_c = gla_bidirectional(gla_heads(xgq, xgk, xgv, xaf, xab, gla_w_a2, gla_b_a),
                                       gla_heads(cgq, cgk, cgv, caf, cab, gla_w_a2, gla_b_a), with_ctx_out)
    y_gla = gla_output(o_gla, xgr, gla_out_norm)

    y_hy = hyena_branch(xhy, hy_short_w, hy_short_b, hyena_filters(L, *hy_filter_w), hy_bias)

    out_x = merge_branches(xgate, y_mla, y_gla, y_hy, w_o_mla, w_o_gla, w_o_hy, w_out)
    if not with_ctx_out:
        return out_x, None

    qnc, qrc = mla_queries(cq, mla_q_norm, mla_w_uq, None)
    y_mla_c = mla_attend(qnc, qrc, knc, krc, vc).reshape(hc.shape[0], Lc, MLA_OUT)
    y_gla_c = gla_output(o_gla_c, cgr, gla_out_norm)
    y_hy_c = hyena_branch(chy, hy_short_w, hy_short_b, hyena_filters(Lc, *hy_filter_w), hy_bias)
    out_c = merge_branches(cgate, y_mla_c, y_gla_c, y_hy_c, w_o_mla, w_o_gla, w_o_hy, w_out)
    return out_x, out_c


def setup_inputs(seed: int = 0) -> dict:
    key = jax.random.key(seed)
    keys = jax.random.split(key, 32)

    def nrm(i, shape, scale):
        return jax.random.normal(keys[i], shape, F32) * scale

    def gain(i, shape):
        return 1.0 + 0.02 * jax.random.normal(keys[i], shape, F32)

    n_filt = 2 * HY_ORDER * HY_WIDTH
    return {
        'x': nrm(0, (BATCH, SEQ, D_MODEL), 1.0),
        'c': nrm(1, (BATCH, D_MODEL), 1.0),
        'ctx': nrm(2, (BATCH, CTX_LEN, D_MODEL), 1.0),
        'c_ctx': nrm(3, (D_MODEL,), 1.0),
        'ada_w': nrm(4, (DEPTH, D_MODEL, 6 * D_MODEL), 0.5 * D_MODEL ** -0.5),
        'ada_b': nrm(5, (DEPTH, 6 * D_MODEL), 0.02),
        'norm1_g': gain(6, (DEPTH, D_MODEL)),
        'norm2_g': gain(7, (DEPTH, D_MODEL)),
        'w_in': nrm(8, (DEPTH, D_MODEL, D_IN), D_MODEL ** -0.5),
        'mla_q_norm': gain(9, (DEPTH, MLA_Q_LORA)),
        'mla_w_uq': nrm(10, (DEPTH, MLA_Q_LORA, MLA_HEADS * (MLA_NOPE + MLA_ROPE)), MLA_Q_LORA ** -0.5),
        'mla_kv_norm': gain(11, (DEPTH, MLA_KV_LORA)),
        'mla_w_ukv': nrm(12, (DEPTH, MLA_KV_LORA, MLA_HEADS * (MLA_NOPE + MLA_V)), MLA_KV_LORA ** -0.5),
        'gla_w_a2': nrm(13, (DEPTH, 2, GLA_GATE_RANK, GLA_DK), GLA_GATE_RANK ** -0.5),
        'gla_b_a': nrm(14, (DEPTH, 2, GLA_DK), 0.1),
        'gla_out_norm': gain(15, (DEPTH, GLA_HV)),
        'hy_short_w': nrm(16, (DEPTH, HY_SHORT, (HY_ORDER + 1) * HY_WIDTH), HY_SHORT ** -0.5),
        'hy_short_b': nrm(17, (DEPTH, (HY_ORDER + 1) * HY_WIDTH), 0.02),
        'hy_f_w1': nrm(18, (DEPTH, HY_POS_DIM, HY_FILTER_HIDDEN), HY_POS_DIM ** -0.5),
        'hy_f_b1': nrm(19, (DEPTH, HY_FILTER_HIDDEN), 0.1),
        'hy_f_w2': nrm(20, (DEPTH, HY_FILTER_HIDDEN, HY_FILTER_HIDDEN), HY_FILTER_HIDDEN ** -0.5),
        'hy_f_b2': nrm(21, (DEPTH, HY_FILTER_HIDDEN), 0.1),
        'hy_f_w3': nrm(22, (DEPTH, HY_FILTER_HIDDEN, n_filt), HY_FILTER_HIDDEN ** -0.5),
        'hy_f_b3': nrm(23, (DEPTH, n_filt), 0.02),
        'hy_bias': nrm(24, (DEPTH, HY_ORDER, HY_WIDTH), 0.5),
        'w_o_mla': nrm(25, (DEPTH, MLA_OUT, D_MODEL), MLA_OUT ** -0.5),
        'w_o_gla': nrm(26, (DEPTH, GLA_DV, D_MODEL), GLA_DV ** -0.5),
        'w_o_hy': nrm(27, (DEPTH, HY_WIDTH, D_MODEL), HY_WIDTH ** -0.5),
        'w_out': nrm(28, (DEPTH, D_MODEL, D_MODEL), D_MODEL ** -0.5),
        'ff_w1': nrm(29, (DEPTH, D_MODEL, D_FF), D_MODEL ** -0.5),
        'ff_w2': nrm(30, (DEPTH, D_FF, D_MODEL), D_FF ** -0.5),
        'final_norm_g': gain(31, (D_MODEL,)),
    }


def reference(x, c, ctx, c_ctx, ada_w, ada_b, norm1_g, norm2_g, w_in, mla_q_norm, mla_w_uq, mla_kv_norm,
              mla_w_ukv, gla_w_a2, gla_b_a, gla_out_norm, hy_short_w, hy_short_b, hy_f_w1, hy_f_b1, hy_f_w2,
              hy_f_b2, hy_f_w3, hy_f_b3, hy_bias, w_o_mla, w_o_gla, w_o_hy, w_out, ff_w1, ff_w2, final_norm_g):
    rows = x.shape[1] // GRID_W
    rope = axial_rope_tables(rows)
    sc = jax.nn.silu(c)
    scc = jax.nn.silu(c_ctx)
    for l in range(DEPTH):
        with_ctx_out = l < DEPTH - 1
        mod_x = (sc @ ada_w[l] + ada_b[l])[:, None, :]
        mod_c = scc @ ada_w[l] + ada_b[l]
        shx1, scx1, gx1, shx2, scx2, gx2 = _split(mod_x, (D_MODEL,) * 6)
        shc1, scc1, gc1, shc2, scc2, gc2 = _split(mod_c, (D_MODEL,) * 6)

        hx = modulate(rmsnorm(x, norm1_g[l]), shx1, scx1)
        hc = modulate(rmsnorm(ctx, norm1_g[l]), shc1, scc1)
        mx, mc = token_mixer(hx, hc, rope, with_ctx_out, w_in[l], mla_q_norm[l], mla_w_uq[l], mla_kv_norm[l],
                             mla_w_ukv[l], gla_w_a2[l], gla_b_a[l], gla_out_norm[l], hy_short_w[l], hy_short_b[l],
                             (hy_f_w1[l], hy_f_b1[l], hy_f_w2[l], hy_f_b2[l], hy_f_w3[l], hy_f_b3[l]), hy_bias[l],
                             w_o_mla[l], w_o_gla[l], w_o_hy[l], w_out[l])
        x = x + gx1 * mx
        x = x + gx2 * sqrelu_mlp(modulate(rmsnorm(x, norm2_g[l]), shx2, scx2), ff_w1[l], ff_w2[l])
        if with_ctx_out:
            ctx = ctx + gc1 * mc
            ctx = ctx + gc2 * sqrelu_mlp(modulate(rmsnorm(ctx, norm2_g[l]), shc2, scc2), ff_w1[l], ff_w2[l])
    return rmsnorm(x, final_norm_g)
```

```cpp
#include <hip/hip_runtime.h>
#include <hip/hip_bf16.h>
#include <hip/hip_cooperative_groups.h>
#include <cstdio>
namespace cg = cooperative_groups;

typedef unsigned short u16;
typedef __attribute__((ext_vector_type(8))) short bf16x8;
typedef __attribute__((ext_vector_type(4))) float f32x4;
#define DEV __device__ __forceinline__
#define GAS __attribute__((address_space(1)))
#define LAS __attribute__((address_space(3)))
typedef unsigned int u32x4 __attribute__((ext_vector_type(4)));
typedef GAS const u32x4 gu4;

#ifndef SINGLE_LAUNCH
#define SINGLE_LAUNCH 1
#endif

constexpr int D = 1024, L = 4096, LC = 256, NB = 4, NGRP = 2;
constexpr int RL = NB * L, RC = NB * LC, RG = RL + RC;
constexpr int NIN = 6656;
constexpr int PK = L + LC;
constexpr int DFF = 4096;
constexpr int KSLD = 4104;
constexpr float EPS = 1e-6f;
constexpr int NPHASE = 43;

constexpr size_t al(size_t x) { return (x + 255) & ~(size_t)255; }
constexpr size_t CTRL_BYTES = 1 << 20;
constexpr size_t OFF_CNT = 0;
constexpr size_t OFF_NORM = 1024;
constexpr size_t OFF_NORMC = OFF_NORM + 2 * 1024 * 4;
constexpr size_t OFF_SSQ = 16384;
constexpr size_t OFF_BAR = 573440;
constexpr size_t OFF_MOD = 587264;
static_assert(OFF_SSQ + (size_t)2 * 2 * 34816 * 4 <= OFF_BAR && OFF_MOD + 2 * 9 * 6144 * 4 <= CTRL_BYTES, "ctrl map");
constexpr size_t OFF_CTXS = CTRL_BYTES;
constexpr size_t OFF_WIN = OFF_CTXS + (size_t)2048 * 1024 * 4;
constexpr size_t OFF_WUQ = OFF_WIN + (size_t)NIN * 1024 * 2;
constexpr size_t OFF_WUKV = OFF_WUQ + (size_t)768 * 256 * 2;
constexpr size_t OFF_WOM = OFF_WUKV + (size_t)1024 * 128 * 2;
constexpr size_t OFF_WOG = OFF_WOM + (size_t)1024 * 512 * 2;
constexpr size_t OFF_WOH = OFF_WOG + (size_t)1024 * 512 * 2;
constexpr size_t OFF_WOUT = OFF_WOH + (size_t)1024 * 512 * 2;
constexpr size_t OFF_W1 = OFF_WOUT + (size_t)1024 * 1024 * 2;
constexpr size_t OFF_W2 = OFF_W1 + (size_t)4096 * 1024 * 2;
constexpr size_t OFF_KS = OFF_W2 + (size_t)4096 * 1024 * 2;
constexpr size_t OFF_KFC = OFF_KS + (size_t)1024 * KSLD * 8;
constexpr size_t OFF_HX = OFF_KFC + (size_t)2 * 2 * 512 * 256 * 4;
constexpr size_t OFF_Q = OFF_HX + (size_t)RG * 1024 * 2;
constexpr size_t OFF_K = OFF_Q + (size_t)NB * 8 * PK * 96 * 2;
constexpr size_t OFF_VT = OFF_K + (size_t)NB * 8 * PK * 96 * 2;
constexpr size_t OFF_YMLA = OFF_VT + (size_t)NB * 8 * 64 * PK * 2;
constexpr size_t OFF_OF = OFF_YMLA + (size_t)RG * 512 * 2;
constexpr size_t OFF_OB = OFF_OF + (size_t)RG * 512 * 2;
constexpr size_t OFF_YHY = OFF_OB + (size_t)RG * 512 * 2;
constexpr size_t OFF_Z = OFF_YHY + (size_t)RG * 512 * 2;
constexpr size_t OFF_ZQ = OFF_Z;
constexpr size_t OFF_ZKV = OFF_ZQ + (size_t)RG * 256 * 2;
constexpr size_t OFF_MISC = OFF_ZKV + (size_t)RG * 128 * 2;
constexpr size_t OFF_GQ = OFF_MISC + (size_t)RG * 64 * 2;
constexpr size_t OFF_GK = OFF_GQ + (size_t)RG * 256 * 2;
constexpr size_t OFF_GV = OFF_GK + (size_t)RG * 256 * 2;
constexpr size_t OFF_GR = OFF_GV + (size_t)RG * 512 * 2;
constexpr size_t OFF_HYT = OFF_GR + (size_t)RG * 512 * 2;
constexpr size_t OFF_HYC = OFF_HYT + (size_t)NB * 2048 * L * 2;
constexpr size_t OFF_GATES = OFF_HYC + (size_t)RC * 1536 * 2;
constexpr size_t OFF_END1 = OFF_GATES + (size_t)RG * 3072 * 2;
constexpr size_t OFF_H = OFF_Z;
constexpr size_t OFF_END2 = OFF_H + (size_t)RG * 4096 * 2;
constexpr size_t WS_NEED = OFF_END1 > OFF_END2 ? OFF_END1 : OFF_END2;
static_assert(WS_NEED <= ((size_t)512 << 20), "workspace over 512 MiB");
static_assert((size_t)2 * 512 * 8192 * 4 <= (size_t)RG * 3072 * 2, "KF alias");

constexpr int SMEM_BYTES = 131072;
constexpr int NTH = 512;

struct P {
  const float* in[32];
  float* out;
  char* ws;
  int ph_lo, ph_hi;
};
enum { I_X = 0, I_C, I_CTX, I_CCTX, I_ADAW, I_ADAB, I_N1G, I_N2G, I_WIN, I_QNORM, I_WUQ, I_KVNORM, I_WUKV, I_WA2, I_BA,
       I_GONORM, I_HSW, I_HSB, I_FW1, I_FB1, I_FW2, I_FB2, I_FW3, I_FB3, I_HYB, I_WOM, I_WOG, I_WOH, I_WOUT, I_FF1, I_FF2, I_FNG };

DEV int TID() { int t = threadIdx.x; asm volatile("" : "+v"(t)); return t; }
DEV int BID() { int b = blockIdx.x; asm volatile("" : "+s"(b)); return b; }
DEV char* WSP(char* w) { asm volatile("" : "+s"(w)); return w; }
typedef __bf16 bf16x2_t __attribute__((ext_vector_type(2)));
typedef float f32x2_t __attribute__((ext_vector_type(2)));
DEV u16 f2bf(float f) { return __builtin_bit_cast(u16, (__bf16)f); }
DEV float bf2f(u16 h) { return __uint_as_float(((unsigned)h) << 16); }
DEV unsigned pk2(float a, float b) { f32x2_t v = {a, b}; bf16x2_t r = __builtin_convertvector(v, bf16x2_t); return __builtin_bit_cast(unsigned, r); }
DEV uint2 pk4(f32x4 v) { return make_uint2(pk2(v[0], v[1]), pk2(v[2], v[3])); }
DEV float wave_sum(float v) {
#pragma unroll
  for (int o = 1; o < 64; o <<= 1) v += __shfl_xor(v, o);
  return v;
}
DEV float sigmoidf(float x) { return 1.f / (1.f + __expf(-x)); }
DEV bf16x8 mk8(uint2 a, uint2 b) {
  union { uint4 u; bf16x8 v; } t; t.u = make_uint4(a.x, a.y, b.x, b.y); return t.v;
}
DEV f32x4 mfma(bf16x8 a, bf16x8 b, f32x4 c) { return __builtin_amdgcn_mfma_f32_16x16x32_bf16(a, b, c, 0, 0, 0); }
DEV void rowinfo(int r, int& b, int& p) {
  if (r < RL) { b = r >> 12; p = LC + (r & (L - 1)); } else { int rc = r - RL; b = rc >> 8; p = rc & (LC - 1); }
}

constexpr int LDT = 72;
constexpr int STG = 128 * LDT;
template <bool SWAP, int TN, bool PERM = false, bool PERMA = false>
DEV void gemm_core(f32x4 (&acc)[TN == 256 ? 8 : 4][4], const u16* __restrict__ A, int lda, const u16* __restrict__ B, int ldb, int K, u16* sm,
                   bool first = true, const u16* nA = nullptr, int nlda = 0, const u16* nB = nullptr, int nldb = 0) {
  constexpr int MI = TN == 256 ? 8 : 4;
  const int tid = TID(), lane = tid & 63, w = tid >> 6, lr = lane & 15, lg = lane >> 4;
  const int wr = TN == 256 ? (w >> 2) : (w >> 1), wc = TN == 256 ? (w & 3) : (w & 1);
  constexpr int OPA = 256 * 32, OPB = TN * 32, STSZ = OPA + OPB;
  const int drow = lane >> 2, dch = lane & 3;
  const int brow = TN == 256 ? w * 32 : w * 16;
  const int pa0 = PERMA ? (w * 32 + 8 * (drow >> 2) + (drow & 3)) : (w * 32 + drow);
  const int pa1 = PERMA ? (pa0 + 4) : (w * 32 + 16 + drow);
  const GAS u16* ga0 = (const GAS u16*)(A + (size_t)pa0 * lda + dch * 8);
  const GAS u16* ga1 = (const GAS u16*)(A + (size_t)pa1 * lda + dch * 8);
  const int pb0 = PERM ? ((TN == 256 ? w * 32 : (w >> 1) * 32) + 8 * (drow >> 2) + (TN == 256 ? 0 : 4 * (w & 1)) + (drow & 3)) : (brow + drow);
  const int pb1 = PERM ? (pb0 + 4) : (brow + 16 + drow);
  const GAS u16* gb0 = (const GAS u16*)(B + (size_t)pb0 * ldb + dch * 8);
  const GAS u16* gb1 = (const GAS u16*)(B + (size_t)pb1 * ldb + dch * 8);
  LAS u16* ls = (LAS u16*)sm;
  const int wofA = __builtin_amdgcn_readfirstlane(w * 32 * 32);
  const int wofB = __builtin_amdgcn_readfirstlane(OPA + brow * 32);
#define ISSUE(kk) do { const int _st = ((kk) & 3) * STSZ; const int _ko = (kk) * 32; \
    __builtin_amdgcn_global_load_lds((const GAS unsigned*)(ga0 + _ko), (LAS unsigned*)(ls + _st + wofA), 16, 0, 0); \
    __builtin_amdgcn_global_load_lds((const GAS unsigned*)(ga1 + _ko), (LAS unsigned*)(ls + _st + wofA + 16 * 32), 16, 0, 0); \
    __builtin_amdgcn_global_load_lds((const GAS unsigned*)(gb0 + _ko), (LAS unsigned*)(ls + _st + wofB), 16, 0, 0); \
    if (TN == 256) __builtin_amdgcn_global_load_lds((const GAS unsigned*)(gb1 + _ko), (LAS unsigned*)(ls + _st + wofB + 16 * 32), 16, 0, 0); } while (0)
#define FRAG(p, i) (*(const bf16x8*)((p) + (i) * 16 * 32))
#define MM(mi, ni, av, bv) acc[mi][ni] = SWAP ? mfma(bv, av, acc[mi][ni]) : mfma(av, bv, acc[mi][ni])
#define MM16(mo, a0, a1, a2, a3, b0, b1, b2, b3) do { \
    MM(mo + 0, 0, a0, b0); MM(mo + 1, 0, a1, b0); MM(mo + 0, 1, a0, b1); MM(mo + 1, 1, a1, b1); \
    MM(mo + 2, 0, a2, b0); MM(mo + 3, 0, a3, b0); MM(mo + 2, 1, a2, b1); MM(mo + 3, 1, a3, b1); \
    MM(mo + 0, 2, a0, b2); MM(mo + 1, 2, a1, b2); MM(mo + 2, 2, a2, b2); MM(mo + 3, 2, a3, b2); \
    MM(mo + 0, 3, a0, b3); MM(mo + 1, 3, a1, b3); MM(mo + 2, 3, a2, b3); MM(mo + 3, 3, a3, b3); } while (0)
  const int nk2 = K >> 6;
  if (first) { __syncthreads(); ISSUE(0); ISSUE(1); }
  const int aoff = (wr * MI * 16 + lr) * 32 + lg * 8, boff = OPA + (wc * 64 + lr) * 32 + lg * 8;
  for (int s2 = 0; s2 < nk2; ++s2) {
    asm volatile("s_waitcnt vmcnt(0)" ::: "memory");
    __builtin_amdgcn_s_barrier();
    __builtin_amdgcn_sched_barrier(0);
    if (s2 + 1 < nk2) { ISSUE(2 * s2 + 2); ISSUE(2 * s2 + 3); }
    const u16* p0 = sm + ((2 * s2) & 3) * STSZ;
    const u16* p1 = sm + ((2 * s2 + 1) & 3) * STSZ;
    const bf16x8 b0 = FRAG(p0 + boff, 0), b1 = FRAG(p0 + boff, 1), b2 = FRAG(p0 + boff, 2), b3 = FRAG(p0 + boff, 3);
    const bf16x8 a0 = FRAG(p0 + aoff, 0), a1 = FRAG(p0 + aoff, 1), a2 = FRAG(p0 + aoff, 2), a3 = FRAG(p0 + aoff, 3);
    if (MI == 8) {
      const bf16x8 a4 = FRAG(p0 + aoff, 4), a5 = FRAG(p0 + aoff, 5), a6 = FRAG(p0 + aoff, 6), a7 = FRAG(p0 + aoff, 7);
      __builtin_amdgcn_sched_barrier(0);
      MM16(0, a0, a1, a2, a3, b0, b1, b2, b3);
      __builtin_amdgcn_sched_barrier(0);
      const bf16x8 d0 = FRAG(p1 + aoff, 0), d1 = FRAG(p1 + aoff, 1), d2 = FRAG(p1 + aoff, 2), d3 = FRAG(p1 + aoff, 3);
      __builtin_amdgcn_sched_barrier(0);
      MM16(MI - 4, a4, a5, a6, a7, b0, b1, b2, b3);
      __builtin_amdgcn_sched_barrier(0);
      const bf16x8 c0 = FRAG(p1 + boff, 0), c1 = FRAG(p1 + boff, 1), c2 = FRAG(p1 + boff, 2), c3 = FRAG(p1 + boff, 3);
      const bf16x8 d4 = FRAG(p1 + aoff, 4), d5 = FRAG(p1 + aoff, 5), d6 = FRAG(p1 + aoff, 6), d7 = FRAG(p1 + aoff, 7);
      __builtin_amdgcn_sched_barrier(0);
      MM16(0, d0, d1, d2, d3, c0, c1, c2, c3);
      __builtin_amdgcn_sched_barrier(0);
      MM16(MI - 4, d4, d5, d6, d7, c0, c1, c2, c3);
    } else {
      const bf16x8 c0 = FRAG(p1 + boff, 0), c1 = FRAG(p1 + boff, 1), c2 = FRAG(p1 + boff, 2), c3 = FRAG(p1 + boff, 3);
      const bf16x8 d0 = FRAG(p1 + aoff, 0), d1 = FRAG(p1 + aoff, 1), d2 = FRAG(p1 + aoff, 2), d3 = FRAG(p1 + aoff, 3);
      __builtin_amdgcn_sched_barrier(0);
      MM16(0, a0, a1, a2, a3, b0, b1, b2, b3);
      __builtin_amdgcn_sched_barrier(0);
      MM16(0, d0, d1, d2, d3, c0, c1, c2, c3);
    }
    __builtin_amdgcn_sched_barrier(0);
  }
  if (nA) {
    ga0 = (const GAS u16*)(nA + (size_t)pa0 * nlda + dch * 8);
    ga1 = (const GAS u16*)(nA + (size_t)pa1 * nlda + dch * 8);
    gb0 = (const GAS u16*)(nB + (size_t)pb0 * nldb + dch * 8);
    gb1 = (const GAS u16*)(nB + (size_t)pb1 * nldb + dch * 8);
    ISSUE(0); ISSUE(1);
  }
#undef MM16
#undef MM
#undef FRAG
#undef ISSUE
}
template <int MI>
DEV void zero_acc(f32x4 (&acc)[MI][4]) {
#pragma unroll
  for (int i = 0; i < MI; ++i)
#pragma unroll
    for (int j = 0; j < 4; ++j) acc[i][j] = f32x4{0.f, 0.f, 0.f, 0.f};
}

DEV int win_orig_col(int j) {
  if (j < 416) return j;
  if (j < 432) return 1952 + (j - 416);
  if (j < 448) return 1968 + (j - 432);
  if (j < 512) return -1;
  if (j < 2048) return 416 + (j - 512);
  return j - 64;
}
DEV void cvt_item(const float* __restrict__ W, int Norig, int K, u16* WT, int n, int k8, int oc, const float* gain) {
  float v[8];
#pragma unroll
  for (int e = 0; e < 8; ++e) {
    int k = k8 * 8 + e;
    float x = (oc >= 0) ? W[(size_t)k * Norig + oc] : 0.f;
    if (gain) x *= gain[k];
    v[e] = x;
  }
  *(uint4*)(WT + (size_t)n * K + k8 * 8) = make_uint4(pk2(v[0], v[1]), pk2(v[2], v[3]), pk2(v[4], v[5]), pk2(v[6], v[7]));
}

DEV void filter_item(const P& p, int l, int item, char* smem) {
  constexpr int NP = 8;
  const bool isc = item >= 512;
  const int Lx = isc ? LC : L;
  const int pos0 = (isc ? item - 512 : item) * NP;
  float* feat = (float*)smem;
  float* h1 = feat + NP * 36;
  float* h2 = h1 + NP * 64;
  const int tid = TID();
  const float* w1 = p.in[I_FW1] + (size_t)l * 33 * 64; const float* b1 = p.in[I_FB1] + l * 64;
  const float* w2 = p.in[I_FW2] + (size_t)l * 64 * 64; const float* b2 = p.in[I_FB2] + l * 64;
  const float* w3 = p.in[I_FW3] + (size_t)l * 64 * 2048; const float* b3 = p.in[I_FB3] + l * 2048;
  __syncthreads();
  for (int e = tid; e < NP * 33; e += NTH) {
    int ps = e / 33, fi = e % 33;
    float pos = (float)(pos0 + ps);
    float v;
    if (fi == 0) v = pos / (float)(Lx - 1);
    else {
      int i = (fi - 1) & 15;
      float f = 1e-4f + (float)i * ((15.f - 1e-4f) / 15.f);
      float ang = (6.283185307179586f / (float)Lx) * pos * f;
      v = (fi <= 16) ? __cosf(ang) : __sinf(ang);
    }
    feat[ps * 36 + fi] = v;
  }
  __syncthreads();
  {
    const int ps = tid >> 6, u = tid & 63;
    float a = b1[u];
#pragma unroll 11
    for (int k = 0; k < 33; ++k) a += feat[ps * 36 + k] * w1[k * 64 + u];
    h1[ps * 64 + u] = __sinf(a);
    __syncthreads();
    a = b2[u];
#pragma unroll 16
    for (int k = 0; k < 64; ++k) a += h1[ps * 64 + k] * w2[k * 64 + u];
    h2[ps * 64 + u] = __sinf(a);
  }
  __syncthreads();
  float* KF = isc ? (float*)(p.ws + OFF_KFC) : (float*)(p.ws + OFF_GATES);
  float* NRM = isc ? (float*)(p.ws + OFF_NORMC) : (float*)(p.ws + OFF_NORM) + l * 1024;
  const float da = logf(1e-2f) / 0.3f, db = logf(1e-2f) / 1.5f;
#pragma unroll 1
  for (int jj = 0; jj < 4; ++jj) {
    const int j = tid + NTH * jj;
    float acc[NP];
#pragma unroll
    for (int q = 0; q < NP; ++q) acc[q] = 0.f;
#pragma unroll 4
    for (int k = 0; k < 64; k += 4) {
      const float w0 = w3[(k + 0) * 2048 + j], w1v = w3[(k + 1) * 2048 + j], w2v = w3[(k + 2) * 2048 + j], w3v = w3[(k + 3) * 2048 + j];
#pragma unroll
      for (int q = 0; q < NP; ++q) {
        const f32x4 h = *(const f32x4*)(h2 + q * 64 + k);
        acc[q] += h[0] * w0 + h[1] * w1v + h[2] * w2v + h[3] * w3v;
      }
    }
    const int dir = j >> 10, n = (j >> 9) & 1, c = j & 511;
    const float delta = fabsf(da + (float)c * ((db - da) / 511.f));
    const float bb = b3[j];
    float s = 0.f;
    float* dst = KF + ((size_t)((n * 2 + dir) * 512 + c)) * Lx + pos0;
#pragma unroll
    for (int q = 0; q < NP; ++q) {
      float t = (float)(pos0 + q) / (float)(Lx - 1);
      float v = (acc[q] + bb) * expf(-t * delta);
      s += fabsf(v);
      dst[q] = v;
    }
    atomicAdd(NRM + n * 512 + c, s);
  }
}

DEV void adaln_item(const P& p, int item, char* smem) {
  float* sc = (float*)smem;
  const int tid = TID();
  const int l2 = item / 96, rem = item % 96, nch = rem >> 3, ks = rem & 7, k0 = ks * 128;
  __syncthreads();
  for (int e = tid; e < 9 * 128; e += NTH) {
    int r = e >> 7, k = k0 + (e & 127);
    float v = (r < 8) ? p.in[I_C][r * 1024 + k] : p.in[I_CCTX][k];
    sc[e] = v / (1.f + expf(-v));
  }
  __syncthreads();
  const int n = nch * 512 + tid;
  const float* W = p.in[I_ADAW] + (size_t)l2 * 1024 * 6144 + (size_t)k0 * 6144;
  float acc[9];
#pragma unroll
  for (int r = 0; r < 9; ++r) acc[r] = 0.f;
#pragma unroll 32
  for (int k = 0; k < 128; ++k) {
    float w = W[(size_t)k * 6144 + n];
#pragma unroll
    for (int r = 0; r < 9; ++r) acc[r] += sc[r * 128 + k] * w;
  }
  const float bb = (ks == 0) ? p.in[I_ADAB][l2 * 6144 + n] : 0.f;
  float* MOD = (float*)(p.ws + OFF_MOD);
#pragma unroll
  for (int r = 0; r < 9; ++r) atomicAdd(MOD + ((size_t)l2 * 9 + r) * 6144 + n, acc[r] + bb);
}

DEV void phase_prep(const P& p, int l, char* smem) {
  const int nfilt = (l == 0) ? 544 : 512;
  for (int it = BID(); it < nfilt; it += gridDim.x) filter_item(p, l, it, smem);
  if (l == 0) for (int it = BID(); it < 192; it += gridDim.x) adaln_item(p, it, smem);
  const long T = (long)gridDim.x * NTH;
  const long gt = (long)BID() * NTH + TID();
  char* ws = WSP(p.ws);
  {
    const float* W = p.in[I_WIN] + (size_t)l * 1024 * 6592;
    for (long i = gt; i < (long)NIN * 128; i += T) { int k8 = (int)(i / NIN), n = (int)(i % NIN); cvt_item(W, 6592, 1024, (u16*)(ws + OFF_WIN), n, k8, win_orig_col(n), nullptr); }
  }
  {
    const float* W = p.in[I_WUQ] + (size_t)l * 256 * 768; const float* g = p.in[I_QNORM] + l * 256;
    for (long i = gt; i < 768L * 32; i += T) {
      int k8 = (int)(i / 768), n = (int)(i % 768);
      int oc = (n < 512) ? (n >> 6) * 96 + (n & 63) : ((n - 512) >> 5) * 96 + 64 + ((n - 512) & 31);
      cvt_item(W, 768, 256, (u16*)(ws + OFF_WUQ), n, k8, oc, g);
    }
  }
  {
    const float* W = p.in[I_WUKV] + (size_t)l * 128 * 1024; const float* g = p.in[I_KVNORM] + l * 128;
    for (long i = gt; i < 1024L * 16; i += T) {
      int k8 = (int)(i / 1024), n = (int)(i % 1024);
      int oc = (n < 512) ? (n >> 6) * 128 + (n & 63) : ((n - 512) >> 6) * 128 + 64 + ((n - 512) & 63);
      cvt_item(W, 1024, 128, (u16*)(ws + OFF_WUKV), n, k8, oc, g);
    }
  }
  for (int m = 0; m < 3; ++m) {
    const float* W = p.in[I_WOM + m] + (size_t)l * 512 * 1024;
    u16* WT = (u16*)(ws + (m == 0 ? OFF_WOM : (m == 1 ? OFF_WOG : OFF_WOH)));
    for (long i = gt; i < 1024L * 64; i += T) { int k8 = (int)(i / 1024), n = (int)(i % 1024); cvt_item(W, 1024, 512, WT, n, k8, n, nullptr); }
  }
  {
    const float* W = p.in[I_WOUT] + (size_t)l * 1024 * 1024;
    for (long i = gt; i < 1024L * 128; i += T) { int k8 = (int)(i / 1024), n = (int)(i % 1024); cvt_item(W, 1024, 1024, (u16*)(ws + OFF_WOUT), n, k8, n, nullptr); }
  }
  {
    const float* W = p.in[I_FF1] + (size_t)l * 1024 * 4096;
    for (long i = gt; i < 4096L * 128; i += T) { int k8 = (int)(i / 4096), n = (int)(i % 4096); cvt_item(W, 4096, 1024, (u16*)(ws + OFF_W1), n, k8, n, nullptr); }
  }
  {
    const float* W = p.in[I_FF2] + (size_t)l * 4096 * 1024;
    for (long i = gt; i < 1024L * 512; i += T) { int k8 = (int)(i / 1024), n = (int)(i % 1024); cvt_item(W, 1024, 4096, (u16*)(ws + OFF_W2), n, k8, n, nullptr); }
  }
}

DEV int PADI(int i) { return i + (i >> 4); }
constexpr int TW_OFF = 90112;
DEV int PADT(int k) { return k + (k >> 3); }
DEV void fft_build_tw(char* smem) {
  float2* tw = (float2*)(smem + TW_OFF);
  __syncthreads();
  for (int k = TID(); k < 4096; k += NTH) {
    const float fr = (float)k * (1.f / 8192.f);
    tw[PADT(k)] = make_float2(__builtin_amdgcn_cosf(fr), __builtin_amdgcn_sinf(fr));
  }
  __syncthreads();
}
template <bool INV>
DEV void bfly(float2& a, float2& b, const float2 w) {
  const float c = w.x, s = w.y;
  if (!INV) {
    float tx = a.x - b.x, ty = a.y - b.y;
    a.x += b.x; a.y += b.y;
    b.x = tx * c + ty * s; b.y = ty * c - tx * s;
  } else {
    float tx = b.x * c - b.y * s, ty = b.x * s + b.y * c;
    b.x = a.x - tx; b.y = a.y - ty;
    a.x += tx; a.y += ty;
  }
}
template <bool INV, bool HALF>
DEV void fft_r8_pass(float2* buf, int q, int lq) {
  const float2* tw = (const float2*)((const char*)buf + TW_OFF);
#pragma unroll 2
  for (int gi = TID(); gi < 1024; gi += NTH) {
    const int pos = gi & (q - 1), base = (gi >> lq) * 8 * q + pos;
    const int fpi = pos << (10 - lq);
    float2 e[8];
#pragma unroll
    for (int m = 0; m < 8; ++m) e[m] = (HALF && !INV && m >= 4) ? make_float2(0.f, 0.f) : buf[PADI(base + m * q)];
    if (!INV) {
      if (HALF) {
#pragma unroll
        for (int m = 0; m < 4; ++m) { const float2 w = tw[PADT(fpi + m * 1024)]; e[m + 4] = make_float2(e[m].x * w.x + e[m].y * w.y, e[m].y * w.x - e[m].x * w.y); }
      } else {
#pragma unroll
        for (int m = 0; m < 4; ++m) bfly<false>(e[m], e[m + 4], tw[PADT(fpi + m * 1024)]);
      }
#pragma unroll
      for (int m = 0; m < 2; ++m) { const float2 w = tw[PADT(2 * fpi + m * 2048)]; bfly<false>(e[m], e[m + 2], w); bfly<false>(e[m + 4], e[m + 6], w); }
      {
        const float2 w = tw[PADT(4 * fpi)];
#pragma unroll
        for (int m = 0; m < 8; m += 2) bfly<false>(e[m], e[m + 1], w);
      }
    } else {
      {
        const float2 w = tw[PADT(4 * fpi)];
#pragma unroll
        for (int m = 0; m < 8; m += 2) bfly<true>(e[m], e[m + 1], w);
      }
#pragma unroll
      for (int m = 0; m < 2; ++m) { const float2 w = tw[PADT(2 * fpi + m * 2048)]; bfly<true>(e[m], e[m + 2], w); bfly<true>(e[m + 4], e[m + 6], w); }
      if (HALF) {
#pragma unroll
        for (int m = 0; m < 4; ++m) { const float2 w = tw[PADT(fpi + m * 1024)]; e[m].x += e[m + 4].x * w.x - e[m + 4].y * w.y; e[m].y += e[m + 4].x * w.y + e[m + 4].y * w.x; }
      } else {
#pragma unroll
        for (int m = 0; m < 4; ++m) bfly<true>(e[m], e[m + 4], tw[PADT(fpi + m * 1024)]);
      }
    }
#pragma unroll
    for (int m = 0; m < 8; ++m) if (!(HALF && INV && m >= 4)) buf[PADI(base + m * q)] = e[m];
  }
  __syncthreads();
}
DEV void fft_r2_last(float2* buf) {
#pragma unroll 4
  for (int gi = TID(); gi < 4096; gi += NTH) {
    float2 a = buf[PADI(2 * gi)], b = buf[PADI(2 * gi + 1)];
    buf[PADI(2 * gi)] = make_float2(a.x + b.x, a.y + b.y);
    buf[PADI(2 * gi + 1)] = make_float2(a.x - b.x, a.y - b.y);
  }
  __syncthreads();
}
template <bool ZHI>
DEV void fft_fwd(float2* buf) {
  fft_r8_pass<false, ZHI>(buf, 1024, 10); fft_r8_pass<false, false>(buf, 128, 7); fft_r8_pass<false, false>(buf, 16, 4); fft_r8_pass<false, false>(buf, 2, 1);
  fft_r2_last(buf);
}
template <bool LOHALF>
DEV void fft_inv(float2* buf) {
  fft_r2_last(buf);
  fft_r8_pass<true, false>(buf, 2, 1); fft_r8_pass<true, false>(buf, 16, 4); fft_r8_pass<true, false>(buf, 128, 7); fft_r8_pass<true, LOHALF>(buf, 1024, 10);
}
DEV int brev13(int f) { return (int)(__brev((unsigned)f) >> 19); }

DEV void filtfft_task(const P& p, int l, int c, char* smem) {
  float2* buf = (float2*)smem;
  const float* KF = (const float*)(p.ws + OFF_GATES);
  const float* NRM = (const float*)(p.ws + OFF_NORM) + l * 1024;
  const int tid = TID();
  __syncthreads();
  for (int i = tid; i < 8192; i += NTH) {
    float a, b;
    if (i < 4096) { a = KF[((size_t)(0 * 2 + 0) * 512 + c) * L + i]; b = KF[((size_t)(1 * 2 + 0) * 512 + c) * L + i]; }
    else if (i == 4096) { a = 0.f; b = 0.f; }
    else { a = KF[((size_t)(0 * 2 + 1) * 512 + c) * L + (8192 - i)]; b = KF[((size_t)(1 * 2 + 1) * 512 + c) * L + (8192 - i)]; }
    buf[PADI(i)] = make_float2(a, b);
  }
  __syncthreads();
  fft_fwd<false>(buf);
  const float s0 = 0.5f / (NRM[c] * 8192.f), s1 = 0.5f / (NRM[512 + c] * 8192.f);
  float2* KS = (float2*)(p.ws + OFF_KS);
  for (int f = tid; f <= 4096; f += NTH) {
    float2 zf = buf[PADI(brev13(f))], zn = buf[PADI(brev13((8192 - f) & 8191))];
    KS[(size_t)(0 * 512 + c) * KSLD + f] = make_float2((zf.x + zn.x) * s0, (zf.y - zn.y) * s0);
    KS[(size_t)(1 * 512 + c) * KSLD + f] = make_float2((zf.y + zn.y) * s1, -(zf.x - zn.x) * s1);
  }
  __syncthreads();
}

DEV void norm_rows(const float* xl, const float* xc, const float* gain, const float* modl, const float* modc, int shoff, u16* HX, int nrows) {
  const int gw = BID() * 8 + (TID() >> 6), NW = gridDim.x * 8, lane = TID() & 63;
  for (int r0 = gw; r0 < nrows; r0 += 2 * NW) {
    const int r1 = r0 + NW; const bool has1 = r1 < nrows;
    const float* s0 = (r0 < RL) ? xl + (size_t)r0 * D : xc + (size_t)(r0 - RL) * D;
    const float* s1 = has1 ? ((r1 < RL) ? xl + (size_t)r1 * D : xc + (size_t)(r1 - RL) * D) : s0;
    f32x4 a[4], b[4];
#pragma unroll
    for (int j = 0; j < 2; ++j) {
      a[2 * j] = *(const f32x4*)(s0 + j * 512 + lane * 8); a[2 * j + 1] = *(const f32x4*)(s0 + j * 512 + lane * 8 + 4);
      b[2 * j] = *(const f32x4*)(s1 + j * 512 + lane * 8); b[2 * j + 1] = *(const f32x4*)(s1 + j * 512 + lane * 8 + 4);
    }
    float sa = 0.f, sb = 0.f;
#pragma unroll
    for (int j = 0; j < 4; ++j) {
      sa += a[j][0] * a[j][0] + a[j][1] * a[j][1] + a[j][2] * a[j][2] + a[j][3] * a[j][3];
      sb += b[j][0] * b[j][0] + b[j][1] * b[j][1] + b[j][2] * b[j][2] + b[j][3] * b[j][3];
    }
    const float ra = rsqrtf(wave_sum(sa) * (1.f / D) + EPS), rb = rsqrtf(wave_sum(sb) * (1.f / D) + EPS);
    const float* m0 = (r0 < RL) ? modl + (size_t)(r0 >> 12) * 6144 : modc;
    const float* m1 = (r1 < RL) ? modl + (size_t)(r1 >> 12) * 6144 : modc;
#pragma unroll
    for (int j = 0; j < 2; ++j) {
      const int c0 = j * 512 + lane * 8;
      f32x4 ya[2], yb[2];
#pragma unroll
      for (int h = 0; h < 2; ++h) {
        const f32x4 g = *(const f32x4*)(gain + c0 + 4 * h);
        const f32x4 sh0 = *(const f32x4*)(m0 + shoff + c0 + 4 * h), sc0 = *(const f32x4*)(m0 + shoff + 1024 + c0 + 4 * h);
        const f32x4 sh1 = *(const f32x4*)(m1 + shoff + c0 + 4 * h), sc1 = *(const f32x4*)(m1 + shoff + 1024 + c0 + 4 * h);
#pragma unroll
        for (int e = 0; e < 4; ++e) {
          ya[h][e] = a[2 * j + h][e] * ra * g[e] * (1.f + sc0[e]) + sh0[e];
          yb[h][e] = b[2 * j + h][e] * rb * g[e] * (1.f + sc1[e]) + sh1[e];
        }
      }
      { const uint2 lo = pk4(ya[0]), hi = pk4(ya[1]); *(uint4*)(HX + (size_t)r0 * D + c0) = make_uint4(lo.x, lo.y, hi.x, hi.y); }
      if (has1) { const uint2 lo = pk4(yb[0]), hi = pk4(yb[1]); *(uint4*)(HX + (size_t)r1 * D + c0) = make_uint4(lo.x, lo.y, hi.x, hi.y); }
    }
  }
}

DEV void rope4(f32x4& v, int pos, int lg) {
#pragma unroll
  for (int j = 0; j < 4; ++j) {
    float pv = __shfl_xor(v[j], 32);
    int i = (lg * 4 + j) & 7;
    float inv = exp2f(-(float)i * (13.287712379549449f / 8.f));
    float ang = (float)pos * inv; float sn = __sinf(ang), cs = __cosf(ang);
    v[j] = (lg < 2) ? v[j] * cs - pv * sn : pv * sn + v[j] * cs;
  }
}

DEV void rope_perm(f32x4& ve, f32x4& vo, int pos, int lg) {
#pragma unroll
  for (int h = 0; h < 2; ++h) {
#pragma unroll
    for (int j = 0; j < 4; ++j) {
      float x = h ? vo[j] : ve[j];
      float pv = __shfl_xor(x, 16);
      int i = h * 4 + j;
      float inv = exp2f(-(float)i * (13.287712379549449f / 8.f));
      float ang = (float)pos * inv; float sn = __sinf(ang), cs = __cosf(ang);
      float y = ((lg & 1) == 0) ? x * cs - pv * sn : pv * sn + x * cs;
      if (h) vo[j] = y; else ve[j] = y;
    }
  }
}

DEV void phase_win(const P& p, int l, int g, char* smem) {
  char* ws = WSP(p.ws);
  const u16* HX = (const u16*)(ws + OFF_HX);
  const u16* WT = (const u16*)(ws + OFF_WIN);
  float* SSQ = (float*)(ws + OFF_SSQ) + (size_t)l * 2 * 34816;
  const int tid = TID(), lane = tid & 63, w = tid >> 6, wr = w >> 2, wc = w & 3, lr = lane & 15, lg = lane >> 4;
  const int NT = 26, ntiles = 68 * NT;
  bool pref = false;
  for (int t = BID(); t < ntiles; t += gridDim.x) {
    const int mt = t / NT, nt = t % NT;
    const int m0 = mt * 256, n0 = nt * 256;
    const bool lat = mt < 64;
    f32x4 acc[8][4]; zero_acc<8>(acc);
    const bool swap = !(nt >= 8 && nt < 14 && lat);
    const int t2 = t + gridDim.x;
    const bool swap2 = !((t2 % NT) >= 8 && (t2 % NT) < 14 && (t2 / NT) < 64);
    const bool hn = t2 < ntiles && swap2 == swap;
    const u16* nA = hn ? HX + (size_t)(t2 / NT) * 256 * D : nullptr; const u16* nB = WT + (size_t)(t2 % NT) * 256 * D;
    if (swap) gemm_core<true, 256, true>(acc, HX + (size_t)m0 * D, D, WT + (size_t)n0 * D, D, D, (u16*)smem, !pref, nA, D, nB, D);
    else gemm_core<false, 256, false, true>(acc, HX + (size_t)m0 * D, D, WT + (size_t)n0 * D, D, D, (u16*)smem, !pref, nA, D, nB, D);
    pref = hn;
    if (!swap) {
      const int b = m0 >> 12, s0 = m0 & (L - 1);
      u16* HYT = (u16*)(ws + OFF_HYT);
#pragma unroll
      for (int mp = 0; mp < 4; ++mp)
#pragma unroll
        for (int ni = 0; ni < 4; ++ni) {
          int ch = n0 - 2048 + wc * 64 + ni * 16 + lr;
          int s = s0 + wr * 128 + mp * 32 + lg * 8;
          const uint2 lo = pk4(acc[2 * mp][ni]), hi = pk4(acc[2 * mp + 1][ni]);
          *(uint4*)(HYT + ((size_t)(b * 2048 + ch)) * L + s) = make_uint4(lo.x, lo.y, hi.x, hi.y);
        }
      continue;
    }
    const int cs = nt * 4 + wc;
    if (cs == 7) continue;
#pragma unroll
    for (int mi = 0; mi < 8; ++mi) {
      const int r = m0 + wr * 128 + mi * 16 + lr;
      if (cs < 6) {
        u16* dst = (cs < 4) ? (u16*)(ws + OFF_ZQ) + (size_t)r * 256 + cs * 64 : (u16*)(ws + OFF_ZKV) + (size_t)r * 128 + (cs - 4) * 64;
        float ss = 0.f;
#pragma unroll
        for (int np = 0; np < 2; ++np) {
          const f32x4 v = acc[mi][2 * np], v2 = acc[mi][2 * np + 1];
          ss += v[0] * v[0] + v[1] * v[1] + v[2] * v[2] + v[3] * v[3] + v2[0] * v2[0] + v2[1] * v2[1] + v2[2] * v2[2] + v2[3] * v2[3];
          const uint2 lo = pk4(v), hi = pk4(v2);
          *(uint4*)(dst + np * 32 + lg * 8) = make_uint4(lo.x, lo.y, hi.x, hi.y);
        }
        ss += __shfl_xor(ss, 16); ss += __shfl_xor(ss, 32);
        if (lg == 0) {
          int grow = (r < RL) ? g * RL + r : 32768 + g * RC + (r - RL);
          atomicAdd(SSQ + (size_t)(cs < 4 ? 0 : 1) * 34816 + grow, ss);
        }
      } else if (cs == 6) {
        int b, pp; rowinfo(r, b, pp);
        u16* Kb = (u16*)(ws + OFF_K);
        u16* MISC = (u16*)(ws + OFF_MISC);
        {
          f32x4 ve = acc[mi][0], vo = acc[mi][1];
          if (r < RL) { int sidx = r & (L - 1); rope_perm(ve, vo, (lg < 2) ? (sidx >> 6) : (sidx & 63), lg); }
          const uint2 lo = pk4(ve), hi = pk4(vo);
          const uint4 pk = make_uint4(lo.x, lo.y, hi.x, hi.y);
#pragma unroll
          for (int h = 0; h < 8; ++h) *(uint4*)(Kb + ((size_t)(b * 8 + h) * PK + pp) * 96 + 64 + lg * 8) = pk;
          *(uint4*)(MISC + (size_t)r * 64 + lg * 8) = pk;
        }
        {
          const uint2 lo = pk4(acc[mi][2]), hi = pk4(acc[mi][3]);
          *(uint4*)(MISC + (size_t)r * 64 + 32 + lg * 8) = make_uint4(lo.x, lo.y, hi.x, hi.y);
        }
      } else if (cs < 56) {
        u16* dst;
        if (cs < 12) dst = (u16*)(ws + OFF_GQ) + (size_t)r * 256 + (cs - 8) * 64;
        else if (cs < 16) dst = (u16*)(ws + OFF_GK) + (size_t)r * 256 + (cs - 12) * 64;
        else if (cs < 24) dst = (u16*)(ws + OFF_GV) + (size_t)r * 512 + (cs - 16) * 64;
        else if (cs < 32) dst = (u16*)(ws + OFF_GR) + (size_t)r * 512 + (cs - 24) * 64;
        else dst = (u16*)(ws + OFF_HYC) + (size_t)(r - RL) * 1536 + (cs - 32) * 64;
#pragma unroll
        for (int np = 0; np < 2; ++np) {
          const uint2 lo = pk4(acc[mi][2 * np]), hi = pk4(acc[mi][2 * np + 1]);
          *(uint4*)(dst + np * 32 + lg * 8) = make_uint4(lo.x, lo.y, hi.x, hi.y);
        }
      } else {
        u16* dst = (u16*)(ws + OFF_GATES) + (size_t)r * 3072 + (cs - 56) * 64;
#pragma unroll
        for (int np = 0; np < 2; ++np) {
          f32x4 v = acc[mi][2 * np], v2 = acc[mi][2 * np + 1];
#pragma unroll
          for (int e = 0; e < 4; ++e) { v[e] = sigmoidf(v[e]); v2[e] = sigmoidf(v2[e]); }
          const uint2 lo = pk4(v), hi = pk4(v2);
          *(uint4*)(dst + np * 32 + lg * 8) = make_uint4(lo.x, lo.y, hi.x, hi.y);
        }
      }
    }
  }
}

DEV void phase_up(const P& p, int l, int g, char* smem) {
  char* ws = WSP(p.ws);
  const float* SSQ = (const float*)(ws + OFF_SSQ) + (size_t)l * 2 * 34816;
  const int tid = TID(), lane = tid & 63, w = tid >> 6, wr = w >> 1, wc = w & 1, lr = lane & 15, lg = lane >> 4;
  const int ntiles = 68 * 14;
  u16* Qb = (u16*)(ws + OFF_Q); u16* Kb = (u16*)(ws + OFF_K); u16* VT = (u16*)(ws + OFF_VT);
  bool pref = false;
  for (int t = BID(); t < ntiles; t += gridDim.x) {
    const int mt = t / 14, nt = t % 14;
    const int m0 = mt * 256;
    f32x4 acc[4][4]; zero_acc<4>(acc);
    const bool isq = nt < 6;
    const int nk = nt - 6;
    const bool vtile = !isq && nk >= 4;
    const u16* A = isq ? (const u16*)(ws + OFF_ZQ) + (size_t)m0 * 256 : (const u16*)(ws + OFF_ZKV) + (size_t)m0 * 128;
    const u16* B = isq ? (const u16*)(ws + OFF_WUQ) + (size_t)nt * 128 * 256 : (const u16*)(ws + OFF_WUKV) + (size_t)nk * 128 * 128;
    const int K = isq ? 256 : 128;
    const int t2 = t + gridDim.x; const bool hn = t2 < ntiles;
    const int mt2 = t2 / 14, nt2 = t2 % 14; const bool isq2 = nt2 < 6;
    const u16* A2 = isq2 ? (const u16*)(ws + OFF_ZQ) + (size_t)mt2 * 256 * 256 : (const u16*)(ws + OFF_ZKV) + (size_t)mt2 * 256 * 128;
    const u16* B2 = isq2 ? (const u16*)(ws + OFF_WUQ) + (size_t)nt2 * 128 * 256 : (const u16*)(ws + OFF_WUKV) + (size_t)(nt2 - 6) * 128 * 128;
    const int K2 = isq2 ? 256 : 128;
    const bool was = pref; pref = hn;
    if (!vtile) {
      gemm_core<true, 128>(acc, A, K, B, K, K, (u16*)smem, !was, hn ? A2 : nullptr, K2, B2, K2);
#pragma unroll
      for (int mi = 0; mi < 4; ++mi) {
        const int r = m0 + wr * 64 + mi * 16 + lr;
        int b, pp; rowinfo(r, b, pp);
        const int grow = (r < RL) ? g * RL + r : 32768 + g * RC + (r - RL);
        const float sc = isq ? rsqrtf(SSQ[grow] * (1.f / 256.f) + EPS) * (0.10206207261596577f * 1.4426950408889634f)
                             : rsqrtf(SSQ[34816 + grow] * (1.f / 128.f) + EPS);
#pragma unroll
        for (int ni = 0; ni < 4; ++ni) {
          f32x4 v = acc[mi][ni];
#pragma unroll
          for (int e = 0; e < 4; ++e) v[e] *= sc;
          if (!isq) {
            const int h = nk * 2 + wc, d = ni * 16 + lg * 4;
            *(uint2*)(Kb + ((size_t)(b * 8 + h) * PK + pp) * 96 + d) = pk4(v);
          } else if (nt < 4) {
            const int h = nt * 2 + wc, d = ni * 16 + lg * 4;
            *(uint2*)(Qb + ((size_t)(b * 8 + h) * PK + pp) * 96 + d) = pk4(v);
          } else {
            const int h = (nt - 4) * 4 + wc * 2 + (ni >> 1), rr = (ni & 1) * 16 + lg * 4;
            if (r < RL) { int s = r & (L - 1); rope4(v, (rr < 16) ? (s >> 6) : (s & 63), lg); }
            *(uint2*)(Qb + ((size_t)(b * 8 + h) * PK + pp) * 96 + 64 + rr) = pk4(v);
          }
        }
      }
    } else {
      gemm_core<false, 128>(acc, A, K, B, K, K, (u16*)smem, !was, hn ? A2 : nullptr, K2, B2, K2);
#pragma unroll
      for (int mi = 0; mi < 4; ++mi) {
        const int r = m0 + wr * 64 + mi * 16 + lg * 4;
        int b, pp; rowinfo(r, b, pp);
        const int grow = (r < RL) ? g * RL + r : 32768 + g * RC + (r - RL);
        float sc[4];
#pragma unroll
        for (int e = 0; e < 4; ++e) sc[e] = rsqrtf(SSQ[34816 + grow + e] * (1.f / 128.f) + EPS);
#pragma unroll
        for (int ni = 0; ni < 4; ++ni) {
          f32x4 v = acc[mi][ni];
#pragma unroll
          for (int e = 0; e < 4; ++e) v[e] *= sc[e];
          const int h = (nk - 4) * 2 + wc, d = ni * 16 + lr;
          *(uint2*)(VT + ((size_t)(b * 8 + h) * 64 + d) * PK + pp) = pk4(v);
        }
      }
    }
  }
}

DEV void attn_task(const P& p, int b, int h, int qb, bool isctx, char* smem) {
  char* ws = WSP(p.ws);
  const int tid = TID(), lane = tid & 63, w = tid >> 6, lr = lane & 15, lg = lane >> 4;
  const int p0 = isctx ? 0 : LC + qb * 256;
  const int nkeys = isctx ? LC : PK;
  const u16* Qb = (const u16*)(ws + OFF_Q) + ((size_t)(b * 8 + h) * PK) * 96;
  const u16* Kb = (const u16*)(ws + OFF_K) + ((size_t)(b * 8 + h) * PK) * 96;
  const u16* VT = (const u16*)(ws + OFF_VT) + ((size_t)(b * 8 + h) * 64) * PK;
  constexpr int KLD = 104, VLD = 136, KSZ = 128 * KLD, VSZ = 64 * VLD;
  u16* sK = (u16*)smem;
  u16* sV = sK + 2 * KSZ;
  bf16x8 qf[2][3];
#pragma unroll
  for (int qs = 0; qs < 2; ++qs)
#pragma unroll
    for (int ks = 0; ks < 3; ++ks)
      qf[qs][ks] = *(const bf16x8*)(Qb + (size_t)(p0 + w * 32 + qs * 16 + lr) * 96 + ks * 32 + lg * 8);
  f32x4 o[4][2];
#pragma unroll
  for (int i = 0; i < 4; ++i) { o[i][0] = f32x4{0, 0, 0, 0}; o[i][1] = f32x4{0, 0, 0, 0}; }
  float mrun[2] = {-1e30f, -1e30f}, lsum[2] = {0.f, 0.f};
  u32x4 rkA0, rkA1, rkA2, rvA0, rvA1, rkB0, rkB1, rkB2, rvB0, rvB1;
  const int kr0 = tid / 12, kc0 = tid % 12, kr1 = (tid + 512) / 12, kc1 = (tid + 512) % 12, kr2 = (tid + 1024) / 12, kc2 = (tid + 1024) % 12;
  const int vd0 = tid >> 4, vd1 = (tid + 512) >> 4, vc0 = tid & 15;
#define AGLD(S, j0) do { rk##S##0 = *(gu4*)(Kb + (size_t)((j0) + kr0) * 96 + kc0 * 8); rk##S##1 = *(gu4*)(Kb + (size_t)((j0) + kr1) * 96 + kc1 * 8); \
    rk##S##2 = *(gu4*)(Kb + (size_t)((j0) + kr2) * 96 + kc2 * 8); \
    rv##S##0 = *(gu4*)(VT + (size_t)vd0 * PK + (j0) + vc0 * 8); rv##S##1 = *(gu4*)(VT + (size_t)vd1 * PK + (j0) + vc0 * 8); } while (0)
#define ASST(S, st) do { *(u32x4*)(sK + (st) * KSZ + kr0 * KLD + kc0 * 8) = rk##S##0; *(u32x4*)(sK + (st) * KSZ + kr1 * KLD + kc1 * 8) = rk##S##1; \
    *(u32x4*)(sK + (st) * KSZ + kr2 * KLD + kc2 * 8) = rk##S##2; \
    *(u32x4*)(sV + (st) * VSZ + vd0 * VLD + vc0 * 8) = rv##S##0; *(u32x4*)(sV + (st) * VSZ + vd1 * VLD + vc0 * 8) = rv##S##1; } while (0)
#define SOFTMAX(S, QS, PF) do { \
      float mx = -1e30f; \
      _Pragma("unroll") for (int kk = 0; kk < 4; ++kk) \
        _Pragma("unroll") for (int e = 0; e < 4; ++e) mx = fmaxf(mx, S[kk][e]); \
      mx = fmaxf(mx, __shfl_xor(mx, 16)); mx = fmaxf(mx, __shfl_xor(mx, 32)); \
        \
      if (__builtin_amdgcn_ballot_w64(mx > mrun[QS] + 8.f) != 0ull) { \
        const float mn = fmaxf(mrun[QS], mx); \
        const float alpha = __builtin_amdgcn_exp2f(mrun[QS] - mn); \
        mrun[QS] = mn; \
        lsum[QS] *= alpha; \
        _Pragma("unroll") for (int ds = 0; ds < 4; ++ds) \
          _Pragma("unroll") for (int e = 0; e < 4; ++e) o[ds][QS][e] *= alpha; \
      } \
      const float mn = mrun[QS]; \
      float ps = 0.f; \
      _Pragma("unroll") for (int kk = 0; kk < 4; ++kk) \
        _Pragma("unroll") for (int e = 0; e < 4; ++e) { float pv = __builtin_amdgcn_exp2f(S[kk][e] - mn); S[kk][e] = pv; ps += pv; } \
      lsum[QS] += ps; \
      PF[0] = mk8(pk4(S[0]), pk4(S[1])); PF[1] = mk8(pk4(S[2]), pk4(S[3])); } while (0)
#define ATILE(st, hh) do { \
    const u16* k_s = sK + (st) * KSZ + (hh) * 64 * KLD; \
    const u16* v_s = sV + (st) * VSZ + (hh) * 64; \
    f32x4 s0[4], s1[4]; bf16x8 pf0[2], pf1[2]; \
      \
    _Pragma("unroll") for (int kk = 0; kk < 4; ++kk) { \
      s0[kk] = f32x4{0, 0, 0, 0}; \
      _Pragma("unroll") for (int ks = 0; ks < 3; ++ks) \
        s0[kk] = mfma(*(const bf16x8*)(k_s + (kk * 16 + lr) * KLD + ks * 32 + lg * 8), qf[0][ks], s0[kk]); \
    } \
      \
    _Pragma("unroll") for (int kk = 0; kk < 4; ++kk) { \
      s1[kk] = f32x4{0, 0, 0, 0}; \
      _Pragma("unroll") for (int ks = 0; ks < 3; ++ks) \
        s1[kk] = mfma(*(const bf16x8*)(k_s + (kk * 16 + lr) * KLD + ks * 32 + lg * 8), qf[1][ks], s1[kk]); \
    } \
    SOFTMAX(s0, 0, pf0); \
      \
    _Pragma("unroll") for (int k2i = 0; k2i < 2; ++k2i) \
      _Pragma("unroll") for (int ds = 0; ds < 4; ++ds) { \
        const u16* vp = v_s + (ds * 16 + lr) * VLD + k2i * 32 + lg * 4; \
        o[ds][0] = mfma(mk8(*(const uint2*)vp, *(const uint2*)(vp + 16)), pf0[k2i], o[ds][0]); \
      } \
    SOFTMAX(s1, 1, pf1); \
      \
    _Pragma("unroll") for (int k2i = 0; k2i < 2; ++k2i) \
      _Pragma("unroll") for (int ds = 0; ds < 4; ++ds) { \
        const u16* vp = v_s + (ds * 16 + lr) * VLD + k2i * 32 + lg * 4; \
        o[ds][1] = mfma(mk8(*(const uint2*)vp, *(const uint2*)(vp + 16)), pf1[k2i], o[ds][1]); \
      } } while (0)
  const int nt = nkeys >> 7;
  AGLD(B, 0);
  AGLD(A, 128);
  __syncthreads();
  ASST(B, 0);
  __syncthreads();
  for (int kt = 0; kt < nt; kt += 2) {
    if (kt + 2 < nt) AGLD(B, (kt + 2) * 128);
    __builtin_amdgcn_sched_barrier(0);
    ATILE(0, 0);
    ATILE(0, 1);
    __builtin_amdgcn_sched_barrier(0);
    ASST(A, 1);
    __syncthreads();
    if (kt + 3 < nt) AGLD(A, (kt + 3) * 128);
    __builtin_amdgcn_sched_barrier(0);
    ATILE(1, 0);
    ATILE(1, 1);
    __builtin_amdgcn_sched_barrier(0);
    if (kt + 2 < nt) ASST(B, 0);
    __syncthreads();
  }
#undef ATILE
#undef SOFTMAX
#undef AGLD
#undef ASST
  u16* Y = (u16*)(ws + OFF_YMLA);
#pragma unroll
  for (int qs = 0; qs < 2; ++qs) {
    float ls = lsum[qs];
    ls += __shfl_xor(ls, 16); ls += __shfl_xor(ls, 32);
    const float inv = 1.f / ls;
    const int pq = p0 + w * 32 + qs * 16 + lr;
    const int r = isctx ? RL + b * LC + pq : b * L + (pq - LC);
#pragma unroll
    for (int ds = 0; ds < 4; ++ds) {
      f32x4 v = o[ds][qs];
#pragma unroll
      for (int e = 0; e < 4; ++e) v[e] *= inv;
      *(uint2*)(Y + (size_t)r * 512 + h * 64 + ds * 16 + lg * 4) = pk4(v);
    }
  }
}

DEV void gla_task(const P& p, int l, int b, int h, int dir, char* smem) {
  char* ws = WSP(p.ws);
  const int tid = TID(), lane = tid & 63, w = tid >> 6, lr = lane & 15, lg = lane >> 4;
  const u16* GQ = (const u16*)(ws + OFF_GQ); const u16* GK = (const u16*)(ws + OFF_GK);
  const u16* GV = (const u16*)(ws + OFF_GV); const u16* MISC = (const u16*)(ws + OFF_MISC);
  u16* OUT = (u16*)(ws + (dir ? OFF_OB : OFF_OF));
  constexpr int LD = 72, TS = 64 * LD;
  u16* sQ = (u16*)smem; u16* sK = sQ + TS; u16* sKLT = sK + TS; u16* sAL = sKLT + TS; u16* sVT = sAL + TS;
  float* sAf = (float*)(sVT + 2 * TS);
  float* sTot = sAf + 64 * 16;
  float* sEG = sTot + 512;
  const int gk = tid & 63, part = tid >> 6;
  float wa[16];
  {
    const float* W = p.in[I_WA2] + ((size_t)(l * 2 + dir) * 16) * 256 + h * 64 + gk;
#pragma unroll
    for (int r = 0; r < 16; ++r) wa[r] = W[r * 256];
  }
  const float ba = p.in[I_BA][(l * 2 + dir) * 256 + h * 64 + gk];
  f32x4 S[4];
#pragma unroll
  for (int i = 0; i < 4; ++i) S[i] = f32x4{0, 0, 0, 0};
  u32x4 rq0, rk0, rv0, rv1, ra;
  const int si0 = tid >> 3, sch = tid & 7;
  const int vi0 = tid >> 4, vi1 = (tid + 512) >> 4, vch = tid & 15;
#define ROWOF(n, i) ((n) < 4 ? (RL + b * LC + (dir ? (LC - 1 - (64 * (n) + (i))) : (64 * (n) + (i)))) \
                             : (b * L + (dir ? (L - 1 - (64 * ((n) - 4) + (i))) : (64 * ((n) - 4) + (i)))))
#define GGLD(n) do { size_t _r0 = (size_t)ROWOF(n, si0); \
    rq0 = *(gu4*)(GQ + _r0 * 256 + h * 64 + sch * 8); rk0 = *(gu4*)(GK + _r0 * 256 + h * 64 + sch * 8); \
    rv0 = *(gu4*)(GV + (size_t)ROWOF(n, vi0) * 512 + h * 128 + vch * 8); rv1 = *(gu4*)(GV + (size_t)ROWOF(n, vi1) * 512 + h * 128 + vch * 8); \
    if (tid < 128) ra = *(gu4*)(MISC + (size_t)ROWOF(n, tid >> 1) * 64 + 32 + dir * 16 + (tid & 1) * 8); } while (0)
#define VTW(rv, i) do { sVT[(vch * 8 + 0) * LD + (i)] = (u16)((rv).x & 0xffff); sVT[(vch * 8 + 1) * LD + (i)] = (u16)((rv).x >> 16); \
    sVT[(vch * 8 + 2) * LD + (i)] = (u16)((rv).y & 0xffff); sVT[(vch * 8 + 3) * LD + (i)] = (u16)((rv).y >> 16); \
    sVT[(vch * 8 + 4) * LD + (i)] = (u16)((rv).z & 0xffff); sVT[(vch * 8 + 5) * LD + (i)] = (u16)((rv).z >> 16); \
    sVT[(vch * 8 + 6) * LD + (i)] = (u16)((rv).w & 0xffff); sVT[(vch * 8 + 7) * LD + (i)] = (u16)((rv).w >> 16); } while (0)
  ra = u32x4{0u, 0u, 0u, 0u};
  GGLD(0);
  for (int n = 0; n < 68; ++n) {
    __syncthreads();
    *(u32x4*)(sQ + si0 * LD + sch * 8) = rq0;
    *(u32x4*)(sK + si0 * LD + sch * 8) = rk0;
    VTW(rv0, vi0); VTW(rv1, vi1);
    if (tid < 128) {
      float* ap = sAf + (tid >> 1) * 16 + (tid & 1) * 8;
      ap[0] = bf2f((u16)(ra.x & 0xffff)); ap[1] = bf2f((u16)(ra.x >> 16)); ap[2] = bf2f((u16)(ra.y & 0xffff)); ap[3] = bf2f((u16)(ra.y >> 16));
      ap[4] = bf2f((u16)(ra.z & 0xffff)); ap[5] = bf2f((u16)(ra.z >> 16)); ap[6] = bf2f((u16)(ra.w & 0xffff)); ap[7] = bf2f((u16)(ra.w >> 16));
    }
    __syncthreads();
    if (n + 1 < 68) GGLD(n + 1);
    __builtin_amdgcn_sched_barrier(0);
    float pre[8]; float run = 0.f;
#pragma unroll
    for (int ii = 0; ii < 8; ++ii) {
      const int i = part * 8 + ii;
      float x = ba;
#pragma unroll
      for (int r = 0; r < 16; ++r) x += sAf[i * 16 + r] * wa[r];
      float ls = fminf(x, 0.f) * 1.4426950408889634f - __builtin_amdgcn_logf(1.f + __builtin_amdgcn_exp2f(-fabsf(x) * 1.4426950408889634f));
      run += ls * (1.f / 16.f);
      pre[ii] = run;
    }
    sTot[part * 64 + gk] = run;
    __syncthreads();
    float off = 0.f, glast = 0.f;
#pragma unroll
    for (int q = 0; q < 8; ++q) { float tv = sTot[q * 64 + gk]; glast += tv; if (q < part) off += tv; }
    const float eglast = __builtin_amdgcn_exp2f(glast);
    if (part == 0) sEG[gk] = eglast;
    {
      float klt[8];
#pragma unroll
      for (int ii = 0; ii < 8; ++ii) {
        const int i = part * 8 + ii;
        const float G = off + pre[ii];
        float qv = bf2f(sQ[i * LD + gk]), kv = bf2f(sK[i * LD + gk]);
        const float eg = __builtin_amdgcn_exp2f(G), egi = __builtin_amdgcn_exp2f(-G);
        sQ[i * LD + gk] = f2bf(qv * 0.125f * eg);
        sK[i * LD + gk] = f2bf(kv * egi);
        klt[ii] = kv * (eglast * egi);
      }
      *(uint4*)(sKLT + gk * LD + part * 8) = make_uint4(pk2(klt[0], klt[1]), pk2(klt[2], klt[3]), pk2(klt[4], klt[5]), pk2(klt[6], klt[7]));
    }
    __syncthreads();
    {
      const int it = w & 3, jt0 = (w >> 2) * 2;
      bf16x8 qb[2];
#pragma unroll
      for (int m = 0; m < 2; ++m) qb[m] = *(const bf16x8*)(sQ + (it * 16 + lr) * LD + m * 32 + lg * 8);
      const int i = it * 16 + lr;
#pragma unroll
      for (int jj = 0; jj < 2; ++jj) {
        const int jt = jt0 + jj;
        f32x4 c = f32x4{0, 0, 0, 0};
#pragma unroll
        for (int m = 0; m < 2; ++m) c = mfma(*(const bf16x8*)(sK + (jt * 16 + lr) * LD + m * 32 + lg * 8), qb[m], c);
#pragma unroll
        for (int e = 0; e < 4; ++e) { int j = jt * 16 + lg * 4 + e; if (j > i) c[e] = 0.f; }
        *(uint2*)(sAL + i * LD + jt * 16 + lg * 4) = pk4(c);
      }
    }
    __syncthreads();
    {
      bf16x8 sa[2];
#pragma unroll
      for (int m = 0; m < 2; ++m) sa[m] = mk8(pk4(S[2 * m]), pk4(S[2 * m + 1]));
      bf16x8 vtf[2];
#pragma unroll
      for (int m = 0; m < 2; ++m) vtf[m] = *(const bf16x8*)(sVT + (w * 16 + lr) * LD + m * 32 + lg * 8);
      const bool store = (n >= 4) || (l == 0);
#pragma unroll
      for (int it = 0; it < 4; ++it) {
        f32x4 oc = f32x4{0, 0, 0, 0};
#pragma unroll
        for (int m = 0; m < 2; ++m) {
          const u16* qp = sQ + (it * 16 + lr) * LD + m * 32 + lg * 4;
          oc = mfma(sa[m], mk8(*(const uint2*)qp, *(const uint2*)(qp + 16)), oc);
          oc = mfma(vtf[m], *(const bf16x8*)(sAL + (it * 16 + lr) * LD + m * 32 + lg * 8), oc);
        }
        if (store) {
          size_t row = (size_t)ROWOF(n, it * 16 + lr);
          *(uint2*)(OUT + row * 512 + h * 128 + w * 16 + lg * 4) = pk4(oc);
        }
      }
#pragma unroll
      for (int kt = 0; kt < 4; ++kt) {
        f32x4 eg = *(const f32x4*)(sEG + kt * 16 + lg * 4);
        f32x4 c;
#pragma unroll
        for (int e = 0; e < 4; ++e) c[e] = S[kt][e] * eg[e];
#pragma unroll
        for (int m = 0; m < 2; ++m) c = mfma(*(const bf16x8*)(sKLT + (kt * 16 + lr) * LD + m * 32 + lg * 8), vtf[m], c);
        S[kt] = c;
      }
    }
  }
}
#undef ROWOF
#undef GGLD
#undef VTW
struct F8 { float v[8]; };
DEV F8 sconv8(const u16* row, int t0, float w0, float w1, float w2, float bb) {
  const u32x4 q = *(gu4*)(row + t0);
  const float lo = (t0 > 0) ? bf2f(row[t0 - 1]) : 0.f;
  const float hi = (t0 + 8 < L) ? bf2f(row[t0 + 8]) : 0.f;
  float u[10];
  u[0] = lo; u[9] = hi;
  u[1] = bf2f((u16)(q.x & 0xffff)); u[2] = bf2f((u16)(q.x >> 16)); u[3] = bf2f((u16)(q.y & 0xffff)); u[4] = bf2f((u16)(q.y >> 16));
  u[5] = bf2f((u16)(q.z & 0xffff)); u[6] = bf2f((u16)(q.z >> 16)); u[7] = bf2f((u16)(q.w & 0xffff)); u[8] = bf2f((u16)(q.w >> 16));
  F8 r;
#pragma unroll
  for (int j = 0; j < 8; ++j) r.v[j] = bb + w0 * u[j] + w1 * u[j + 1] + w2 * u[j + 2];
  return r;
}
DEV F8 ld8bf(const u16* row, int t0) {
  const u32x4 q = *(gu4*)(row + t0);
  F8 r;
  r.v[0] = bf2f((u16)(q.x & 0xffff)); r.v[1] = bf2f((u16)(q.x >> 16)); r.v[2] = bf2f((u16)(q.y & 0xffff)); r.v[3] = bf2f((u16)(q.y >> 16));
  r.v[4] = bf2f((u16)(q.z & 0xffff)); r.v[5] = bf2f((u16)(q.z >> 16)); r.v[6] = bf2f((u16)(q.w & 0xffff)); r.v[7] = bf2f((u16)(q.w >> 16));
  return r;
}
DEV void st8bf(u16* row, int t0, const F8& a) {
  *(uint4*)(row + t0) = make_uint4(pk2(a.v[0], a.v[1]), pk2(a.v[2], a.v[3]), pk2(a.v[4], a.v[5]), pk2(a.v[6], a.v[7]));
}
DEV void spec_mul(float2* buf, const float2* KSr) {
  const int tid = TID();
  float2 kv[8];
#pragma unroll
  for (int m = 0; m < 8; ++m) kv[m] = KSr[tid + NTH * m];
  const float2 klast = KSr[4096];
#pragma unroll
  for (int m = 0; m < 8; ++m) {
    const int f = tid + NTH * m;
    const int i1 = PADI(brev13(f));
    const float2 z = buf[i1];
    buf[i1] = make_float2(z.x * kv[m].x - z.y * kv[m].y, z.x * kv[m].y + z.y * kv[m].x);
    if (f != 0) {
      const int i2 = PADI(brev13(8192 - f));
      const float2 z2 = buf[i2];
      buf[i2] = make_float2(z2.x * kv[m].x + z2.y * kv[m].y, -z2.x * kv[m].y + z2.y * kv[m].x);
    }
  }
  if (tid == 0) {
    const int i1 = PADI(brev13(4096));
    const float2 z = buf[i1];
    buf[i1] = make_float2(z.x * klast.x - z.y * klast.y, z.x * klast.y + z.y * klast.x);
  }
  __syncthreads();
}
DEV void hyena_task(const P& p, int l, int c, int pr, char* smem) {
  char* ws = WSP(p.ws);
  float2* buf = (float2*)smem;
  const int tid = TID(), t0 = tid * 8;
  u16* HYT = (u16*)(ws + OFF_HYT);
  const float2* KS0 = (const float2*)(ws + OFF_KS) + (size_t)(0 * 512 + c) * KSLD;
  const float2* KS1 = (const float2*)(ws + OFF_KS) + (size_t)(1 * 512 + c) * KSLD;
  const float* sw = p.in[I_HSW] + (size_t)l * 3 * 1536; const float* sb = p.in[I_HSB] + l * 1536;
  const float wx1[4] = {sw[c], sw[1536 + c], sw[3072 + c], sb[c]};
  const float wx2[4] = {sw[512 + c], sw[1536 + 512 + c], sw[3072 + 512 + c], sb[512 + c]};
  const float wv[4] = {sw[1024 + c], sw[1536 + 1024 + c], sw[3072 + 1024 + c], sb[1024 + c]};
  const float bias0 = p.in[I_HYB][(l * 2 + 0) * 512 + c], bias1 = p.in[I_HYB][(l * 2 + 1) * 512 + c];
  {
    const int b0 = 2 * pr, b1 = 2 * pr + 1;
    const u16* x1r0 = HYT + ((size_t)(b0 * 2048 + c)) * L; const u16* x1r1 = HYT + ((size_t)(b1 * 2048 + c)) * L;
    const u16* x2r0 = x1r0 + (size_t)512 * L; const u16* x2r1 = x1r1 + (size_t)512 * L;
    const u16* vr0 = x1r0 + (size_t)1024 * L; const u16* vr1 = x1r1 + (size_t)1024 * L;
    u16* st0 = (u16*)(ws + OFF_YHY) + ((size_t)(b0 * 512 + c)) * L; u16* st1 = (u16*)(ws + OFF_YHY) + ((size_t)(b1 * 512 + c)) * L;
    __syncthreads();
    {
      const F8 va = sconv8(vr0, t0, wv[0], wv[1], wv[2], wv[3]), vb = sconv8(vr1, t0, wv[0], wv[1], wv[2], wv[3]);
#pragma unroll
      for (int j = 0; j < 8; ++j) buf[PADI(t0 + j)] = make_float2(va.v[j], vb.v[j]);
    }
    __syncthreads();
    fft_fwd<true>(buf);
    spec_mul(buf, KS0);
    fft_inv<true>(buf);
    {
      const F8 va = sconv8(vr0, t0, wv[0], wv[1], wv[2], wv[3]), vb = sconv8(vr1, t0, wv[0], wv[1], wv[2], wv[3]);
      const F8 ga = sconv8(x1r0, t0, wx1[0], wx1[1], wx1[2], wx1[3]), gb = sconv8(x1r1, t0, wx1[0], wx1[1], wx1[2], wx1[3]);
      F8 ya, yb;
#pragma unroll
      for (int j = 0; j < 8; ++j) {
        const float2 cv = buf[PADI(t0 + j)];
        ya.v[j] = ga.v[j] * (cv.x + bias0 * va.v[j]); yb.v[j] = gb.v[j] * (cv.y + bias0 * vb.v[j]);
        buf[PADI(t0 + j)] = make_float2(ya.v[j], yb.v[j]);
      }
      st8bf(st0, t0, ya); st8bf(st1, t0, yb);
    }
    __syncthreads();
    fft_fwd<true>(buf);
    spec_mul(buf, KS1);
    fft_inv<true>(buf);
    {
      u16* o0 = HYT + ((size_t)(b0 * 2048 + 1536 + c)) * L; u16* o1 = HYT + ((size_t)(b1 * 2048 + 1536 + c)) * L;
      const F8 ga = sconv8(x2r0, t0, wx2[0], wx2[1], wx2[2], wx2[3]), gb = sconv8(x2r1, t0, wx2[0], wx2[1], wx2[2], wx2[3]);
      const F8 sa = ld8bf(st0, t0), sbb = ld8bf(st1, t0);
      F8 oa, ob;
#pragma unroll
      for (int j = 0; j < 8; ++j) {
        const float2 cv = buf[PADI(t0 + j)];
        oa.v[j] = ga.v[j] * (cv.x + bias1 * sa.v[j]); ob.v[j] = gb.v[j] * (cv.y + bias1 * sbb.v[j]);
      }
      st8bf(o0, t0, oa); st8bf(o1, t0, ob);
    }
  }
  __syncthreads();
}

DEV void hyena_ctx_task(const P& p, int c, char* smem) {
  char* ws = WSP(p.ws);
  float* hf0 = (float*)smem; float* hb0 = hf0 + 256; float* hf1 = hb0 + 256; float* hb1 = hf1 + 256;
  float* sv = hb1 + 256;
  float* sy1 = sv + 512;
  const int tid = TID(), t = tid & 255, bs = tid >> 8;
  const float* KFC = (const float*)(ws + OFF_KFC);
  const float* NRM = (const float*)(ws + OFF_NORMC);
  const float in0 = 1.f / NRM[c], in1 = 1.f / NRM[512 + c];
  __syncthreads();
  if (bs == 0) {
    hf0[t] = KFC[((size_t)(0 * 2 + 0) * 512 + c) * LC + t] * in0; hb0[t] = KFC[((size_t)(0 * 2 + 1) * 512 + c) * LC + t] * in0;
    hf1[t] = KFC[((size_t)(1 * 2 + 0) * 512 + c) * LC + t] * in1; hb1[t] = KFC[((size_t)(1 * 2 + 1) * 512 + c) * LC + t] * in1;
  }
  const float* sw = p.in[I_HSW]; const float* sb = p.in[I_HSB];
  const float bias0 = p.in[I_HYB][c], bias1 = p.in[I_HYB][512 + c];
  const u16* HYC = (const u16*)(ws + OFF_HYC);
  u16* YHY = (u16*)(ws + OFF_YHY);
  for (int bi = 0; bi < NB / 2; ++bi) {
    const int b = bi * 2 + bs;
    const u16* base = HYC + (size_t)(b * LC) * 1536;
    float u[3];
#pragma unroll
    for (int k = 0; k < 3; ++k) {
      int ch = k * 512 + c;
      float cc = bf2f(base[(size_t)t * 1536 + ch]);
      float a = (t > 0) ? bf2f(base[(size_t)(t - 1) * 1536 + ch]) : 0.f;
      float d = (t < LC - 1) ? bf2f(base[(size_t)(t + 1) * 1536 + ch]) : 0.f;
      u[k] = sb[ch] + sw[ch] * a + sw[1536 + ch] * cc + sw[3072 + ch] * d;
    }
    __syncthreads();
    sv[bs * 256 + t] = u[2];
    __syncthreads();
    float a0 = 0.f;
    for (int s = 0; s < LC; ++s) a0 += ((s <= t) ? hf0[t - s] : hb0[s - t]) * sv[bs * 256 + s];
    const float y1 = u[0] * (a0 + bias0 * u[2]);
    sy1[bs * 256 + t] = y1;
    __syncthreads();
    float a1 = 0.f;
    for (int s = 0; s < LC; ++s) a1 += ((s <= t) ? hf1[t - s] : hb1[s - t]) * sy1[bs * 256 + s];
    const float y2 = u[1] * (a1 + bias1 * y1);
    YHY[(size_t)(RL + b * LC + t) * 512 + c] = f2bf(y2);
  }
  __syncthreads();
}

DEV void phase_mix(const P& p, int l, int g, char* smem, int rep = 0) {
  unsigned* cnt = (unsigned*)(p.ws + OFF_CNT) + (rep * 4 + l * 2 + g);
  volatile int* s_taskp = (volatile int*)(smem + SMEM_BYTES + 16);
  const int n_gla = 32, n_hy = 1024, n_hyc = (l == 0) ? 512 : 0, n_at = 512, n_atc = (l == 0) ? 32 : 0;
  const int total = n_gla + n_hy + n_hyc + n_at + n_atc;
  fft_build_tw(smem);
  for (;;) {
    __syncthreads();
    if (TID() == 0) *s_taskp = (int)atomicAdd(cnt, 1u);
    __syncthreads();
    int t = *s_taskp;
    if (t >= total) break;
    if (t < n_gla) { gla_task(p, l, t >> 3, (t >> 1) & 3, t & 1, smem); continue; }
    t -= n_gla;
    if (t < n_at) { attn_task(p, t >> 7, (t >> 4) & 7, t & 15, false, smem); continue; }
    t -= n_at;
    if (t < n_hy) { hyena_task(p, l, t >> 1, t & 1, smem); continue; }
    t -= n_hy;
    if (t < n_atc) { attn_task(p, t >> 3, t & 7, 0, true, smem); continue; }
    t -= n_atc;
    hyena_ctx_task(p, t, smem);
  }
}

DEV void phase_post(const P& p, int l, int g, char* smem) {
  char* ws = WSP(p.ws);
  const int tid = TID();
  {
    u16* tile = (u16*)smem;
    const u16* HYT = (const u16*)(ws + OFF_HYT); u16* YHY = (u16*)(ws + OFF_YHY);
    u32x4 q0, q1;
    const int ecc0 = tid >> 4, ecc1 = (tid + NTH) >> 4, ech = tid & 15;
#define TLOAD(itx) do { const int _b = (itx) >> 8, _ct = ((itx) >> 5) & 7, _tt = (itx) & 31; \
      q0 = *(gu4*)(HYT + ((size_t)(_b * 2048 + 1536 + _ct * 64 + ecc0)) * L + _tt * 128 + ech * 8); \
      q1 = *(gu4*)(HYT + ((size_t)(_b * 2048 + 1536 + _ct * 64 + ecc1)) * L + _tt * 128 + ech * 8); } while (0)
    int it = BID();
    if (it < NB * 8 * 32) TLOAD(it);
    while (it < NB * 8 * 32) {
      const int b = it >> 8, ct = (it >> 5) & 7, tt = it & 31;
      __syncthreads();
      { unsigned* d0 = (unsigned*)(tile + ecc0 * 130 + ech * 8); d0[0] = q0.x; d0[1] = q0.y; d0[2] = q0.z; d0[3] = q0.w;
        unsigned* d1 = (unsigned*)(tile + ecc1 * 130 + ech * 8); d1[0] = q1.x; d1[1] = q1.y; d1[2] = q1.z; d1[3] = q1.w; }
      __syncthreads();
      const int itn = it + gridDim.x;
      if (itn < NB * 8 * 32) TLOAD(itn);
#pragma unroll
      for (int u = 0; u < 2; ++u) { const int e = tid + NTH * u, t2 = e >> 3, c8 = (e & 7) * 8;
        unsigned w0 = (unsigned)tile[(c8 + 0) * 130 + t2] | ((unsigned)tile[(c8 + 1) * 130 + t2] << 16);
        unsigned w1 = (unsigned)tile[(c8 + 2) * 130 + t2] | ((unsigned)tile[(c8 + 3) * 130 + t2] << 16);
        unsigned w2 = (unsigned)tile[(c8 + 4) * 130 + t2] | ((unsigned)tile[(c8 + 5) * 130 + t2] << 16);
        unsigned w3 = (unsigned)tile[(c8 + 6) * 130 + t2] | ((unsigned)tile[(c8 + 7) * 130 + t2] << 16);
        *(uint4*)(YHY + (size_t)(b * L + tt * 128 + t2) * 512 + ct * 64 + c8) = make_uint4(w0, w1, w2, w3); }
      it = itn;
    }
#undef TLOAD
  }
  {
    const int nrows = (l == 0) ? RG : RL;
    const int gw = BID() * 8 + (tid >> 6), NW = gridDim.x * 8, lane = tid & 63;
    u16* OF = (u16*)(ws + OFF_OF); const u16* OB = (const u16*)(ws + OFF_OB); const u16* GR = (const u16*)(ws + OFF_GR);
    const float* gn = p.in[I_GONORM] + l * 128;
    for (int r0 = gw; r0 < nrows; r0 += 2 * NW) {
      const int r1 = (r0 + NW < nrows) ? r0 + NW : r0;
      uint4 A0 = *(const uint4*)(OF + (size_t)r0 * 512 + lane * 8), B0 = *(const uint4*)(OB + (size_t)r0 * 512 + lane * 8), R0 = *(const uint4*)(GR + (size_t)r0 * 512 + lane * 8);
      uint4 A1 = *(const uint4*)(OF + (size_t)r1 * 512 + lane * 8), B1 = *(const uint4*)(OB + (size_t)r1 * 512 + lane * 8), R1 = *(const uint4*)(GR + (size_t)r1 * 512 + lane * 8);
      const int v0 = (lane & 15) * 8;
#pragma unroll
      for (int k = 0; k < 2; ++k) {
        const uint4 a = k ? A1 : A0, bb = k ? B1 : B0, rr = k ? R1 : R0;
        unsigned av[4] = {a.x, a.y, a.z, a.w}, bv[4] = {bb.x, bb.y, bb.z, bb.w}, rv[4] = {rr.x, rr.y, rr.z, rr.w};
        float o[8]; float ss = 0.f;
#pragma unroll
        for (int e = 0; e < 4; ++e) {
          o[2 * e] = bf2f((u16)(av[e] & 0xffff)) + bf2f((u16)(bv[e] & 0xffff));
          o[2 * e + 1] = bf2f((u16)(av[e] >> 16)) + bf2f((u16)(bv[e] >> 16));
          ss += o[2 * e] * o[2 * e] + o[2 * e + 1] * o[2 * e + 1];
        }
        ss += __shfl_xor(ss, 1); ss += __shfl_xor(ss, 2); ss += __shfl_xor(ss, 4); ss += __shfl_xor(ss, 8);
        const float rstd = rsqrtf(ss * (1.f / 128.f) + EPS);
        float y[8];
#pragma unroll
        for (int e = 0; e < 4; ++e) {
          float q0 = bf2f((u16)(rv[e] & 0xffff)), q1 = bf2f((u16)(rv[e] >> 16));
          y[2 * e] = o[2 * e] * rstd * gn[v0 + 2 * e] * (q0 * sigmoidf(q0));
          y[2 * e + 1] = o[2 * e + 1] * rstd * gn[v0 + 2 * e + 1] * (q1 * sigmoidf(q1));
        }
        if (k == 0 || r1 != r0)
          *(uint4*)(OF + (size_t)(k ? r1 : r0) * 512 + lane * 8) = make_uint4(pk2(y[0], y[1]), pk2(y[2], y[3]), pk2(y[4], y[5]), pk2(y[6], y[7]));
      }
    }
  }
}

DEV bool tile_swz8(int i, int MT, int& mt, int& nt) {
  if (gridDim.x != 256) { int t = BID() + i * gridDim.x; mt = t >> 3; nt = t & 7; return t < MT * 8; }
  const int b = BID(), x = b & 7, j = b >> 3, tl = i * 32 + j;
  nt = tl & 7; mt = (tl >> 3) * 8 + x;
  return mt < MT;
}
DEV int tile_swz8_rounds(int MT) { return (gridDim.x != 256) ? (MT * 8 + gridDim.x - 1) / gridDim.x : (((MT + 7) >> 3) * 8 + 31) / 32; }

DEV void phase_merge(const P& p, int l, int g, char* smem) {
  char* ws = WSP(p.ws);
  const int tid = TID(), lane = tid & 63, w = tid >> 6, wr = w >> 1, wc = w & 1, lr = lane & 15, lg = lane >> 4;
  const int MT = (l == 0) ? 68 : 64;
  const u16* GATES = (const u16*)(ws + OFF_GATES);
  u16* M = (u16*)(ws + OFF_HX);
  const int nrounds = tile_swz8_rounds(MT);
  bool first = true;
  for (int it = 0; it < nrounds; ++it) {
    int mt, nt;
    if (!tile_swz8(it, MT, mt, nt)) continue;
    const int m0 = mt * 256, n0 = nt * 128;
    int mt2 = 0, nt2 = 0; bool hn = false;
    for (int i2 = it + 1; i2 < nrounds && !hn; ++i2) hn = tile_swz8(i2, MT, mt2, nt2);
    f32x4 macc[4][4]; zero_acc<4>(macc);
#pragma unroll 1
    for (int br = 0; br < 3; ++br) {
      const u16* Y = (const u16*)(ws + (br == 0 ? OFF_YMLA : (br == 1 ? OFF_OF : OFF_YHY)));
      const u16* W = (const u16*)(ws + (br == 0 ? OFF_WOM : (br == 1 ? OFF_WOG : OFF_WOH)));
      const int nb = (br + 1) % 3;
      const u16* Y2 = (const u16*)(ws + (nb == 0 ? OFF_YMLA : (nb == 1 ? OFF_OF : OFF_YHY)));
      const u16* W2 = (const u16*)(ws + (nb == 0 ? OFF_WOM : (nb == 1 ? OFF_WOG : OFF_WOH)));
      const bool hn2 = (br < 2) || hn;
      const int m2 = (br < 2) ? m0 : mt2 * 256, n2 = (br < 2) ? n0 : nt2 * 128;
      f32x4 acc[4][4]; zero_acc<4>(acc);
      gemm_core<true, 128, true>(acc, Y + (size_t)m0 * 512, 512, W + (size_t)n0 * 512, 512, 512, (u16*)smem, first,
                                 hn2 ? Y2 + (size_t)m2 * 512 : nullptr, 512, W2 + (size_t)n2 * 512, 512);
      first = false;
#pragma unroll
      for (int mi = 0; mi < 4; ++mi) {
        const int r = m0 + wr * 64 + mi * 16 + lr;
#pragma unroll
        for (int np = 0; np < 2; ++np) {
          const uint4 gg = *(const uint4*)(GATES + (size_t)r * 3072 + br * 1024 + n0 + wc * 64 + np * 32 + lg * 8);
          macc[mi][2 * np][0] += acc[mi][2 * np][0] * bf2f((u16)(gg.x & 0xffff));
          macc[mi][2 * np][1] += acc[mi][2 * np][1] * bf2f((u16)(gg.x >> 16));
          macc[mi][2 * np][2] += acc[mi][2 * np][2] * bf2f((u16)(gg.y & 0xffff));
          macc[mi][2 * np][3] += acc[mi][2 * np][3] * bf2f((u16)(gg.y >> 16));
          macc[mi][2 * np + 1][0] += acc[mi][2 * np + 1][0] * bf2f((u16)(gg.z & 0xffff));
          macc[mi][2 * np + 1][1] += acc[mi][2 * np + 1][1] * bf2f((u16)(gg.z >> 16));
          macc[mi][2 * np + 1][2] += acc[mi][2 * np + 1][2] * bf2f((u16)(gg.w & 0xffff));
          macc[mi][2 * np + 1][3] += acc[mi][2 * np + 1][3] * bf2f((u16)(gg.w >> 16));
        }
      }
    }
#pragma unroll
    for (int mi = 0; mi < 4; ++mi) {
      const int r = m0 + wr * 64 + mi * 16 + lr;
#pragma unroll
      for (int np = 0; np < 2; ++np) {
        const uint2 lo = pk4(macc[mi][2 * np]), hi = pk4(macc[mi][2 * np + 1]);
        *(uint4*)(M + (size_t)r * D + n0 + wc * 64 + np * 32 + lg * 8) = make_uint4(lo.x, lo.y, hi.x, hi.y);
      }
    }
  }
}

DEV void xs_ptrs(const P& p, int l, int g, const float*& srcl, const float*& srcc, float*& dstl, float*& dstc, bool first) {
  dstl = p.out + (size_t)g * RL * D;
  dstc = (float*)(p.ws + OFF_CTXS) + (size_t)g * RC * D;
  if (first && l == 0) { srcl = p.in[I_X] + (size_t)g * RL * D; srcc = p.in[I_CTX] + (size_t)g * RC * D; }
  else { srcl = dstl; srcc = dstc; }
}
DEV void phase_resid(const P& p, int l, int g, char* smem, bool isout) {
  char* ws = WSP(p.ws);
  const int tid = TID(), lane = tid & 63, w = tid >> 6, wr = w >> 1, wc = w & 1, lr = lane & 15, lg = lane >> 4;
  const int MT = (l == 0) ? 68 : 64;
  const float *srcl, *srcc; float *dstl, *dstc;
  xs_ptrs(p, l, g, srcl, srcc, dstl, dstc, isout);
  const u16* A = (const u16*)(ws + (isout ? OFF_HX : OFF_H));
  const u16* W = (const u16*)(ws + (isout ? OFF_WOUT : OFF_W2));
  const int K = isout ? 1024 : 4096;
  const float* MOD = (const float*)(ws + OFF_MOD) + (size_t)l * 9 * 6144;
  const int goff = isout ? 2048 : 5120;
  const int nrounds = tile_swz8_rounds(MT);
  bool first = true;
  for (int it = 0; it < nrounds; ++it) {
    int mt, nt;
    if (!tile_swz8(it, MT, mt, nt)) continue;
    const int m0 = mt * 256, n0 = nt * 128;
    int mt2 = 0, nt2 = 0; bool hn = false;
    for (int i2 = it + 1; i2 < nrounds && !hn; ++i2) hn = tile_swz8(i2, MT, mt2, nt2);
    f32x4 acc[4][4]; zero_acc<4>(acc);
    gemm_core<true, 128>(acc, A + (size_t)m0 * K, K, W + (size_t)n0 * K, K, K, (u16*)smem, first,
                         hn ? A + (size_t)mt2 * 256 * K : nullptr, K, W + (size_t)nt2 * 128 * K, K);
    first = false;
    const float* gate = MOD + (size_t)((m0 < RL) ? (g * NB + (m0 >> 12)) : 8) * 6144 + goff + n0 + wc * 64 + lg * 4;
    f32x4 gv[4];
#pragma unroll
    for (int ni = 0; ni < 4; ++ni) gv[ni] = *(const f32x4*)(gate + ni * 16);
    f32x4 xv[4][4];
#pragma unroll
    for (int mi = 0; mi < 4; ++mi) {
      const int r = m0 + wr * 64 + mi * 16 + lr;
      const float* src = (r < RL) ? srcl + (size_t)r * D : srcc + (size_t)(r - RL) * D;
#pragma unroll
      for (int ni = 0; ni < 4; ++ni) xv[mi][ni] = *(const f32x4*)(src + n0 + wc * 64 + ni * 16 + lg * 4);
    }
#pragma unroll
    for (int mi = 0; mi < 4; ++mi) {
      const int r = m0 + wr * 64 + mi * 16 + lr;
      float* dst = (r < RL) ? dstl + (size_t)r * D : dstc + (size_t)(r - RL) * D;
#pragma unroll
      for (int ni = 0; ni < 4; ++ni) {
        f32x4 y;
#pragma unroll
        for (int e = 0; e < 4; ++e) y[e] = xv[mi][ni][e] + gv[ni][e] * acc[mi][ni][e];
        *(f32x4*)(dst + n0 + wc * 64 + ni * 16 + lg * 4) = y;
      }
    }
  }
}
DEV void phase_mlp1(const P& p, int l, int g, char* smem) {
  char* ws = WSP(p.ws);
  const int tid = TID(), lane = tid & 63, w = tid >> 6, wr = w >> 2, wc = w & 3, lr = lane & 15, lg = lane >> 4;
  const int MT = (l == 0) ? 68 : 64, ntiles = MT * 16;
  const u16* A = (const u16*)(ws + OFF_HX); const u16* W = (const u16*)(ws + OFF_W1); u16* H = (u16*)(ws + OFF_H);
  for (int t = BID(); t < ntiles; t += gridDim.x) {
    const int mt = t >> 4, nt = t & 15, m0 = mt * 256, n0 = nt * 256;
    const int t2 = t + gridDim.x; const bool hn = t2 < ntiles;
    f32x4 acc[8][4]; zero_acc<8>(acc);
    gemm_core<true, 256, true>(acc, A + (size_t)m0 * D, D, W + (size_t)n0 * D, D, D, (u16*)smem, t == BID(),
                               hn ? A + (size_t)(t2 >> 4) * 256 * D : nullptr, D, W + (size_t)(t2 & 15) * 256 * D, D);
#pragma unroll
    for (int mi = 0; mi < 8; ++mi) {
      const int r = m0 + wr * 128 + mi * 16 + lr;
#pragma unroll
      for (int np = 0; np < 2; ++np) {
        f32x4 v = acc[mi][2 * np], v2 = acc[mi][2 * np + 1];
#pragma unroll
        for (int e = 0; e < 4; ++e) { float x = fmaxf(v[e], 0.f); v[e] = x * x; float y = fmaxf(v2[e], 0.f); v2[e] = y * y; }
        const uint2 lo = pk4(v), hi = pk4(v2);
        *(uint4*)(H + (size_t)r * DFF + n0 + wc * 64 + np * 32 + lg * 8) = make_uint4(lo.x, lo.y, hi.x, hi.y);
      }
    }
  }
}

DEV void phase_final(const P& p) {
  const int gw = BID() * 8 + (TID() >> 6), NW = gridDim.x * 8, lane = TID() & 63;
  const float* gain = p.in[I_FNG];
  f32x4 gg[4];
#pragma unroll
  for (int j = 0; j < 4; ++j) gg[j] = *(const f32x4*)(gain + j * 256 + lane * 4);
  for (int r = gw; r < 32768; r += 2 * NW) {
    float* s0 = p.out + (size_t)r * D; float* s1 = p.out + (size_t)(r + NW) * D;
    f32x4 a[4], b[4]; float sa = 0.f, sb = 0.f;
#pragma unroll
    for (int j = 0; j < 4; ++j) { a[j] = *(const f32x4*)(s0 + j * 256 + lane * 4); b[j] = *(const f32x4*)(s1 + j * 256 + lane * 4); }
#pragma unroll
    for (int j = 0; j < 4; ++j) {
      sa += a[j][0] * a[j][0] + a[j][1] * a[j][1] + a[j][2] * a[j][2] + a[j][3] * a[j][3];
      sb += b[j][0] * b[j][0] + b[j][1] * b[j][1] + b[j][2] * b[j][2] + b[j][3] * b[j][3];
    }
    const float ra = rsqrtf(wave_sum(sa) * (1.f / D) + EPS), rb = rsqrtf(wave_sum(sb) * (1.f / D) + EPS);
#pragma unroll
    for (int j = 0; j < 4; ++j) {
      f32x4 ya, yb;
#pragma unroll
      for (int e = 0; e < 4; ++e) { ya[e] = a[j][e] * ra * gg[j][e]; yb[e] = b[j][e] * rb * gg[j][e]; }
      *(f32x4*)(s0 + j * 256 + lane * 4) = ya;
      *(f32x4*)(s1 + j * 256 + lane * 4) = yb;
    }
  }
}

#define XB_TMO      128
#define XB_XCNT(j)  (256  + 64 * (j))
#define XB_XSUB(j)  (1280 + 64 * (j))
#define XB_XGEN(j)  (2304 + 64 * (j))
#define XB_TOP      3328
#define XB_TOPGEN   3392
#define XCD_BAR_WORDS 3456
#define XB_SPIN_CAP (1u << 22)
DEV unsigned xb_ld(unsigned* p) { return __hip_atomic_load(p, __ATOMIC_RELAXED, __HIP_MEMORY_SCOPE_AGENT); }
DEV unsigned xb_add(unsigned* p, unsigned v) { return __hip_atomic_fetch_add(p, v, __ATOMIC_RELAXED, __HIP_MEMORY_SCOPE_AGENT); }
DEV unsigned xb_xcc_id() { return (unsigned)__builtin_amdgcn_s_getreg((3 << 11) | 20) & 0xFu; }
#define XB_SPIN(cond, bar) do { unsigned _sp = 0; while (cond) { __builtin_amdgcn_s_sleep(1); \
    if ((++_sp & 255u) == 0u) { if (xb_ld(&(bar)[XB_TMO])) break; if (_sp > XB_SPIN_CAP) { atomicAdd(&(bar)[XB_TMO], 1u); break; } } } } while (0)
struct XcdBarrier { unsigned* bar; unsigned x; volatile LAS unsigned* st; };
DEV XcdBarrier xcd_barrier_post(unsigned* bar, volatile LAS unsigned* st) {
  XcdBarrier b; b.bar = bar; b.x = xb_xcc_id(); b.st = st;
  if (threadIdx.x == 0) (void)xb_add(&bar[XB_XCNT(b.x)], 1u);
  return b;
}
DEV void xcd_barrier_complete(unsigned* bar, unsigned x, unsigned& nloc, unsigned& nx) {
  const unsigned G = gridDim.x * gridDim.y * gridDim.z;
  unsigned sum, cnt, mine, sp = 0u;
  for (;;) {
    sum = 0u; cnt = 0u; mine = 0u;
#pragma unroll
    for (unsigned j = 0; j < 16; ++j) { const unsigned c = xb_ld(&bar[XB_XCNT(j)]); sum += c; cnt += (c > 0u) ? 1u : 0u; mine = (j == x) ? c : mine; }
    if (sum == G) break;
    __builtin_amdgcn_s_sleep(1);
    if ((++sp & 255u) == 0u) { if (xb_ld(&bar[XB_TMO])) break; if (sp > XB_SPIN_CAP) { atomicAdd(&bar[XB_TMO], 1u); break; } }
  }
  nloc = mine > 0u ? mine : 1u; nx = cnt > 0u ? cnt : 1u;
}
DEV void xcd_barrier(const XcdBarrier& b) {
  asm volatile("s_waitcnt vmcnt(0)" ::: "memory");
  __syncthreads();
  if (threadIdx.x == 0) {
    unsigned* bar = b.bar;
    __builtin_amdgcn_s_waitcnt(0);
    unsigned nloc = b.st[0], nx = b.st[1];
    if (nloc == 0u) { xcd_barrier_complete(bar, b.x, nloc, nx); b.st[0] = nloc; b.st[1] = nx; }
    const unsigned old = xb_add(&bar[XB_XSUB(b.x)], 1u);
    const unsigned gen = old / nloc;
    if (old + 1u == (gen + 1u) * nloc) {
      __builtin_amdgcn_fence(__ATOMIC_RELEASE, "agent");
      asm volatile("s_waitcnt vmcnt(0)" ::: "memory");
      const unsigned og = xb_add(&bar[XB_TOP], 1u);
      const unsigned tg = og / nx;
      if (og + 1u == (tg + 1u) * nx) xb_add(&bar[XB_TOPGEN], 1u);
      else XB_SPIN(xb_ld(&bar[XB_TOPGEN]) == tg, bar);
      __builtin_amdgcn_fence(__ATOMIC_ACQUIRE, "agent");
      xb_add(&bar[XB_XGEN(b.x)], 1u);
      asm volatile("s_waitcnt vmcnt(0)" ::: "memory");
    } else {
      XB_SPIN(xb_ld(&bar[XB_XGEN(b.x)]) == gen, bar);
      __builtin_amdgcn_fence(__ATOMIC_ACQUIRE, "agent");
      asm volatile("s_waitcnt vmcnt(0)" ::: "memory");
    }
  }
  __syncthreads();
}

DEV void run_phase(const P& p, int ph, char* smem) {
#if !defined(ONLY_SUB) || ONLY_SUB == 10
  if (ph == 0) { phase_prep(p, 0, smem); return; }
  if (ph == 21) { phase_prep(p, 1, smem); return; }
#endif
#if !defined(ONLY_SUB) || ONLY_SUB == 11
  if (ph == 42) { phase_final(p); return; }
#endif
  const int l = ph > 21 ? 1 : 0;
  const int q = ph - (l ? 22 : 1);
  const int g = q / 10, sub = q % 10;
  const float* MOD = (const float*)(p.ws + OFF_MOD) + (size_t)l * 9 * 6144;
  switch (sub) {
#if !defined(ONLY_SUB) || ONLY_SUB == 0
    case 0: {
      if (g == 0) { fft_build_tw(smem); for (int c = BID(); c < 512; c += gridDim.x) filtfft_task(p, l, c, smem); }
      const float *srcl, *srcc; float *dl, *dc;
      xs_ptrs(p, l, g, srcl, srcc, dl, dc, true);
      norm_rows(srcl, srcc, p.in[I_N1G] + l * D, MOD + (size_t)(g * NB) * 6144, MOD + (size_t)8 * 6144, 0, (u16*)(p.ws + OFF_HX), RG);
    } break;
#endif
#if !defined(ONLY_SUB) || ONLY_SUB == 1
    case 1: phase_win(p, l, g, smem); break;
#endif
#if !defined(ONLY_SUB) || ONLY_SUB == 2
    case 2: phase_up(p, l, g, smem); break;
#endif
#if !defined(ONLY_SUB) || ONLY_SUB == 3
    case 3: phase_mix(p, l, g, smem); break;
#endif
#if !defined(ONLY_SUB) || ONLY_SUB == 4
    case 4: phase_post(p, l, g, smem); break;
#endif
#if !defined(ONLY_SUB) || ONLY_SUB == 5
    case 5: phase_merge(p, l, g, smem); break;
#endif
#if !defined(ONLY_SUB) || ONLY_SUB == 6
    case 6: phase_resid(p, l, g, smem, true); break;
#endif
#if !defined(ONLY_SUB) || ONLY_SUB == 7
    case 7: {
      const float *srcl, *srcc; float *dl, *dc;
      xs_ptrs(p, l, g, srcl, srcc, dl, dc, false);
      norm_rows(srcl, srcc, p.in[I_N2G] + l * D, MOD + (size_t)(g * NB) * 6144, MOD + (size_t)8 * 6144, 3072, (u16*)(p.ws + OFF_HX), (l == 0) ? RG : RL);
    } break;
#endif
#if !defined(ONLY_SUB) || ONLY_SUB == 8
    case 8: phase_mlp1(p, l, g, smem); break;
#endif
#if !defined(ONLY_SUB) || ONLY_SUB == 9
    case 9: phase_resid(p, l, g, smem, false); break;
#endif
  }
}

__global__ void __launch_bounds__(512) mega(P p) {
  __shared__ __attribute__((aligned(16))) char smem[SMEM_BYTES + 32];
  cg::grid_group grid = cg::this_grid();
  if (threadIdx.x == 0) *(uint4*)(smem + SMEM_BYTES) = make_uint4(0u, 0u, 0u, 0u);
  __syncthreads();
  XcdBarrier xb = xcd_barrier_post((unsigned*)(p.ws + OFF_BAR), (volatile LAS unsigned*)(smem + SMEM_BYTES));
  if (p.ph_hi > 1000) grid.sync();
  for (int ph = p.ph_lo; ph < p.ph_hi; ++ph) {
    run_phase(p, ph, smem);
    if (ph + 1 < p.ph_hi) xcd_barrier(xb);
  }
}

extern "C" void kernel_launch(void* const* d_in, const int* in_sizes, int n_in, void* d_out, int out_size, void* d_ws, size_t ws_size,
                              hipStream_t stream) {
  static int grid_blocks = 0;
  if (!grid_blocks) {
    int dev = 0, cus = 0, per_cu = 0;
    hipGetDevice(&dev);
    hipDeviceGetAttribute(&cus, hipDeviceAttributeMultiprocessorCount, dev);
    hipOccupancyMaxActiveBlocksPerMultiprocessor(&per_cu, mega, NTH, 0);
    per_cu = 1;
    grid_blocks = cus * per_cu;
    if (ws_size < WS_NEED) { fprintf(stderr, "workspace too small: %zu < %zu\n", ws_size, (size_t)WS_NEED); grid_blocks = -1; }
  }
  if (grid_blocks < 0 || n_in != 32) return;
  hipMemsetAsync(d_ws, 0, CTRL_BYTES, stream);
  P p{};
  for (int i = 0; i < 32; ++i) p.in[i] = (const float*)d_in[i];
  p.out = (float*)d_out; p.ws = (char*)d_ws;
#if SINGLE_LAUNCH
  p.ph_lo = 0; p.ph_hi = NPHASE;
  void* args[] = {&p};
  hipError_t e = hipLaunchCooperativeKernel((void*)mega, dim3(grid_blocks), dim3(NTH), args, 0, stream);
  if (e != hipSuccess) fprintf(stderr, "cooperative launch failed: %s (grid %d)\n", hipGetErrorString(e), grid_blocks);
#else
  for (int ph = 0; ph < NPHASE; ++ph) {
    p.ph_lo = ph; p.ph_hi = ph + 1;
    hipLaunchKernelGGL(mega, dim3(grid_blocks), dim3(NTH), 0, stream, p);
  }
#endif
}
```

```cpp
#include <hip/hip_runtime.h>
#include <hip/hip_bf16.h>
#include <hip/hip_cooperative_groups.h>
#include <cstdio>
namespace cg = cooperative_groups;

typedef unsigned short u16;
typedef __attribute__((ext_vector_type(8))) short bf16x8;
typedef __attribute__((ext_vector_type(4))) float f32x4;
#define DEV __device__ __forceinline__
#define GAS __attribute__((address_space(1)))
#define LAS __attribute__((address_space(3)))
typedef unsigned int u32x4 __attribute__((ext_vector_type(4)));
typedef GAS const u32x4 gu4;

#ifndef SINGLE_LAUNCH
#define SINGLE_LAUNCH 1
#endif

constexpr int D = 1024, L = 4096, LC = 256, NB = 4, NGRP = 2;
constexpr int RL = NB * L, RC = NB * LC, RG = RL + RC;
constexpr int NIN = 6656;
constexpr int PK = L + LC;
constexpr int DFF = 4096;
constexpr int KSLD = 4104;
constexpr float EPS = 1e-6f;
constexpr int NPHASE = 43;

constexpr size_t al(size_t x) { return (x + 255) & ~(size_t)255; }
constexpr size_t CTRL_BYTES = 1 << 20;
constexpr size_t OFF_CNT = 0;
constexpr size_t OFF_NORM = 1024;
constexpr size_t OFF_NORMC = OFF_NORM + 2 * 1024 * 4;
constexpr size_t OFF_SSQ = 16384;
constexpr size_t OFF_BAR = 573440;
constexpr size_t OFF_MOD = 587264;
static_assert(OFF_SSQ + (size_t)2 * 2 * 34816 * 4 <= OFF_BAR && OFF_MOD + 2 * 9 * 6144 * 4 <= CTRL_BYTES, "ctrl map");
constexpr size_t OFF_CTXS = CTRL_BYTES;
constexpr size_t OFF_WIN = OFF_CTXS + (size_t)2048 * 1024 * 4;
constexpr size_t OFF_WUQ = OFF_WIN + (size_t)NIN * 1024 * 2;
constexpr size_t OFF_WUKV = OFF_WUQ + (size_t)768 * 256 * 2;
constexpr size_t OFF_WOM = OFF_WUKV + (size_t)1024 * 128 * 2;
constexpr size_t OFF_WOG = OFF_WOM + (size_t)1024 * 512 * 2;
constexpr size_t OFF_WOH = OFF_WOG + (size_t)1024 * 512 * 2;
constexpr size_t OFF_WOUT = OFF_WOH + (size_t)1024 * 512 * 2;
constexpr size_t OFF_W1 = OFF_WOUT + (size_t)1024 * 1024 * 2;
constexpr size_t OFF_W2 = OFF_W1 + (size_t)4096 * 1024 * 2;
constexpr size_t OFF_KS = OFF_W2 + (size_t)4096 * 1024 * 2;
constexpr size_t OFF_KFC = OFF_KS + (size_t)1024 * KSLD * 8;
constexpr size_t OFF_HX = OFF_KFC + (size_t)2 * 2 * 512 * 256 * 4;
constexpr size_t OFF_Q = OFF_HX + (size_t)RG * 1024 * 2;
constexpr size_t OFF_K = OFF_Q + (size_t)NB * 8 * PK * 96 * 2;
constexpr size_t OFF_VT = OFF_K + (size_t)NB * 8 * PK * 96 * 2;
constexpr size_t OFF_YMLA = OFF_VT + (size_t)NB * 8 * 64 * PK * 2;
constexpr size_t OFF_OF = OFF_YMLA + (size_t)RG * 512 * 2;
constexpr size_t OFF_OB = OFF_OF + (size_t)RG * 512 * 2;
constexpr size_t OFF_YHY = OFF_OB + (size_t)RG * 512 * 2;
constexpr size_t OFF_Z = OFF_YHY + (size_t)RG * 512 * 2;
constexpr size_t OFF_ZQ = OFF_Z;
constexpr size_t OFF_ZKV = OFF_ZQ + (size_t)RG * 256 * 2;
constexpr size_t OFF_MISC = OFF_ZKV + (size_t)RG * 128 * 2;
constexpr size_t OFF_GQ = OFF_MISC + (size_t)RG * 64 * 2;
constexpr size_t OFF_GK = OFF_GQ + (size_t)RG * 256 * 2;
constexpr size_t OFF_GV = OFF_GK + (size_t)RG * 256 * 2;
constexpr size_t OFF_GR = OFF_GV + (size_t)RG * 512 * 2;
constexpr size_t OFF_HYT = OFF_GR + (size_t)RG * 512 * 2;
constexpr size_t OFF_HYC = OFF_HYT + (size_t)NB * 2048 * L * 2;
constexpr size_t OFF_GATES = OFF_HYC + (size_t)RC * 1536 * 2;
constexpr size_t OFF_END1 = OFF_GATES + (size_t)RG * 3072 * 2;
constexpr size_t OFF_H = OFF_Z;
constexpr size_t OFF_END2 = OFF_H + (size_t)RG * 4096 * 2;
constexpr size_t WS_NEED = OFF_END1 > OFF_END2 ? OFF_END1 : OFF_END2;
static_assert(WS_NEED <= ((size_t)512 << 20), "workspace over 512 MiB");
static_assert((size_t)2 * 512 * 8192 * 4 <= (size_t)RG * 3072 * 2, "KF alias");

constexpr int SMEM_BYTES = 131072;
constexpr int NTH = 512;

struct P {
  const float* in[32];
  float* out;
  char* ws;
  int ph_lo, ph_hi;
};
enum { I_X = 0, I_C, I_CTX, I_CCTX, I_ADAW, I_ADAB, I_N1G, I_N2G, I_WIN, I_QNORM, I_WUQ, I_KVNORM, I_WUKV, I_WA2, I_BA,
       I_GONORM, I_HSW, I_HSB, I_FW1, I_FB1, I_FW2, I_FB2, I_FW3, I_FB3, I_HYB, I_WOM, I_WOG, I_WOH, I_WOUT, I_FF1, I_FF2, I_FNG };

DEV int TID() { int t = threadIdx.x; asm volatile("" : "+v"(t)); return t; }
DEV int BID() { int b = blockIdx.x; asm volatile("" : "+s"(b)); return b; }
DEV char* WSP(char* w) { asm volatile("" : "+s"(w)); return w; }
typedef __bf16 bf16x2_t __attribute__((ext_vector_type(2)));
typedef float f32x2_t __attribute__((ext_vector_type(2)));
DEV u16 f2bf(float f) { return __builtin_bit_cast(u16, (__bf16)f); }
DEV float bf2f(u16 h) { return __uint_as_float(((unsigned)h) << 16); }
DEV unsigned pk2(float a, float b) { f32x2_t v = {a, b}; bf16x2_t r = __builtin_convertvector(v, bf16x2_t); return __builtin_bit_cast(unsigned, r); }
DEV uint2 pk4(f32x4 v) { return make_uint2(pk2(v[0], v[1]), pk2(v[2], v[3])); }
DEV float wave_sum(float v) {
#pragma unroll
  for (int o = 1; o < 64; o <<= 1) v += __shfl_xor(v, o);
  return v;
}
DEV float sigmoidf(float x) { return 1.f / (1.f + __expf(-x)); }
DEV bf16x8 mk8(uint2 a, uint2 b) {
  union { uint4 u; bf16x8 v; } t; t.u = make_uint4(a.x, a.y, b.x, b.y); return t.v;
}
DEV f32x4 mfma(bf16x8 a, bf16x8 b, f32x4 c) { return __builtin_amdgcn_mfma_f32_16x16x32_bf16(a, b, c, 0, 0, 0); }
DEV void rowinfo(int r, int& b, int& p) {
  if (r < RL) { b = r >> 12; p = LC + (r & (L - 1)); } else { int rc = r - RL; b = rc >> 8; p = rc & (LC - 1); }
}

constexpr int LDT = 72;
constexpr int STG = 128 * LDT;
template <bool SWAP, int TN, bool PERM = false, bool PERMA = false>
DEV void gemm_core(f32x4 (&acc)[TN == 256 ? 8 : 4][4], const u16* __restrict__ A, int lda, const u16* __restrict__ B, int ldb, int K, u16* sm,
                   bool first = true, const u16* nA = nullptr, int nlda = 0, const u16* nB = nullptr, int nldb = 0) {
  constexpr int MI = TN == 256 ? 8 : 4;
  const int tid = TID(), lane = tid & 63, w = tid >> 6, lr = lane & 15, lg = lane >> 4;
  const int wr = TN == 256 ? (w >> 2) : (w >> 1), wc = TN == 256 ? (w & 3) : (w & 1);
  constexpr int OPA = 256 * 32, OPB = TN * 32, STSZ = OPA + OPB;
  const int drow = lane >> 2, dch = lane & 3;
  const int brow = TN == 256 ? w * 32 : w * 16;
  const int pa0 = PERMA ? (w * 32 + 8 * (drow >> 2) + (drow & 3)) : (w * 32 + drow);
  const int pa1 = PERMA ? (pa0 + 4) : (w * 32 + 16 + drow);
  const GAS u16* ga0 = (const GAS u16*)(A + (size_t)pa0 * lda + dch * 8);
  const GAS u16* ga1 = (const GAS u16*)(A + (size_t)pa1 * lda + dch * 8);
  const int pb0 = PERM ? ((TN == 256 ? w * 32 : (w >> 1) * 32) + 8 * (drow >> 2) + (TN == 256 ? 0 : 4 * (w & 1)) + (drow & 3)) : (brow + drow);
  const int pb1 = PERM ? (pb0 + 4) : (brow + 16 + drow);
  const GAS u16* gb0 = (const GAS u16*)(B + (size_t)pb0 * ldb + dch * 8);
  const GAS u16* gb1 = (const GAS u16*)(B + (size_t)pb1 * ldb + dch * 8);
  LAS u16* ls = (LAS u16*)sm;
  const int wofA = __builtin_amdgcn_readfirstlane(w * 32 * 32);
  const int wofB = __builtin_amdgcn_readfirstlane(OPA + brow * 32);
#define ISSUE(kk) do { const int _st = ((kk) & 3) * STSZ; const int _ko = (kk) * 32; \
    __builtin_amdgcn_global_load_lds((const GAS unsigned*)(ga0 + _ko), (LAS unsigned*)(ls + _st + wofA), 16, 0, 0); \
    __builtin_amdgcn_global_load_lds((const GAS unsigned*)(ga1 + _ko), (LAS unsigned*)(ls + _st + wofA + 16 * 32), 16, 0, 0); \
    __builtin_amdgcn_global_load_lds((const GAS unsigned*)(gb0 + _ko), (LAS unsigned*)(ls + _st + wofB), 16, 0, 0); \
    if (TN == 256) __builtin_amdgcn_global_load_lds((const GAS unsigned*)(gb1 + _ko), (LAS unsigned*)(ls + _st + wofB + 16 * 32), 16, 0, 0); } while (0)
#define FRAG(p, i) (*(const bf16x8*)((p) + (i) * 16 * 32))
#define MM(mi, ni, av, bv) acc[mi][ni] = SWAP ? mfma(bv, av, acc[mi][ni]) : mfma(av, bv, acc[mi][ni])
#define MM16(mo, a0, a1, a2, a3, b0, b1, b2, b3) do { \
    MM(mo + 0, 0, a0, b0); MM(mo + 1, 0, a1, b0); MM(mo + 0, 1, a0, b1); MM(mo + 1, 1, a1, b1); \
    MM(mo + 2, 0, a2, b0); MM(mo + 3, 0, a3, b0); MM(mo + 2, 1, a2, b1); MM(mo + 3, 1, a3, b1); \
    MM(mo + 0, 2, a0, b2); MM(mo + 1, 2, a1, b2); MM(mo + 2, 2, a2, b2); MM(mo + 3, 2, a3, b2); \
    MM(mo + 0, 3, a0, b3); MM(mo + 1, 3, a1, b3); MM(mo + 2, 3, a2, b3); MM(mo + 3, 3, a3, b3); } while (0)
  const int nk2 = K >> 6;
  if (first) { __syncthreads(); ISSUE(0); ISSUE(1); }
  const int aoff = (wr * MI * 16 + lr) * 32 + lg * 8, boff = OPA + (wc * 64 + lr) * 32 + lg * 8;
  for (int s2 = 0; s2 < nk2; ++s2) {
    asm volatile("s_waitcnt vmcnt(0)" ::: "memory");
    __builtin_amdgcn_s_barrier();
    __builtin_amdgcn_sched_barrier(0);
    if (s2 + 1 < nk2) { ISSUE(2 * s2 + 2); ISSUE(2 * s2 + 3); }
    const u16* p0 = sm + ((2 * s2) & 3) * STSZ;
    const u16* p1 = sm + ((2 * s2 + 1) & 3) * STSZ;
    const bf16x8 b0 = FRAG(p0 + boff, 0), b1 = FRAG(p0 + boff, 1), b2 = FRAG(p0 + boff, 2), b3 = FRAG(p0 + boff, 3);
    const bf16x8 a0 = FRAG(p0 + aoff, 0), a1 = FRAG(p0 + aoff, 1), a2 = FRAG(p0 + aoff, 2), a3 = FRAG(p0 + aoff, 3);
    if (MI == 8) {
      const bf16x8 a4 = FRAG(p0 + aoff, 4), a5 = FRAG(p0 + aoff, 5), a6 = FRAG(p0 + aoff, 6), a7 = FRAG(p0 + aoff, 7);
      __builtin_amdgcn_sched_barrier(0);
      MM16(0, a0, a1, a2, a3, b0, b1, b2, b3);
      __builtin_amdgcn_sched_barrier(0);
      const bf16x8 d0 = FRAG(p1 + aoff, 0), d1 = FRAG(p1 + aoff, 1), d2 = FRAG(p1 + aoff, 2), d3 = FRAG(p1 + aoff, 3);
      __builtin_amdgcn_sched_barrier(0);
      MM16(MI - 4, a4, a5, a6, a7, b0, b1, b2, b3);
      __builtin_amdgcn_sched_barrier(0);
      const bf16x8 c0 = FRAG(p1 + boff, 0), c1 = FRAG(p1 + boff, 1), c2 = FRAG(p1 + boff, 2), c3 = FRAG(p1 + boff, 3);
      const bf16x8 d4 = FRAG(p1 + aoff, 4), d5 = FRAG(p1 + aoff, 5), d6 = FRAG(p1 + aoff, 6), d7 = FRAG(p1 + aoff, 7);
      __builtin_amdgcn_sched_barrier(0);
      MM16(0, d0, d1, d2, d3, c0, c1, c2, c3);
      __builtin_amdgcn_sched_barrier(0);
      MM16(MI - 4, d4, d5, d6, d7, c0, c1, c2, c3);
    } else {
      const bf16x8 c0 = FRAG(p1 + boff, 0), c1 = FRAG(p1 + boff, 1), c2 = FRAG(p1 + boff, 2), c3 = FRAG(p1 + boff, 3);
      const bf16x8 d0 = FRAG(p1 + aoff, 0), d1 = FRAG(p1 + aoff, 1), d2 = FRAG(p1 + aoff, 2), d3 = FRAG(p1 + aoff, 3);
      __builtin_amdgcn_sched_barrier(0);
      MM16(0, a0, a1, a2, a3, b0, b1, b2, b3);
      __builtin_amdgcn_sched_barrier(0);
      MM16(0, d0, d1, d2, d3, c0, c1, c2, c3);
    }
    __builtin_amdgcn_sched_barrier(0);
  }
  if (nA) {
    ga0 = (const GAS u16*)(nA + (size_t)pa0 * nlda + dch * 8);
    ga1 = (const GAS u16*)(nA + (size_t)pa1 * nlda + dch * 8);
    gb0 = (const GAS u16*)(nB + (size_t)pb0 * nldb + dch * 8);
    gb1 = (const GAS u16*)(nB + (size_t)pb1 * nldb + dch * 8);
    ISSUE(0); ISSUE(1);
  }
#undef MM16
#undef MM
#undef FRAG
#undef ISSUE
}
template <int MI>
DEV void zero_acc(f32x4 (&acc)[MI][4]) {
#pragma unroll
  for (int i = 0; i < MI; ++i)
#pragma unroll
    for (int j = 0; j < 4; ++j) acc[i][j] = f32x4{0.f, 0.f, 0.f, 0.f};
}

DEV int win_orig_col(int j) {
  if (j < 416) return j;
  if (j < 432) return 1952 + (j - 416);
  if (j < 448) return 1968 + (j - 432);
  if (j < 512) return -1;
  if (j < 2048) return 416 + (j - 512);
  return j - 64;
}
DEV void cvt_item(const float* __restrict__ W, int Norig, int K, u16* WT, int n, int k8, int oc, const float* gain) {
  float v[8];
#pragma unroll
  for (int e = 0; e < 8; ++e) {
    int k = k8 * 8 + e;
    float x = (oc >= 0) ? W[(size_t)k * Norig + oc] : 0.f;
    if (gain) x *= gain[k];
    v[e] = x;
  }
  *(uint4*)(WT + (size_t)n * K + k8 * 8) = make_uint4(pk2(v[0], v[1]), pk2(v[2], v[3]), pk2(v[4], v[5]), pk2(v[6], v[7]));
}

DEV void filter_item(const P& p, int l, int item, char* smem) {
  constexpr int NP = 8;
  const bool isc = item >= 512;
  const int Lx = isc ? LC : L;
  const int pos0 = (isc ? item - 512 : item) * NP;
  float* feat = (float*)smem;
  float* h1 = feat + NP * 36;
  float* h2 = h1 + NP * 64;
  const int tid = TID();
  const float* w1 = p.in[I_FW1] + (size_t)l * 33 * 64; const float* b1 = p.in[I_FB1] + l * 64;
  const float* w2 = p.in[I_FW2] + (size_t)l * 64 * 64; const float* b2 = p.in[I_FB2] + l * 64;
  const float* w3 = p.in[I_FW3] + (size_t)l * 64 * 2048; const float* b3 = p.in[I_FB3] + l * 2048;
  __syncthreads();
  for (int e = tid; e < NP * 33; e += NTH) {
    int ps = e / 33, fi = e % 33;
    float pos = (float)(pos0 + ps);
    float v;
    if (fi == 0) v = pos / (float)(Lx - 1);
    else {
      int i = (fi - 1) & 15;
      float f = 1e-4f + (float)i * ((15.f - 1e-4f) / 15.f);
      float ang = (6.283185307179586f / (float)Lx) * pos * f;
      v = (fi <= 16) ? __cosf(ang) : __sinf(ang);
    }
    feat[ps * 36 + fi] = v;
  }
  __syncthreads();
  {
    const int ps = tid >> 6, u = tid & 63;
    float a = b1[u];
#pragma unroll 11
    for (int k = 0; k < 33; ++k) a += feat[ps * 36 + k] * w1[k * 64 + u];
    h1[ps * 64 + u] = __sinf(a);
    __syncthreads();
    a = b2[u];
#pragma unroll 16
    for (int k = 0; k < 64; ++k) a += h1[ps * 64 + k] * w2[k * 64 + u];
    h2[ps * 64 + u] = __sinf(a);
  }
  __syncthreads();
  float* KF = isc ? (float*)(p.ws + OFF_KFC) : (float*)(p.ws + OFF_GATES);
  float* NRM = isc ? (float*)(p.ws + OFF_NORMC) : (float*)(p.ws + OFF_NORM) + l * 1024;
  const float da = logf(1e-2f) / 0.3f, db = logf(1e-2f) / 1.5f;
#pragma unroll 1
  for (int jj = 0; jj < 4; ++jj) {
    const int j = tid + NTH * jj;
    float acc[NP];
#pragma unroll
    for (int q = 0; q < NP; ++q) acc[q] = 0.f;
#pragma unroll 4
    for (int k = 0; k < 64; k += 4) {
      const float w0 = w3[(k + 0) * 2048 + j], w1v = w3[(k + 1) * 2048 + j], w2v = w3[(k + 2) * 2048 + j], w3v = w3[(k + 3) * 2048 + j];
#pragma unroll
      for (int q = 0; q < NP; ++q) {
        const f32x4 h = *(const f32x4*)(h2 + q * 64 + k);
        acc[q] += h[0] * w0 + h[1] * w1v + h[2] * w2v + h[3] * w3v;
      }
    }
    const int dir = j >> 10, n = (j >> 9) & 1, c = j & 511;
    const float delta = fabsf(da + (float)c * ((db - da) / 511.f));
    const float bb = b3[j];
    float s = 0.f;
    float* dst = KF + ((size_t)((n * 2 + dir) * 512 + c)) * Lx + pos0;
#pragma unroll
    for (int q = 0; q < NP; ++q) {
      float t = (float)(pos0 + q) / (float)(Lx - 1);
      float v = (acc[q] + bb) * expf(-t * delta);
      s += fabsf(v);
      dst[q] = v;
    }
    atomicAdd(NRM + n * 512 + c, s);
  }
}

DEV void adaln_item(const P& p, int item, char* smem) {
  float* sc = (float*)smem;
  const int tid = TID();
  const int l2 = item / 96, rem = item % 96, nch = rem >> 3, ks = rem & 7, k0 = ks * 128;
  __syncthreads();
  for (int e = tid; e < 9 * 128; e += NTH) {
    int r = e >> 7, k = k0 + (e & 127);
    float v = (r < 8) ? p.in[I_C][r * 1024 + k] : p.in[I_CCTX][k];
    sc[e] = v / (1.f + expf(-v));
  }
  __syncthreads();
  const int n = nch * 512 + tid;
  const float* W = p.in[I_ADAW] + (size_t)l2 * 1024 * 6144 + (size_t)k0 * 6144;
  float acc[9];
#pragma unroll
  for (int r = 0; r < 9; ++r) acc[r] = 0.f;
#pragma unroll 32
  for (int k = 0; k < 128; ++k) {
    float w = W[(size_t)k * 6144 + n];
#pragma unroll
    for (int r = 0; r < 9; ++r) acc[r] += sc[r * 128 + k] * w;
  }
  const float bb = (ks == 0) ? p.in[I_ADAB][l2 * 6144 + n] : 0.f;
  float* MOD = (float*)(p.ws + OFF_MOD);
#pragma unroll
  for (int r = 0; r < 9; ++r) atomicAdd(MOD + ((size_t)l2 * 9 + r) * 6144 + n, acc[r] + bb);
}

DEV void phase_prep(const P& p, int l, char* smem) {
  const int nfilt = (l == 0) ? 544 : 512;
  for (int it = BID(); it < nfilt; it += gridDim.x) filter_item(p, l, it, smem);
  if (l == 0) for (int it = BID(); it < 192; it += gridDim.x) adaln_item(p, it, smem);
  const long T = (long)gridDim.x * NTH;
  const long gt = (long)BID() * NTH + TID();
  char* ws = WSP(p.ws);
  {
    const float* W = p.in[I_WIN] + (size_t)l * 1024 * 6592;
    for (long i = gt; i < (long)NIN * 128; i += T) { int k8 = (int)(i / NIN), n = (int)(i % NIN); cvt_item(W, 6592, 1024, (u16*)(ws + OFF_WIN), n, k8, win_orig_col(n), nullptr); }
  }
  {
    const float* W = p.in[I_WUQ] + (size_t)l * 256 * 768; const float* g = p.in[I_QNORM] + l * 256;
    for (long i = gt; i < 768L * 32; i += T) {
      int k8 = (int)(i / 768), n = (int)(i % 768);
      int oc = (n < 512) ? (n >> 6) * 96 + (n & 63) : ((n - 512) >> 5) * 96 + 64 + ((n - 512) & 31);
      cvt_item(W, 768, 256, (u16*)(ws + OFF_WUQ), n, k8, oc, g);
    }
  }
  {
    const float* W = p.in[I_WUKV] + (size_t)l * 128 * 1024; const float* g = p.in[I_KVNORM] + l * 128;
    for (long i = gt; i < 1024L * 16; i += T) {
      int k8 = (int)(i / 1024), n = (int)(i % 1024);
      int oc = (n < 512) ? (n >> 6) * 128 + (n & 63) : ((n - 512) >> 6) * 128 + 64 + ((n - 512) & 63);
      cvt_item(W, 1024, 128, (u16*)(ws + OFF_WUKV), n, k8, oc, g);
    }
  }
  for (int m = 0; m < 3; ++m) {
    const float* W = p.in[I_WOM + m] + (size_t)l * 512 * 1024;
    u16* WT = (u16*)(ws + (m == 0 ? OFF_WOM : (m == 1 ? OFF_WOG : OFF_WOH)));
    for (long i = gt; i < 1024L * 64; i += T) { int k8 = (int)(i / 1024), n = (int)(i % 1024); cvt_item(W, 1024, 512, WT, n, k8, n, nullptr); }
  }
  {
    const float* W = p.in[I_WOUT] + (size_t)l * 1024 * 1024;
    for (long i = gt; i < 1024L * 128; i += T) { int k8 = (int)(i / 1024), n = (int)(i % 1024); cvt_item(W, 1024, 1024, (u16*)(ws + OFF_WOUT), n, k8, n, nullptr); }
  }
  {
    const float* W = p.in[I_FF1] + (size_t)l * 1024 * 4096;
    for (long i = gt; i < 4096L * 128; i += T) { int k8 = (int)(i / 4096), n = (int)(i % 4096); cvt_item(W, 4096, 1024, (u16*)(ws + OFF_W1), n, k8, n, nullptr); }
  }
  {
    const float* W = p.in[I_FF2] + (size_t)l * 4096 * 1024;
    for (long i = gt; i < 1024L * 512; i += T) { int k8 = (int)(i / 1024), n = (int)(i % 1024); cvt_item(W, 1024, 4096, (u16*)(ws + OFF_W2), n, k8, n, nullptr); }
  }
}

DEV int PADI(int i) { return i + (i >> 4); }
constexpr int TW_OFF = 90112;
DEV int PADT(int k) { return k + (k >> 3); }
DEV void fft_build_tw(char* smem) {
  float2* tw = (float2*)(smem + TW_OFF);
  __syncthreads();
  for (int k = TID(); k < 4096; k += NTH) {
    const float fr = (float)k * (1.f / 8192.f);
    tw[PADT(k)] = make_float2(__builtin_amdgcn_cosf(fr), __builtin_amdgcn_sinf(fr));
  }
  __syncthreads();
}
template <bool INV>
DEV void bfly(float2& a, float2& b, const float2 w) {
  const float c = w.x, s = w.y;
  if (!INV) {
    float tx = a.x - b.x, ty = a.y - b.y;
    a.x += b.x; a.y += b.y;
    b.x = tx * c + ty * s; b.y = ty * c - tx * s;
  } else {
    float tx = b.x * c - b.y * s, ty = b.x * s + b.y * c;
    b.x = a.x - tx; b.y = a.y - ty;
    a.x += tx; a.y += ty;
  }
}
template <bool INV, bool HALF>
DEV void fft_r8_pass(float2* buf, int q, int lq) {
  const float2* tw = (const float2*)((const char*)buf + TW_OFF);
#pragma unroll 2
  for (int gi = TID(); gi < 1024; gi += NTH) {
    const int pos = gi & (q - 1), base = (gi >> lq) * 8 * q + pos;
    const int fpi = pos << (10 - lq);
    float2 e[8];
#pragma unroll
    for (int m = 0; m < 8; ++m) e[m] = (HALF && !INV && m >= 4) ? make_float2(0.f, 0.f) : buf[PADI(base + m * q)];
    if (!INV) {
      if (HALF) {
#pragma unroll
        for (int m = 0; m < 4; ++m) { const float2 w = tw[PADT(fpi + m * 1024)]; e[m + 4] = make_float2(e[m].x * w.x + e[m].y * w.y, e[m].y * w.x - e[m].x * w.y); }
      } else {
#pragma unroll
        for (int m = 0; m < 4; ++m) bfly<false>(e[m], e[m + 4], tw[PADT(fpi + m * 1024)]);
      }
#pragma unroll
      for (int m = 0; m < 2; ++m) { const float2 w = tw[PADT(2 * fpi + m * 2048)]; bfly<false>(e[m], e[m + 2], w); bfly<false>(e[m + 4], e[m + 6], w); }
      {
        const float2 w = tw[PADT(4 * fpi)];
#pragma unroll
        for (int m = 0; m < 8; m += 2) bfly<false>(e[m], e[m + 1], w);
      }
    } else {
      {
        const float2 w = tw[PADT(4 * fpi)];
#pragma unroll
        for (int m = 0; m < 8; m += 2) bfly<true>(e[m], e[m + 1], w);
      }
#pragma unroll
      for (int m = 0; m < 2; ++m) { const float2 w = tw[PADT(2 * fpi + m * 2048)]; bfly<true>(e[m], e[m + 2], w); bfly<true>(e[m + 4], e[m + 6], w); }
      if (HALF) {
#pragma unroll
        for (int m = 0; m < 4; ++m) { const float2 w = tw[PADT(fpi + m * 1024)]; e[m].x += e[m + 4].x * w.x - e[m + 4].y * w.y; e[m].y += e[m + 4].x * w.y + e[m + 4].y * w.x; }
      } else {
#pragma unroll
        for (int m = 0; m < 4; ++m) bfly<true>(e[m], e[m + 4], tw[PADT(fpi + m * 1024)]);
      }
    }
#pragma unroll
    for (int m = 0; m < 8; ++m) if (!(HALF && INV && m >= 4)) buf[PADI(base + m * q)] = e[m];
  }
  __syncthreads();
}
DEV void fft_r2_last(float2* buf) {
#pragma unroll 4
  for (int gi = TID(); gi < 4096; gi += NTH) {
    float2 a = buf[PADI(2 * gi)], b = buf[PADI(2 * gi + 1)];
    buf[PADI(2 * gi)] = make_float2(a.x + b.x, a.y + b.y);
    buf[PADI(2 * gi + 1)] = make_float2(a.x - b.x, a.y - b.y);
  }
  __syncthreads();
}
template <bool ZHI>
DEV void fft_fwd(float2* buf) {
  fft_r8_pass<false, ZHI>(buf, 1024, 10); fft_r8_pass<false, false>(buf, 128, 7); fft_r8_pass<false, false>(buf, 16, 4); fft_r8_pass<false, false>(buf, 2, 1);
  fft_r2_last(buf);
}
template <bool LOHALF>
DEV void fft_inv(float2* buf) {
  fft_r2_last(buf);
  fft_r8_pass<true, false>(buf, 2, 1); fft_r8_pass<true, false>(buf, 16, 4); fft_r8_pass<true, false>(buf, 128, 7); fft_r8_pass<true, LOHALF>(buf, 1024, 10);
}
DEV int brev13(int f) { return (int)(__brev((unsigned)f) >> 19); }

DEV void filtfft_task(const P& p, int l, int c, char* smem) {
  float2* buf = (float2*)smem;
  const float* KF = (const float*)(p.ws + OFF_GATES);
  const float* NRM = (const float*)(p.ws + OFF_NORM) + l * 1024;
  const int tid = TID();
  __syncthreads();
  for (int i = tid; i < 8192; i += NTH) {
    float a, b;
    if (i < 4096) { a = KF[((size_t)(0 * 2 + 0) * 512 + c) * L + i]; b = KF[((size_t)(1 * 2 + 0) * 512 + c) * L + i]; }
    else if (i == 4096) { a = 0.f; b = 0.f; }
    else { a = KF[((size_t)(0 * 2 + 1) * 512 + c) * L + (8192 - i)]; b = KF[((size_t)(1 * 2 + 1) * 512 + c) * L + (8192 - i)]; }
    buf[PADI(i)] = make_float2(a, b);
  }
  __syncthreads();
  fft_fwd<false>(buf);
  const float s0 = 0.5f / (NRM[c] * 8192.f), s1 = 0.5f / (NRM[512 + c] * 8192.f);
  float2* KS = (float2*)(p.ws + OFF_KS);
  for (int f = tid; f <= 4096; f += NTH) {
    float2 zf = buf[PADI(brev13(f))], zn = buf[PADI(brev13((8192 - f) & 8191))];
    KS[(size_t)(0 * 512 + c) * KSLD + f] = make_float2((zf.x + zn.x) * s0, (zf.y - zn.y) * s0);
    KS[(size_t)(1 * 512 + c) * KSLD + f] = make_float2((zf.y + zn.y) * s1, -(zf.x - zn.x) * s1);
  }
  __syncthreads();
}

DEV void norm_rows(const float* xl, const float* xc, const float* gain, const float* modl, const float* modc, int shoff, u16* HX, int nrows) {
  const int gw = BID() * 8 + (TID() >> 6), NW = gridDim.x * 8, lane = TID() & 63;
#define NR_SRC(r) (((r) < RL) ? xl + (size_t)(r) * D : xc + (size_t)((r) - RL) * D)
#define NR_LOAD(A_, B_, ra_) do { const int _r1 = ((ra_) + NW < nrows) ? (ra_) + NW : (ra_); const float* _s0 = NR_SRC(ra_); const float* _s1 = NR_SRC(_r1); \
    _Pragma("unroll") for (int j = 0; j < 2; ++j) { \
      A_[2 * j] = *(const f32x4*)(_s0 + j * 512 + lane * 8); A_[2 * j + 1] = *(const f32x4*)(_s0 + j * 512 + lane * 8 + 4); \
      B_[2 * j] = *(const f32x4*)(_s1 + j * 512 + lane * 8); B_[2 * j + 1] = *(const f32x4*)(_s1 + j * 512 + lane * 8 + 4); } } while (0)
  f32x4 a[4], b[4];
  int r0 = gw;
  if (r0 < nrows) NR_LOAD(a, b, r0);
  while (r0 < nrows) {
    const int r1 = r0 + NW; const bool has1 = r1 < nrows;
    float sa = 0.f, sb = 0.f;
#pragma unroll
    for (int j = 0; j < 4; ++j) {
      sa += a[j][0] * a[j][0] + a[j][1] * a[j][1] + a[j][2] * a[j][2] + a[j][3] * a[j][3];
      sb += b[j][0] * b[j][0] + b[j][1] * b[j][1] + b[j][2] * b[j][2] + b[j][3] * b[j][3];
    }
    const float ra = rsqrtf(wave_sum(sa) * (1.f / D) + EPS), rb = rsqrtf(wave_sum(sb) * (1.f / D) + EPS);
    const int rn = r0 + 2 * NW;
    f32x4 na[4], nb[4];
#pragma unroll
    for (int j = 0; j < 4; ++j) { na[j] = a[j]; nb[j] = b[j]; }
    if (rn < nrows) NR_LOAD(na, nb, rn);
    const float* m0 = (r0 < RL) ? modl + (size_t)(r0 >> 12) * 6144 : modc;
    const float* m1 = (has1 && r1 < RL) ? modl + (size_t)(r1 >> 12) * 6144 : (has1 ? modc : m0);
#pragma unroll
    for (int j = 0; j < 2; ++j) {
      const int c0 = j * 512 + lane * 8;
      f32x4 ya[2], yb[2];
#pragma unroll
      for (int h = 0; h < 2; ++h) {
        const f32x4 g = *(const f32x4*)(gain + c0 + 4 * h);
        const f32x4 sh0 = *(const f32x4*)(m0 + shoff + c0 + 4 * h), sc0 = *(const f32x4*)(m0 + shoff + 1024 + c0 + 4 * h);
        const f32x4 sh1 = *(const f32x4*)(m1 + shoff + c0 + 4 * h), sc1 = *(const f32x4*)(m1 + shoff + 1024 + c0 + 4 * h);
#pragma unroll
        for (int e = 0; e < 4; ++e) {
          ya[h][e] = a[2 * j + h][e] * ra * g[e] * (1.f + sc0[e]) + sh0[e];
          yb[h][e] = b[2 * j + h][e] * rb * g[e] * (1.f + sc1[e]) + sh1[e];
        }
      }
      { const uint2 lo = pk4(ya[0]), hi = pk4(ya[1]); *(uint4*)(HX + (size_t)r0 * D + c0) = make_uint4(lo.x, lo.y, hi.x, hi.y); }
      if (has1) { const uint2 lo = pk4(yb[0]), hi = pk4(yb[1]); *(uint4*)(HX + (size_t)r1 * D + c0) = make_uint4(lo.x, lo.y, hi.x, hi.y); }
    }
#pragma unroll
    for (int j = 0; j < 4; ++j) { a[j] = na[j]; b[j] = nb[j]; }
    r0 = rn;
  }
#undef NR_LOAD
#undef NR_SRC
}

DEV void rope4(f32x4& v, int pos, int lg) {
#pragma unroll
  for (int j = 0; j < 4; ++j) {
    float pv = __shfl_xor(v[j], 32);
    int i = (lg * 4 + j) & 7;
    float inv = exp2f(-(float)i * (13.287712379549449f / 8.f));
    float ang = (float)pos * inv; float sn = __sinf(ang), cs = __cosf(ang);
    v[j] = (lg < 2) ? v[j] * cs - pv * sn : pv * sn + v[j] * cs;
  }
}

DEV void rope_perm(f32x4& ve, f32x4& vo, int pos, int lg) {
#pragma unroll
  for (int h = 0; h < 2; ++h) {
#pragma unroll
    for (int j = 0; j < 4; ++j) {
      float x = h ? vo[j] : ve[j];
      float pv = __shfl_xor(x, 16);
      int i = h * 4 + j;
      float inv = exp2f(-(float)i * (13.287712379549449f / 8.f));
      float ang = (float)pos * inv; float sn = __sinf(ang), cs = __cosf(ang);
      float y = ((lg & 1) == 0) ? x * cs - pv * sn : pv * sn + x * cs;
      if (h) vo[j] = y; else ve[j] = y;
    }
  }
}

DEV void phase_win(const P& p, int l, int g, char* smem) {
  char* ws = WSP(p.ws);
  const u16* HX = (const u16*)(ws + OFF_HX);
  const u16* WT = (const u16*)(ws + OFF_WIN);
  float* SSQ = (float*)(ws + OFF_SSQ) + (size_t)l * 2 * 34816;
  const int tid = TID(), lane = tid & 63, w = tid >> 6, wr = w >> 2, wc = w & 3, lr = lane & 15, lg = lane >> 4;
  const int NT = 26, ntiles = 68 * NT;
  bool pref = false;
  for (int t = BID(); t < ntiles; t += gridDim.x) {
    const int mt = t / NT, nt = t % NT;
    const int m0 = mt * 256, n0 = nt * 256;
    const bool lat = mt < 64;
    f32x4 acc[8][4]; zero_acc<8>(acc);
    const bool swap = !(nt >= 8 && nt < 14 && lat);
    const int t2 = t + gridDim.x;
    const bool swap2 = !((t2 % NT) >= 8 && (t2 % NT) < 14 && (t2 / NT) < 64);
    const bool hn = t2 < ntiles && swap2 == swap;
    const u16* nA = hn ? HX + (size_t)(t2 / NT) * 256 * D : nullptr; const u16* nB = WT + (size_t)(t2 % NT) * 256 * D;
    if (swap) gemm_core<true, 256, true>(acc, HX + (size_t)m0 * D, D, WT + (size_t)n0 * D, D, D, (u16*)smem, !pref, nA, D, nB, D);
    else gemm_core<false, 256, false, true>(acc, HX + (size_t)m0 * D, D, WT + (size_t)n0 * D, D, D, (u16*)smem, !pref, nA, D, nB, D);
    pref = hn;
    if (!swap) {
      const int b = m0 >> 12, s0 = m0 & (L - 1);
      u16* HYT = (u16*)(ws + OFF_HYT);
#pragma unroll
      for (int mp = 0; mp < 4; ++mp)
#pragma unroll
        for (int ni = 0; ni < 4; ++ni) {
          int ch = n0 - 2048 + wc * 64 + ni * 16 + lr;
          int s = s0 + wr * 128 + mp * 32 + lg * 8;
          const uint2 lo = pk4(acc[2 * mp][ni]), hi = pk4(acc[2 * mp + 1][ni]);
          *(uint4*)(HYT + ((size_t)(b * 2048 + ch)) * L + s) = make_uint4(lo.x, lo.y, hi.x, hi.y);
        }
      continue;
    }
    const int cs = nt * 4 + wc;
    if (cs == 7) continue;
#pragma unroll
    for (int mi = 0; mi < 8; ++mi) {
      const int r = m0 + wr * 128 + mi * 16 + lr;
      if (cs < 6) {
        u16* dst = (cs < 4) ? (u16*)(ws + OFF_ZQ) + (size_t)r * 256 + cs * 64 : (u16*)(ws + OFF_ZKV) + (size_t)r * 128 + (cs - 4) * 64;
        float ss = 0.f;
#pragma unroll
        for (int np = 0; np < 2; ++np) {
          const f32x4 v = acc[mi][2 * np], v2 = acc[mi][2 * np + 1];
          ss += v[0] * v[0] + v[1] * v[1] + v[2] * v[2] + v[3] * v[3] + v2[0] * v2[0] + v2[1] * v2[1] + v2[2] * v2[2] + v2[3] * v2[3];
          const uint2 lo = pk4(v), hi = pk4(v2);
          *(uint4*)(dst + np * 32 + lg * 8) = make_uint4(lo.x, lo.y, hi.x, hi.y);
        }
        ss += __shfl_xor(ss, 16); ss += __shfl_xor(ss, 32);
        if (lg == 0) {
          int grow = (r < RL) ? g * RL + r : 32768 + g * RC + (r - RL);
          atomicAdd(SSQ + (size_t)(cs < 4 ? 0 : 1) * 34816 + grow, ss);
        }
      } else if (cs == 6) {
        int b, pp; rowinfo(r, b, pp);
        u16* Kb = (u16*)(ws + OFF_K);
        u16* MISC = (u16*)(ws + OFF_MISC);
        {
          f32x4 ve = acc[mi][0], vo = acc[mi][1];
          if (r < RL) { int sidx = r & (L - 1); rope_perm(ve, vo, (lg < 2) ? (sidx >> 6) : (sidx & 63), lg); }
          const uint2 lo = pk4(ve), hi = pk4(vo);
          const uint4 pk = make_uint4(lo.x, lo.y, hi.x, hi.y);
#pragma unroll
          for (int h = 0; h < 8; ++h) *(uint4*)(Kb + ((size_t)(b * 8 + h) * PK + pp) * 96 + 64 + lg * 8) = pk;
          *(uint4*)(MISC + (size_t)r * 64 + lg * 8) = pk;
        }
        {
          const uint2 lo = pk4(acc[mi][2]), hi = pk4(acc[mi][3]);
          *(uint4*)(MISC + (size_t)r * 64 + 32 + lg * 8) = make_uint4(lo.x, lo.y, hi.x, hi.y);
        }
      } else if (cs < 56) {
        u16* dst;
        if (cs < 12) dst = (u16*)(ws + OFF_GQ) + (size_t)r * 256 + (cs - 8) * 64;
        else if (cs < 16) dst = (u16*)(ws + OFF_GK) + (size_t)r * 256 + (cs - 12) * 64;
        else if (cs < 24) dst = (u16*)(ws + OFF_GV) + (size_t)r * 512 + (cs - 16) * 64;
        else if (cs < 32) dst = (u16*)(ws + OFF_GR) + (size_t)r * 512 + (cs - 24) * 64;
        else dst = (u16*)(ws + OFF_HYC) + (size_t)(r - RL) * 1536 + (cs - 32) * 64;
#pragma unroll
        for (int np = 0; np < 2; ++np) {
          const uint2 lo = pk4(acc[mi][2 * np]), hi = pk4(acc[mi][2 * np + 1]);
          *(uint4*)(dst + np * 32 + lg * 8) = make_uint4(lo.x, lo.y, hi.x, hi.y);
        }
      } else {
        u16* dst = (u16*)(ws + OFF_GATES) + (size_t)r * 3072 + (cs - 56) * 64;
#pragma unroll
        for (int np = 0; np < 2; ++np) {
          f32x4 v = acc[mi][2 * np], v2 = acc[mi][2 * np + 1];
#pragma unroll
          for (int e = 0; e < 4; ++e) { v[e] = sigmoidf(v[e]); v2[e] = sigmoidf(v2[e]); }
          const uint2 lo = pk4(v), hi = pk4(v2);
          *(uint4*)(dst + np * 32 + lg * 8) = make_uint4(lo.x, lo.y, hi.x, hi.y);
        }
      }
    }
  }
}

DEV void phase_up(const P& p, int l, int g, char* smem) {
  char* ws = WSP(p.ws);
  const float* SSQ = (const float*)(ws + OFF_SSQ) + (size_t)l * 2 * 34816;
  const int tid = TID(), lane = tid & 63, w = tid >> 6, wr = w >> 1, wc = w & 1, lr = lane & 15, lg = lane >> 4;
  const int ntiles = 68 * 14;
  u16* Qb = (u16*)(ws + OFF_Q); u16* Kb = (u16*)(ws + OFF_K); u16* VT = (u16*)(ws + OFF_VT);
  bool pref = false;
  for (int t = BID(); t < ntiles; t += gridDim.x) {
    const int mt = t / 14, nt = t % 14;
    const int m0 = mt * 256;
    f32x4 acc[4][4]; zero_acc<4>(acc);
    const bool isq = nt < 6;
    const int nk = nt - 6;
    const bool vtile = !isq && nk >= 4;
    const u16* A = isq ? (const u16*)(ws + OFF_ZQ) + (size_t)m0 * 256 : (const u16*)(ws + OFF_ZKV) + (size_t)m0 * 128;
    const u16* B = isq ? (const u16*)(ws + OFF_WUQ) + (size_t)nt * 128 * 256 : (const u16*)(ws + OFF_WUKV) + (size_t)nk * 128 * 128;
    const int K = isq ? 256 : 128;
    const int t2 = t + gridDim.x; const bool hn = t2 < ntiles;
    const int mt2 = t2 / 14, nt2 = t2 % 14; const bool isq2 = nt2 < 6;
    const u16* A2 = isq2 ? (const u16*)(ws + OFF_ZQ) + (size_t)mt2 * 256 * 256 : (const u16*)(ws + OFF_ZKV) + (size_t)mt2 * 256 * 128;
    const u16* B2 = isq2 ? (const u16*)(ws + OFF_WUQ) + (size_t)nt2 * 128 * 256 : (const u16*)(ws + OFF_WUKV) + (size_t)(nt2 - 6) * 128 * 128;
    const int K2 = isq2 ? 256 : 128;
    const bool was = pref; pref = hn;
    if (!vtile) {
      gemm_core<true, 128>(acc, A, K, B, K, K, (u16*)smem, !was, hn ? A2 : nullptr, K2, B2, K2);
#pragma unroll
      for (int mi = 0; mi < 4; ++mi) {
        const int r = m0 + wr * 64 + mi * 16 + lr;
        int b, pp; rowinfo(r, b, pp);
        const int grow = (r < RL) ? g * RL + r : 32768 + g * RC + (r - RL);
        const float sc = isq ? rsqrtf(SSQ[grow] * (1.f / 256.f) + EPS) * (0.10206207261596577f * 1.4426950408889634f)
                             : rsqrtf(SSQ[34816 + grow] * (1.f / 128.f) + EPS);
#pragma unroll
        for (int ni = 0; ni < 4; ++ni) {
          f32x4 v = acc[mi][ni];
#pragma unroll
          for (int e = 0; e < 4; ++e) v[e] *= sc;
          if (!isq) {
            const int h = nk * 2 + wc, d = ni * 16 + lg * 4;
            *(uint2*)(Kb + ((size_t)(b * 8 + h) * PK + pp) * 96 + d) = pk4(v);
          } else if (nt < 4) {
            const int h = nt * 2 + wc, d = ni * 16 + lg * 4;
            *(uint2*)(Qb + ((size_t)(b * 8 + h) * PK + pp) * 96 + d) = pk4(v);
          } else {
            const int h = (nt - 4) * 4 + wc * 2 + (ni >> 1), rr = (ni & 1) * 16 + lg * 4;
            if (r < RL) { int s = r & (L - 1); rope4(v, (rr < 16) ? (s >> 6) : (s & 63), lg); }
            *(uint2*)(Qb + ((size_t)(b * 8 + h) * PK + pp) * 96 + 64 + rr) = pk4(v);
          }
        }
      }
    } else {
      gemm_core<false, 128>(acc, A, K, B, K, K, (u16*)smem, !was, hn ? A2 : nullptr, K2, B2, K2);
#pragma unroll
      for (int mi = 0; mi < 4; ++mi) {
        const int r = m0 + wr * 64 + mi * 16 + lg * 4;
        int b, pp; rowinfo(r, b, pp);
        const int grow = (r < RL) ? g * RL + r : 32768 + g * RC + (r - RL);
        float sc[4];
#pragma unroll
        for (int e = 0; e < 4; ++e) sc[e] = rsqrtf(SSQ[34816 + grow + e] * (1.f / 128.f) + EPS);
#pragma unroll
        for (int ni = 0; ni < 4; ++ni) {
          f32x4 v = acc[mi][ni];
#pragma unroll
          for (int e = 0; e < 4; ++e) v[e] *= sc[e];
          const int h = (nk - 4) * 2 + wc, d = ni * 16 + lr;
          *(uint2*)(VT + ((size_t)(b * 8 + h) * 64 + d) * PK + pp) = pk4(v);
        }
      }
    }
  }
}

DEV void attn_task(const P& p, int b, int h, int qb, bool isctx, char* smem) {
  char* ws = WSP(p.ws);
  const int tid = TID(), lane = tid & 63, w = tid >> 6, lr = lane & 15, lg = lane >> 4;
  const int p0 = isctx ? 0 : LC + qb * 256;
  const int nkeys = isctx ? LC : PK;
  const u16* Qb = (const u16*)(ws + OFF_Q) + ((size_t)(b * 8 + h) * PK) * 96;
  const u16* Kb = (const u16*)(ws + OFF_K) + ((size_t)(b * 8 + h) * PK) * 96;
  const u16* VT = (const u16*)(ws + OFF_VT) + ((size_t)(b * 8 + h) * 64) * PK;
  constexpr int KLD = 104, VLD = 136, KSZ = 128 * KLD, VSZ = 64 * VLD;
  u16* sK = (u16*)smem;
  u16* sV = sK + 2 * KSZ;
  bf16x8 qf[2][3];
#pragma unroll
  for (int qs = 0; qs < 2; ++qs)
#pragma unroll
    for (int ks = 0; ks < 3; ++ks)
      qf[qs][ks] = *(const bf16x8*)(Qb + (size_t)(p0 + w * 32 + qs * 16 + lr) * 96 + ks * 32 + lg * 8);
  f32x4 o[4][2];
#pragma unroll
  for (int i = 0; i < 4; ++i) { o[i][0] = f32x4{0, 0, 0, 0}; o[i][1] = f32x4{0, 0, 0, 0}; }
  float mrun[2] = {-1e30f, -1e30f}, lsum[2] = {0.f, 0.f};
  u32x4 rkA0, rkA1, rkA2, rvA0, rvA1, rkB0, rkB1, rkB2, rvB0, rvB1;
  const int kr0 = tid / 12, kc0 = tid % 12, kr1 = (tid + 512) / 12, kc1 = (tid + 512) % 12, kr2 = (tid + 1024) / 12, kc2 = (tid + 1024) % 12;
  const int vd0 = tid >> 4, vd1 = (tid + 512) >> 4, vc0 = tid & 15;
#define AGLD(S, j0) do { rk##S##0 = *(gu4*)(Kb + (size_t)((j0) + kr0) * 96 + kc0 * 8); rk##S##1 = *(gu4*)(Kb + (size_t)((j0) + kr1) * 96 + kc1 * 8); \
    rk##S##2 = *(gu4*)(Kb + (size_t)((j0) + kr2) * 96 + kc2 * 8); \
    rv##S##0 = *(gu4*)(VT + (size_t)vd0 * PK + (j0) + vc0 * 8); rv##S##1 = *(gu4*)(VT + (size_t)vd1 * PK + (j0) + vc0 * 8); } while (0)
#define ASST(S, st) do { *(u32x4*)(sK + (st) * KSZ + kr0 * KLD + kc0 * 8) = rk##S##0; *(u32x4*)(sK + (st) * KSZ + kr1 * KLD + kc1 * 8) = rk##S##1; \
    *(u32x4*)(sK + (st) * KSZ + kr2 * KLD + kc2 * 8) = rk##S##2; \
    *(u32x4*)(sV + (st) * VSZ + vd0 * VLD + vc0 * 8) = rv##S##0; *(u32x4*)(sV + (st) * VSZ + vd1 * VLD + vc0 * 8) = rv##S##1; } while (0)
#define SOFTMAX(S, QS, PF) do { \
      float mx = -1e30f; \
      _Pragma("unroll") for (int kk = 0; kk < 4; ++kk) \
        _Pragma("unroll") for (int e = 0; e < 4; ++e) mx = fmaxf(mx, S[kk][e]); \
      mx = fmaxf(mx, __shfl_xor(mx, 16)); mx = fmaxf(mx, __shfl_xor(mx, 32)); \
        \
      if (__builtin_amdgcn_ballot_w64(mx > mrun[QS] + 8.f) != 0ull) { \
        const float mn = fmaxf(mrun[QS], mx); \
        const float alpha = __builtin_amdgcn_exp2f(mrun[QS] - mn); \
        mrun[QS] = mn; \
        lsum[QS] *= alpha; \
        _Pragma("unroll") for (int ds = 0; ds < 4; ++ds) \
          _Pragma("unroll") for (int e = 0; e < 4; ++e) o[ds][QS][e] *= alpha; \
      } \
      const float mn = mrun[QS]; \
      float ps = 0.f; \
      _Pragma("unroll") for (int kk = 0; kk < 4; ++kk) \
        _Pragma("unroll") for (int e = 0; e < 4; ++e) { float pv = __builtin_amdgcn_exp2f(S[kk][e] - mn); S[kk][e] = pv; ps += pv; } \
      lsum[QS] += ps; \
      PF[0] = mk8(pk4(S[0]), pk4(S[1])); PF[1] = mk8(pk4(S[2]), pk4(S[3])); } while (0)
#define ATILE(st, hh) do { \
    const u16* k_s = sK + (st) * KSZ + (hh) * 64 * KLD; \
    const u16* v_s = sV + (st) * VSZ + (hh) * 64; \
    f32x4 s0[4], s1[4]; bf16x8 pf0[2], pf1[2]; \
      \
    _Pragma("unroll") for (int kk = 0; kk < 4; ++kk) { \
      s0[kk] = f32x4{0, 0, 0, 0}; \
      _Pragma("unroll") for (int ks = 0; ks < 3; ++ks) \
        s0[kk] = mfma(*(const bf16x8*)(k_s + (kk * 16 + lr) * KLD + ks * 32 + lg * 8), qf[0][ks], s0[kk]); \
    } \
      \
    _Pragma("unroll") for (int kk = 0; kk < 4; ++kk) { \
      s1[kk] = f32x4{0, 0, 0, 0}; \
      _Pragma("unroll") for (int ks = 0; ks < 3; ++ks) \
        s1[kk] = mfma(*(const bf16x8*)(k_s + (kk * 16 + lr) * KLD + ks * 32 + lg * 8), qf[1][ks], s1[kk]); \
    } \
    SOFTMAX(s0, 0, pf0); \
      \
    _Pragma("unroll") for (int k2i = 0; k2i < 2; ++k2i) \
      _Pragma("unroll") for (int ds = 0; ds < 4; ++ds) { \
        const u16* vp = v_s + (ds * 16 + lr) * VLD + k2i * 32 + lg * 4; \
        o[ds][0] = mfma(mk8(*(const uint2*)vp, *(const uint2*)(vp + 16)), pf0[k2i], o[ds][0]); \
      } \
    SOFTMAX(s1, 1, pf1); \
      \
    _Pragma("unroll") for (int k2i = 0; k2i < 2; ++k2i) \
      _Pragma("unroll") for (int ds = 0; ds < 4; ++ds) { \
        const u16* vp = v_s + (ds * 16 + lr) * VLD + k2i * 32 + lg * 4; \
        o[ds][1] = mfma(mk8(*(const uint2*)vp, *(const uint2*)(vp + 16)), pf1[k2i], o[ds][1]); \
      } } while (0)
  const int nt = nkeys >> 7;
  AGLD(B, 0);
  AGLD(A, 128);
  __syncthreads();
  ASST(B, 0);
  __syncthreads();
  for (int kt = 0; kt < nt; kt += 2) {
    if (kt + 2 < nt) AGLD(B, (kt + 2) * 128);
    __builtin_amdgcn_sched_barrier(0);
    ATILE(0, 0);
    ATILE(0, 1);
    __builtin_amdgcn_sched_barrier(0);
    ASST(A, 1);
    __syncthreads();
    if (kt + 3 < nt) AGLD(A, (kt + 3) * 128);
    __builtin_amdgcn_sched_barrier(0);
    ATILE(1, 0);
    ATILE(1, 1);
    __builtin_amdgcn_sched_barrier(0);
    if (kt + 2 < nt) ASST(B, 0);
    __syncthreads();
  }
#undef ATILE
#undef SOFTMAX
#undef AGLD
#undef ASST
  u16* Y = (u16*)(ws + OFF_YMLA);
#pragma unroll
  for (int qs = 0; qs < 2; ++qs) {
    float ls = lsum[qs];
    ls += __shfl_xor(ls, 16); ls += __shfl_xor(ls, 32);
    const float inv = 1.f / ls;
    const int pq = p0 + w * 32 + qs * 16 + lr;
    const int r = isctx ? RL + b * LC + pq : b * L + (pq - LC);
#pragma unroll
    for (int ds = 0; ds < 4; ++ds) {
      f32x4 v = o[ds][qs];
#pragma unroll
      for (int e = 0; e < 4; ++e) v[e] *= inv;
      *(uint2*)(Y + (size_t)r * 512 + h * 64 + ds * 16 + lg * 4) = pk4(v);
    }
  }
}

DEV void gla_task(const P& p, int l, int b, int h, int dir, char* smem) {
  char* ws = WSP(p.ws);
  const int tid = TID(), lane = tid & 63, w = tid >> 6, lr = lane & 15, lg = lane >> 4;
  const u16* GQ = (const u16*)(ws + OFF_GQ); const u16* GK = (const u16*)(ws + OFF_GK);
  const u16* GV = (const u16*)(ws + OFF_GV); const u16* MISC = (const u16*)(ws + OFF_MISC);
  u16* OUT = (u16*)(ws + (dir ? OFF_OB : OFF_OF));
  constexpr int LD = 72, TS = 64 * LD;
  u16* sQ = (u16*)smem; u16* sK = sQ + TS; u16* sKLT = sK + TS; u16* sAL = sKLT + TS; u16* sVT = sAL + TS;
  float* sAf = (float*)(sVT + 2 * TS);
  float* sTot = sAf + 64 * 16;
  float* sEG = sTot + 512;
  const int gk = tid & 63, part = tid >> 6;
  float wa[16];
  {
    const float* W = p.in[I_WA2] + ((size_t)(l * 2 + dir) * 16) * 256 + h * 64 + gk;
#pragma unroll
    for (int r = 0; r < 16; ++r) wa[r] = W[r * 256];
  }
  const float ba = p.in[I_BA][(l * 2 + dir) * 256 + h * 64 + gk];
  f32x4 S[4];
#pragma unroll
  for (int i = 0; i < 4; ++i) S[i] = f32x4{0, 0, 0, 0};
  u32x4 rq0, rk0, rv0, rv1, ra;
  const int si0 = tid >> 3, sch = tid & 7;
  const int vi0 = tid >> 4, vi1 = (tid + 512) >> 4, vch = tid & 15;
#define ROWOF(n, i) ((n) < 4 ? (RL + b * LC + (dir ? (LC - 1 - (64 * (n) + (i))) : (64 * (n) + (i)))) \
                             : (b * L + (dir ? (L - 1 - (64 * ((n) - 4) + (i))) : (64 * ((n) - 4) + (i)))))
#define GGLD(n) do { size_t _r0 = (size_t)ROWOF(n, si0); \
    rq0 = *(gu4*)(GQ + _r0 * 256 + h * 64 + sch * 8); rk0 = *(gu4*)(GK + _r0 * 256 + h * 64 + sch * 8); \
    rv0 = *(gu4*)(GV + (size_t)ROWOF(n, vi0) * 512 + h * 128 + vch * 8); rv1 = *(gu4*)(GV + (size_t)ROWOF(n, vi1) * 512 + h * 128 + vch * 8); \
    if (tid < 128) ra = *(gu4*)(MISC + (size_t)ROWOF(n, tid >> 1) * 64 + 32 + dir * 16 + (tid & 1) * 8); } while (0)
#define VTW(rv, i) do { sVT[(vch * 8 + 0) * LD + (i)] = (u16)((rv).x & 0xffff); sVT[(vch * 8 + 1) * LD + (i)] = (u16)((rv).x >> 16); \
    sVT[(vch * 8 + 2) * LD + (i)] = (u16)((rv).y & 0xffff); sVT[(vch * 8 + 3) * LD + (i)] = (u16)((rv).y >> 16); \
    sVT[(vch * 8 + 4) * LD + (i)] = (u16)((rv).z & 0xffff); sVT[(vch * 8 + 5) * LD + (i)] = (u16)((rv).z >> 16); \
    sVT[(vch * 8 + 6) * LD + (i)] = (u16)((rv).w & 0xffff); sVT[(vch * 8 + 7) * LD + (i)] = (u16)((rv).w >> 16); } while (0)
  ra = u32x4{0u, 0u, 0u, 0u};
  GGLD(0);
  for (int n = 0; n < 68; ++n) {
    __syncthreads();
    *(u32x4*)(sQ + si0 * LD + sch * 8) = rq0;
    *(u32x4*)(sK + si0 * LD + sch * 8) = rk0;
    VTW(rv0, vi0); VTW(rv1, vi1);
    if (tid < 128) {
      float* ap = sAf + (tid >> 1) * 16 + (tid & 1) * 8;
      ap[0] = bf2f((u16)(ra.x & 0xffff)); ap[1] = bf2f((u16)(ra.x >> 16)); ap[2] = bf2f((u16)(ra.y & 0xffff)); ap[3] = bf2f((u16)(ra.y >> 16));
      ap[4] = bf2f((u16)(ra.z & 0xffff)); ap[5] = bf2f((u16)(ra.z >> 16)); ap[6] = bf2f((u16)(ra.w & 0xffff)); ap[7] = bf2f((u16)(ra.w >> 16));
    }
    __syncthreads();
    if (n + 1 < 68) GGLD(n + 1);
    __builtin_amdgcn_sched_barrier(0);
    float pre[8]; float run = 0.f;
#pragma unroll
    for (int ii = 0; ii < 8; ++ii) {
      const int i = part * 8 + ii;
      float x = ba;
#pragma unroll
      for (int r = 0; r < 16; ++r) x += sAf[i * 16 + r] * wa[r];
      float ls = fminf(x, 0.f) * 1.4426950408889634f - __builtin_amdgcn_logf(1.f + __builtin_amdgcn_exp2f(-fabsf(x) * 1.4426950408889634f));
      run += ls * (1.f / 16.f);
      pre[ii] = run;
    }
    sTot[part * 64 + gk] = run;
    __syncthreads();
    float off = 0.f, glast = 0.f;
#pragma unroll
    for (int q = 0; q < 8; ++q) { float tv = sTot[q * 64 + gk]; glast += tv; if (q < part) off += tv; }
    const float eglast = __builtin_amdgcn_exp2f(glast);
    if (part == 0) sEG[gk] = eglast;
    {
      float klt[8];
#pragma unroll
      for (int ii = 0; ii < 8; ++ii) {
        const int i = part * 8 + ii;
        const float G = off + pre[ii];
        float qv = bf2f(sQ[i * LD + gk]), kv = bf2f(sK[i * LD + gk]);
        const float eg = __builtin_amdgcn_exp2f(G), egi = __builtin_amdgcn_exp2f(-G);
        sQ[i * LD + gk] = f2bf(qv * 0.125f * eg);
        sK[i * LD + gk] = f2bf(kv * egi);
        klt[ii] = kv * (eglast * egi);
      }
      *(uint4*)(sKLT + gk * LD + part * 8) = make_uint4(pk2(klt[0], klt[1]), pk2(klt[2], klt[3]), pk2(klt[4], klt[5]), pk2(klt[6], klt[7]));
    }
    __syncthreads();
    {
      const int it = w & 3, jt0 = (w >> 2) * 2;
      bf16x8 qb[2];
#pragma unroll
      for (int m = 0; m < 2; ++m) qb[m] = *(const bf16x8*)(sQ + (it * 16 + lr) * LD + m * 32 + lg * 8);
      const int i = it * 16 + lr;
#pragma unroll
      for (int jj = 0; jj < 2; ++jj) {
        const int jt = jt0 + jj;
        f32x4 c = f32x4{0, 0, 0, 0};
#pragma unroll
        for (int m = 0; m < 2; ++m) c = mfma(*(const bf16x8*)(sK + (jt * 16 + lr) * LD + m * 32 + lg * 8), qb[m], c);
#pragma unroll
        for (int e = 0; e < 4; ++e) { int j = jt * 16 + lg * 4 + e; if (j > i) c[e] = 0.f; }
        *(uint2*)(sAL + i * LD + jt * 16 + lg * 4) = pk4(c);
      }
    }
    __syncthreads();
    {
      bf16x8 sa[2];
#pragma unroll
      for (int m = 0; m < 2; ++m) sa[m] = mk8(pk4(S[2 * m]), pk4(S[2 * m + 1]));
      bf16x8 vtf[2];
#pragma unroll
      for (int m = 0; m < 2; ++m) vtf[m] = *(const bf16x8*)(sVT + (w * 16 + lr) * LD + m * 32 + lg * 8);
      const bool store = (n >= 4) || (l == 0);
#pragma unroll
      for (int it = 0; it < 4; ++it) {
        f32x4 oc = f32x4{0, 0, 0, 0};
#pragma unroll
        for (int m = 0; m < 2; ++m) {
          const u16* qp = sQ + (it * 16 + lr) * LD + m * 32 + lg * 4;
          oc = mfma(sa[m], mk8(*(const uint2*)qp, *(const uint2*)(qp + 16)), oc);
          oc = mfma(vtf[m], *(const bf16x8*)(sAL + (it * 16 + lr) * LD + m * 32 + lg * 8), oc);
        }
        if (store) {
          size_t row = (size_t)ROWOF(n, it * 16 + lr);
          *(uint2*)(OUT + row * 512 + h * 128 + w * 16 + lg * 4) = pk4(oc);
        }
      }
#pragma unroll
      for (int kt = 0; kt < 4; ++kt) {
        f32x4 eg = *(const f32x4*)(sEG + kt * 16 + lg * 4);
        f32x4 c;
#pragma unroll
        for (int e = 0; e < 4; ++e) c[e] = S[kt][e] * eg[e];
#pragma unroll
        for (int m = 0; m < 2; ++m) c = mfma(*(const bf16x8*)(sKLT + (kt * 16 + lr) * LD + m * 32 + lg * 8), vtf[m], c);
        S[kt] = c;
      }
    }
  }
}
#undef ROWOF
#undef GGLD
#undef VTW
struct F8 { float v[8]; };
DEV F8 sconv8(const u16* row, int t0, float w0, float w1, float w2, float bb) {
  const u32x4 q = *(gu4*)(row + t0);
  const float lo = (t0 > 0) ? bf2f(row[t0 - 1]) : 0.f;
  const float hi = (t0 + 8 < L) ? bf2f(row[t0 + 8]) : 0.f;
  float u[10];
  u[0] = lo; u[9] = hi;
  u[1] = bf2f((u16)(q.x & 0xffff)); u[2] = bf2f((u16)(q.x >> 16)); u[3] = bf2f((u16)(q.y & 0xffff)); u[4] = bf2f((u16)(q.y >> 16));
  u[5] = bf2f((u16)(q.z & 0xffff)); u[6] = bf2f((u16)(q.z >> 16)); u[7] = bf2f((u16)(q.w & 0xffff)); u[8] = bf2f((u16)(q.w >> 16));
  F8 r;
#pragma unroll
  for (int j = 0; j < 8; ++j) r.v[j] = bb + w0 * u[j] + w1 * u[j + 1] + w2 * u[j + 2];
  return r;
}
DEV F8 ld8bf(const u16* row, int t0) {
  const u32x4 q = *(gu4*)(row + t0);
  F8 r;
  r.v[0] = bf2f((u16)(q.x & 0xffff)); r.v[1] = bf2f((u16)(q.x >> 16)); r.v[2] = bf2f((u16)(q.y & 0xffff)); r.v[3] = bf2f((u16)(q.y >> 16));
  r.v[4] = bf2f((u16)(q.z & 0xffff)); r.v[5] = bf2f((u16)(q.z >> 16)); r.v[6] = bf2f((u16)(q.w & 0xffff)); r.v[7] = bf2f((u16)(q.w >> 16));
  return r;
}
DEV void st8bf(u16* row, int t0, const F8& a) {
  *(uint4*)(row + t0) = make_uint4(pk2(a.v[0], a.v[1]), pk2(a.v[2], a.v[3]), pk2(a.v[4], a.v[5]), pk2(a.v[6], a.v[7]));
}
DEV void spec_mul(float2* buf, const float2* KSr) {
  const int tid = TID();
  float2 kv[8];
#pragma unroll
  for (int m = 0; m < 8; ++m) kv[m] = KSr[tid + NTH * m];
  const float2 klast = KSr[4096];
#pragma unroll
  for (int m = 0; m < 8; ++m) {
    const int f = tid + NTH * m;
    const int i1 = PADI(brev13(f));
    const float2 z = buf[i1];
    buf[i1] = make_float2(z.x * kv[m].x - z.y * kv[m].y, z.x * kv[m].y + z.y * kv[m].x);
    if (f != 0) {
      const int i2 = PADI(brev13(8192 - f));
      const float2 z2 = buf[i2];
      buf[i2] = make_float2(z2.x * kv[m].x + z2.y * kv[m].y, -z2.x * kv[m].y + z2.y * kv[m].x);
    }
  }
  if (tid == 0) {
    const int i1 = PADI(brev13(4096));
    const float2 z = buf[i1];
    buf[i1] = make_float2(z.x * klast.x - z.y * klast.y, z.x * klast.y + z.y * klast.x);
  }
  __syncthreads();
}
DEV void hyena_task(const P& p, int l, int c, int pr, char* smem) {
  char* ws = WSP(p.ws);
  float2* buf = (float2*)smem;
  const int tid = TID(), t0 = tid * 8;
  u16* HYT = (u16*)(ws + OFF_HYT);
  const float2* KS0 = (const float2*)(ws + OFF_KS) + (size_t)(0 * 512 + c) * KSLD;
  const float2* KS1 = (const float2*)(ws + OFF_KS) + (size_t)(1 * 512 + c) * KSLD;
  const float* sw = p.in[I_HSW] + (size_t)l * 3 * 1536; const float* sb = p.in[I_HSB] + l * 1536;
  const float wx1[4] = {sw[c], sw[1536 + c], sw[3072 + c], sb[c]};
  const float wx2[4] = {sw[512 + c], sw[1536 + 512 + c], sw[3072 + 512 + c], sb[512 + c]};
  const float wv[4] = {sw[1024 + c], sw[1536 + 1024 + c], sw[3072 + 1024 + c], sb[1024 + c]};
  const float bias0 = p.in[I_HYB][(l * 2 + 0) * 512 + c], bias1 = p.in[I_HYB][(l * 2 + 1) * 512 + c];
  {
    const int b0 = 2 * pr, b1 = 2 * pr + 1;
    const u16* x1r0 = HYT + ((size_t)(b0 * 2048 + c)) * L; const u16* x1r1 = HYT + ((size_t)(b1 * 2048 + c)) * L;
    const u16* x2r0 = x1r0 + (size_t)512 * L; const u16* x2r1 = x1r1 + (size_t)512 * L;
    const u16* vr0 = x1r0 + (size_t)1024 * L; const u16* vr1 = x1r1 + (size_t)1024 * L;
    u16* st0 = (u16*)(ws + OFF_YHY) + ((size_t)(b0 * 512 + c)) * L; u16* st1 = (u16*)(ws + OFF_YHY) + ((size_t)(b1 * 512 + c)) * L;
    __syncthreads();
    {
      const F8 va = sconv8(vr0, t0, wv[0], wv[1], wv[2], wv[3]), vb = sconv8(vr1, t0, wv[0], wv[1], wv[2], wv[3]);
#pragma unroll
      for (int j = 0; j < 8; ++j) buf[PADI(t0 + j)] = make_float2(va.v[j], vb.v[j]);
    }
    __syncthreads();
    fft_fwd<true>(buf);
    spec_mul(buf, KS0);
    fft_inv<true>(buf);
    {
      const F8 va = sconv8(vr0, t0, wv[0], wv[1], wv[2], wv[3]), vb = sconv8(vr1, t0, wv[0], wv[1], wv[2], wv[3]);
      const F8 ga = sconv8(x1r0, t0, wx1[0], wx1[1], wx1[2], wx1[3]), gb = sconv8(x1r1, t0, wx1[0], wx1[1], wx1[2], wx1[3]);
      F8 ya, yb;
#pragma unroll
      for (int j = 0; j < 8; ++j) {
        const float2 cv = buf[PADI(t0 + j)];
        ya.v[j] = ga.v[j] * (cv.x + bias0 * va.v[j]); yb.v[j] = gb.v[j] * (cv.y + bias0 * vb.v[j]);
        buf[PADI(t0 + j)] = make_float2(ya.v[j], yb.v[j]);
      }
      st8bf(st0, t0, ya); st8bf(st1, t0, yb);
    }
    __syncthreads();
    fft_fwd<true>(buf);
    spec_mul(buf, KS1);
    fft_inv<true>(buf);
    {
      u16* o0 = HYT + ((size_t)(b0 * 2048 + 1536 + c)) * L; u16* o1 = HYT + ((size_t)(b1 * 2048 + 1536 + c)) * L;
      const F8 ga = sconv8(x2r0, t0, wx2[0], wx2[1], wx2[2], wx2[3]), gb = sconv8(x2r1, t0, wx2[0], wx2[1], wx2[2], wx2[3]);
      const F8 sa = ld8bf(st0, t0), sbb = ld8bf(st1, t0);
      F8 oa, ob;
#pragma unroll
      for (int j = 0; j < 8; ++j) {
        const float2 cv = buf[PADI(t0 + j)];
        oa.v[j] = ga.v[j] * (cv.x + bias1 * sa.v[j]); ob.v[j] = gb.v[j] * (cv.y + bias1 * sbb.v[j]);
      }
      st8bf(o0, t0, oa); st8bf(o1, t0, ob);
    }
  }
  __syncthreads();
}

DEV void hyena_ctx_task(const P& p, int c, char* smem) {
  char* ws = WSP(p.ws);
  float* hf0 = (float*)smem; float* hb0 = hf0 + 256; float* hf1 = hb0 + 256; float* hb1 = hf1 + 256;
  float* sv = hb1 + 256;
  float* sy1 = sv + 512;
  const int tid = TID(), t = tid & 255, bs = tid >> 8;
  const float* KFC = (const float*)(ws + OFF_KFC);
  const float* NRM = (const float*)(ws + OFF_NORMC);
  const float in0 = 1.f / NRM[c], in1 = 1.f / NRM[512 + c];
  __syncthreads();
  if (bs == 0) {
    hf0[t] = KFC[((size_t)(0 * 2 + 0) * 512 + c) * LC + t] * in0; hb0[t] = KFC[((size_t)(0 * 2 + 1) * 512 + c) * LC + t] * in0;
    hf1[t] = KFC[((size_t)(1 * 2 + 0) * 512 + c) * LC + t] * in1; hb1[t] = KFC[((size_t)(1 * 2 + 1) * 512 + c) * LC + t] * in1;
  }
  const float* sw = p.in[I_HSW]; const float* sb = p.in[I_HSB];
  const float bias0 = p.in[I_HYB][c], bias1 = p.in[I_HYB][512 + c];
  const u16* HYC = (const u16*)(ws + OFF_HYC);
  u16* YHY = (u16*)(ws + OFF_YHY);
  for (int bi = 0; bi < NB / 2; ++bi) {
    const int b = bi * 2 + bs;
    const u16* base = HYC + (size_t)(b * LC) * 1536;
    float u[3];
#pragma unroll
    for (int k = 0; k < 3; ++k) {
      int ch = k * 512 + c;
      float cc = bf2f(base[(size_t)t * 1536 + ch]);
      float a = (t > 0) ? bf2f(base[(size_t)(t - 1) * 1536 + ch]) : 0.f;
      float d = (t < LC - 1) ? bf2f(base[(size_t)(t + 1) * 1536 + ch]) : 0.f;
      u[k] = sb[ch] + sw[ch] * a + sw[1536 + ch] * cc + sw[3072 + ch] * d;
    }
    __syncthreads();
    sv[bs * 256 + t] = u[2];
    __syncthreads();
    float a0 = 0.f;
    for (int s = 0; s < LC; ++s) a0 += ((s <= t) ? hf0[t - s] : hb0[s - t]) * sv[bs * 256 + s];
    const float y1 = u[0] * (a0 + bias0 * u[2]);
    sy1[bs * 256 + t] = y1;
    __syncthreads();
    float a1 = 0.f;
    for (int s = 0; s < LC; ++s) a1 += ((s <= t) ? hf1[t - s] : hb1[s - t]) * sy1[bs * 256 + s];
    const float y2 = u[1] * (a1 + bias1 * y1);
    YHY[(size_t)(RL + b * LC + t) * 512 + c] = f2bf(y2);
  }
  __syncthreads();
}

DEV void phase_mix(const P& p, int l, int g, char* smem, int rep = 0) {
  unsigned* cnt = (unsigned*)(p.ws + OFF_CNT) + (rep * 4 + l * 2 + g);
  volatile int* s_taskp = (volatile int*)(smem + SMEM_BYTES + 16);
  const int n_gla = 32, n_hy = 1024, n_hyc = (l == 0) ? 512 : 0, n_at = 512, n_atc = (l == 0) ? 32 : 0;
  const int total = n_gla + n_hy + n_hyc + n_at + n_atc;
  fft_build_tw(smem);
  for (;;) {
    __syncthreads();
    if (TID() == 0) *s_taskp = (int)atomicAdd(cnt, 1u);
    __syncthreads();
    int t = *s_taskp;
    if (t >= total) break;
    if (t < n_gla) { gla_task(p, l, t >> 3, (t >> 1) & 3, t & 1, smem); continue; }
    t -= n_gla;
    if (t < n_at) { attn_task(p, t >> 7, (t >> 4) & 7, t & 15, false, smem); continue; }
    t -= n_at;
    if (t < n_hy) { hyena_task(p, l, t >> 1, t & 1, smem); continue; }
    t -= n_hy;
    if (t < n_atc) { attn_task(p, t >> 3, t & 7, 0, true, smem); continue; }
    t -= n_atc;
    hyena_ctx_task(p, t, smem);
  }
}

DEV void phase_post(const P& p, int l, int g, char* smem) {
  char* ws = WSP(p.ws);
  const int tid = TID();
  {
    u16* tile = (u16*)smem;
    const u16* HYT = (const u16*)(ws + OFF_HYT); u16* YHY = (u16*)(ws + OFF_YHY);
    u32x4 q0, q1;
    const int ecc0 = tid >> 4, ecc1 = (tid + NTH) >> 4, ech = tid & 15;
#define TLOAD(itx) do { const int _b = (itx) >> 8, _ct = ((itx) >> 5) & 7, _tt = (itx) & 31; \
      q0 = *(gu4*)(HYT + ((size_t)(_b * 2048 + 1536 + _ct * 64 + ecc0)) * L + _tt * 128 + ech * 8); \
      q1 = *(gu4*)(HYT + ((size_t)(_b * 2048 + 1536 + _ct * 64 + ecc1)) * L + _tt * 128 + ech * 8); } while (0)
    int it = BID();
    if (it < NB * 8 * 32) TLOAD(it);
    while (it < NB * 8 * 32) {
      const int b = it >> 8, ct = (it >> 5) & 7, tt = it & 31;
      __syncthreads();
      { unsigned* d0 = (unsigned*)(tile + ecc0 * 130 + ech * 8); d0[0] = q0.x; d0[1] = q0.y; d0[2] = q0.z; d0[3] = q0.w;
        unsigned* d1 = (unsigned*)(tile + ecc1 * 130 + ech * 8); d1[0] = q1.x; d1[1] = q1.y; d1[2] = q1.z; d1[3] = q1.w; }
      __syncthreads();
      const int itn = it + gridDim.x;
      if (itn < NB * 8 * 32) TLOAD(itn);
#pragma unroll
      for (int u = 0; u < 2; ++u) { const int e = tid + NTH * u, t2 = e >> 3, c8 = (e & 7) * 8;
        unsigned w0 = (unsigned)tile[(c8 + 0) * 130 + t2] | ((unsigned)tile[(c8 + 1) * 130 + t2] << 16);
        unsigned w1 = (unsigned)tile[(c8 + 2) * 130 + t2] | ((unsigned)tile[(c8 + 3) * 130 + t2] << 16);
        unsigned w2 = (unsigned)tile[(c8 + 4) * 130 + t2] | ((unsigned)tile[(c8 + 5) * 130 + t2] << 16);
        unsigned w3 = (unsigned)tile[(c8 + 6) * 130 + t2] | ((unsigned)tile[(c8 + 7) * 130 + t2] << 16);
        *(uint4*)(YHY + (size_t)(b * L + tt * 128 + t2) * 512 + ct * 64 + c8) = make_uint4(w0, w1, w2, w3); }
      it = itn;
    }
#undef TLOAD
  }
  {
    const int nrows = (l == 0) ? RG : RL;
    const int gw = BID() * 8 + (tid >> 6), NW = gridDim.x * 8, lane = tid & 63;
    u16* OF = (u16*)(ws + OFF_OF); const u16* OB = (const u16*)(ws + OFF_OB); const u16* GR = (const u16*)(ws + OFF_GR);
    const float* gn = p.in[I_GONORM] + l * 128;
    for (int r0 = gw; r0 < nrows; r0 += 2 * NW) {
      const int r1 = (r0 + NW < nrows) ? r0 + NW : r0;
      uint4 A0 = *(const uint4*)(OF + (size_t)r0 * 512 + lane * 8), B0 = *(const uint4*)(OB + (size_t)r0 * 512 + lane * 8), R0 = *(const uint4*)(GR + (size_t)r0 * 512 + lane * 8);
      uint4 A1 = *(const uint4*)(OF + (size_t)r1 * 512 + lane * 8), B1 = *(const uint4*)(OB + (size_t)r1 * 512 + lane * 8), R1 = *(const uint4*)(GR + (size_t)r1 * 512 + lane * 8);
      const int v0 = (lane & 15) * 8;
#pragma unroll
      for (int k = 0; k < 2; ++k) {
        const uint4 a = k ? A1 : A0, bb = k ? B1 : B0, rr = k ? R1 : R0;
        unsigned av[4] = {a.x, a.y, a.z, a.w}, bv[4] = {bb.x, bb.y, bb.z, bb.w}, rv[4] = {rr.x, rr.y, rr.z, rr.w};
        float o[8]; float ss = 0.f;
#pragma unroll
        for (int e = 0; e < 4; ++e) {
          o[2 * e] = bf2f((u16)(av[e] & 0xffff)) + bf2f((u16)(bv[e] & 0xffff));
          o[2 * e + 1] = bf2f((u16)(av[e] >> 16)) + bf2f((u16)(bv[e] >> 16));
          ss += o[2 * e] * o[2 * e] + o[2 * e + 1] * o[2 * e + 1];
        }
        ss += __shfl_xor(ss, 1); ss += __shfl_xor(ss, 2); ss += __shfl_xor(ss, 4); ss += __shfl_xor(ss, 8);
        const float rstd = rsqrtf(ss * (1.f / 128.f) + EPS);
        float y[8];
#pragma unroll
        for (int e = 0; e < 4; ++e) {
          float q0 = bf2f((u16)(rv[e] & 0xffff)), q1 = bf2f((u16)(rv[e] >> 16));
          y[2 * e] = o[2 * e] * rstd * gn[v0 + 2 * e] * (q0 * sigmoidf(q0));
          y[2 * e + 1] = o[2 * e + 1] * rstd * gn[v0 + 2 * e + 1] * (q1 * sigmoidf(q1));
        }
        if (k == 0 || r1 != r0)
          *(uint4*)(OF + (size_t)(k ? r1 : r0) * 512 + lane * 8) = make_uint4(pk2(y[0], y[1]), pk2(y[2], y[3]), pk2(y[4], y[5]), pk2(y[6], y[7]));
      }
    }
  }
}

DEV bool tile_swz8(int i, int MT, int& mt, int& nt) {
  if (gridDim.x != 256) { int t = BID() + i * gridDim.x; mt = t >> 3; nt = t & 7; return t < MT * 8; }
  const int b = BID(), x = b & 7, j = b >> 3, tl = i * 32 + j;
  nt = tl & 7; mt = (tl >> 3) * 8 + x;
  return mt < MT;
}
DEV int tile_swz8_rounds(int MT) { return (gridDim.x != 256) ? (MT * 8 + gridDim.x - 1) / gridDim.x : (((MT + 7) >> 3) * 8 + 31) / 32; }

DEV void phase_merge(const P& p, int l, int g, char* smem) {
  char* ws = WSP(p.ws);
  const int tid = TID(), lane = tid & 63, w = tid >> 6, wr = w >> 1, wc = w & 1, lr = lane & 15, lg = lane >> 4;
  const int MT = (l == 0) ? 68 : 64;
  const u16* GATES = (const u16*)(ws + OFF_GATES);
  u16* M = (u16*)(ws + OFF_HX);
  const int nrounds = tile_swz8_rounds(MT);
  bool first = true;
  for (int it = 0; it < nrounds; ++it) {
    int mt, nt;
    if (!tile_swz8(it, MT, mt, nt)) continue;
    const int m0 = mt * 256, n0 = nt * 128;
    int mt2 = 0, nt2 = 0; bool hn = false;
    for (int i2 = it + 1; i2 < nrounds && !hn; ++i2) hn = tile_swz8(i2, MT, mt2, nt2);
    f32x4 macc[4][4]; zero_acc<4>(macc);
#pragma unroll 1
    for (int br = 0; br < 3; ++br) {
      const u16* Y = (const u16*)(ws + (br == 0 ? OFF_YMLA : (br == 1 ? OFF_OF : OFF_YHY)));
      const u16* W = (const u16*)(ws + (br == 0 ? OFF_WOM : (br == 1 ? OFF_WOG : OFF_WOH)));
      const int nb = (br + 1) % 3;
      const u16* Y2 = (const u16*)(ws + (nb == 0 ? OFF_YMLA : (nb == 1 ? OFF_OF : OFF_YHY)));
      const u16* W2 = (const u16*)(ws + (nb == 0 ? OFF_WOM : (nb == 1 ? OFF_WOG : OFF_WOH)));
      const bool hn2 = (br < 2) || hn;
      const int m2 = (br < 2) ? m0 : mt2 * 256, n2 = (br < 2) ? n0 : nt2 * 128;
      f32x4 acc[4][4]; zero_acc<4>(acc);
      gemm_core<true, 128, true>(acc, Y + (size_t)m0 * 512, 512, W + (size_t)n0 * 512, 512, 512, (u16*)smem, first,
                                 hn2 ? Y2 + (size_t)m2 * 512 : nullptr, 512, W2 + (size_t)n2 * 512, 512);
      first = false;
#pragma unroll
      for (int mi = 0; mi < 4; ++mi) {
        const int r = m0 + wr * 64 + mi * 16 + lr;
#pragma unroll
        for (int np = 0; np < 2; ++np) {
          const uint4 gg = *(const uint4*)(GATES + (size_t)r * 3072 + br * 1024 + n0 + wc * 64 + np * 32 + lg * 8);
          macc[mi][2 * np][0] += acc[mi][2 * np][0] * bf2f((u16)(gg.x & 0xffff));
          macc[mi][2 * np][1] += acc[mi][2 * np][1] * bf2f((u16)(gg.x >> 16));
          macc[mi][2 * np][2] += acc[mi][2 * np][2] * bf2f((u16)(gg.y & 0xffff));
          macc[mi][2 * np][3] += acc[mi][2 * np][3] * bf2f((u16)(gg.y >> 16));
          macc[mi][2 * np + 1][0] += acc[mi][2 * np + 1][0] * bf2f((u16)(gg.z & 0xffff));
          macc[mi][2 * np + 1][1] += acc[mi][2 * np + 1][1] * bf2f((u16)(gg.z >> 16));
          macc[mi][2 * np + 1][2] += acc[mi][2 * np + 1][2] * bf2f((u16)(gg.w & 0xffff));
          macc[mi][2 * np + 1][3] += acc[mi][2 * np + 1][3] * bf2f((u16)(gg.w >> 16));
        }
      }
    }
#pragma unroll
    for (int mi = 0; mi < 4; ++mi) {
      const int r = m0 + wr * 64 + mi * 16 + lr;
#pragma unroll
      for (int np = 0; np < 2; ++np) {
        const uint2 lo = pk4(macc[mi][2 * np]), hi = pk4(macc[mi][2 * np + 1]);
        *(uint4*)(M + (size_t)r * D + n0 + wc * 64 + np * 32 + lg * 8) = make_uint4(lo.x, lo.y, hi.x, hi.y);
      }
    }
  }
}

DEV void xs_ptrs(const P& p, int l, int g, const float*& srcl, const float*& srcc, float*& dstl, float*& dstc, bool first) {
  dstl = p.out + (size_t)g * RL * D;
  dstc = (float*)(p.ws + OFF_CTXS) + (size_t)g * RC * D;
  if (first && l == 0) { srcl = p.in[I_X] + (size_t)g * RL * D; srcc = p.in[I_CTX] + (size_t)g * RC * D; }
  else { srcl = dstl; srcc = dstc; }
}
DEV void phase_resid(const P& p, int l, int g, char* smem, bool isout) {
  char* ws = WSP(p.ws);
  const int tid = TID(), lane = tid & 63, w = tid >> 6, wr = w >> 1, wc = w & 1, lr = lane & 15, lg = lane >> 4;
  const int MT = (l == 0) ? 68 : 64;
  const float *srcl, *srcc; float *dstl, *dstc;
  xs_ptrs(p, l, g, srcl, srcc, dstl, dstc, isout);
  const u16* A = (const u16*)(ws + (isout ? OFF_HX : OFF_H));
  const u16* W = (const u16*)(ws + (isout ? OFF_WOUT : OFF_W2));
  const int K = isout ? 1024 : 4096;
  const float* MOD = (const float*)(ws + OFF_MOD) + (size_t)l * 9 * 6144;
  const int goff = isout ? 2048 : 5120;
  const int nrounds = tile_swz8_rounds(MT);
  bool first = true;
  for (int it = 0; it < nrounds; ++it) {
    int mt, nt;
    if (!tile_swz8(it, MT, mt, nt)) continue;
    const int m0 = mt * 256, n0 = nt * 128;
    int mt2 = 0, nt2 = 0; bool hn = false;
    for (int i2 = it + 1; i2 < nrounds && !hn; ++i2) hn = tile_swz8(i2, MT, mt2, nt2);
    f32x4 acc[4][4]; zero_acc<4>(acc);
    gemm_core<true, 128>(acc, A + (size_t)m0 * K, K, W + (size_t)n0 * K, K, K, (u16*)smem, first,
                         hn ? A + (size_t)mt2 * 256 * K : nullptr, K, W + (size_t)nt2 * 128 * K, K);
    first = false;
    const float* gate = MOD + (size_t)((m0 < RL) ? (g * NB + (m0 >> 12)) : 8) * 6144 + goff + n0 + wc * 64 + lg * 4;
    f32x4 gv[4];
#pragma unroll
    for (int ni = 0; ni < 4; ++ni) gv[ni] = *(const f32x4*)(gate + ni * 16);
    f32x4 xv[4][4];
#pragma unroll
    for (int mi = 0; mi < 4; ++mi) {
      const int r = m0 + wr * 64 + mi * 16 + lr;
      const float* src = (r < RL) ? srcl + (size_t)r * D : srcc + (size_t)(r - RL) * D;
#pragma unroll
      for (int ni = 0; ni < 4; ++ni) xv[mi][ni] = *(const f32x4*)(src + n0 + wc * 64 + ni * 16 + lg * 4);
    }
#pragma unroll
    for (int mi = 0; mi < 4; ++mi) {
      const int r = m0 + wr * 64 + mi * 16 + lr;
      float* dst = (r < RL) ? dstl + (size_t)r * D : dstc + (size_t)(r - RL) * D;
#pragma unroll
      for (int ni = 0; ni < 4; ++ni) {
        f32x4 y;
#pragma unroll
        for (int e = 0; e < 4; ++e) y[e] = xv[mi][ni][e] + gv[ni][e] * acc[mi][ni][e];
        *(f32x4*)(dst + n0 + wc * 64 + ni * 16 + lg * 4) = y;
      }
    }
  }
}
DEV void phase_mlp1(const P& p, int l, int g, char* smem) {
  char* ws = WSP(p.ws);
  const int tid = TID(), lane = tid & 63, w = tid >> 6, wr = w >> 2, wc = w & 3, lr = lane & 15, lg = lane >> 4;
  const int MT = (l == 0) ? 68 : 64, ntiles = MT * 16;
  const u16* A = (const u16*)(ws + OFF_HX); const u16* W = (const u16*)(ws + OFF_W1); u16* H = (u16*)(ws + OFF_H);
  for (int t = BID(); t < ntiles; t += gridDim.x) {
    const int mt = t >> 4, nt = t & 15, m0 = mt * 256, n0 = nt * 256;
    const int t2 = t + gridDim.x; const bool hn = t2 < ntiles;
    f32x4 acc[8][4]; zero_acc<8>(acc);
    gemm_core<true, 256, true>(acc, A + (size_t)m0 * D, D, W + (size_t)n0 * D, D, D, (u16*)smem, t == BID(),
                               hn ? A + (size_t)(t2 >> 4) * 256 * D : nullptr, D, W + (size_t)(t2 & 15) * 256 * D, D);
#pragma unroll
    for (int mi = 0; mi < 8; ++mi) {
      const int r = m0 + wr * 128 + mi * 16 + lr;
#pragma unroll
      for (int np = 0; np < 2; ++np) {
        f32x4 v = acc[mi][2 * np], v2 = acc[mi][2 * np + 1];
#pragma unroll
        for (int e = 0; e < 4; ++e) { float x = fmaxf(v[e], 0.f); v[e] = x * x; float y = fmaxf(v2[e], 0.f); v2[e] = y * y; }
        const uint2 lo = pk4(v), hi = pk4(v2);
        *(uint4*)(H + (size_t)r * DFF + n0 + wc * 64 + np * 32 + lg * 8) = make_uint4(lo.x, lo.y, hi.x, hi.y);
      }
    }
  }
}

DEV void phase_final(const P& p) {
  const int gw = BID() * 8 + (TID() >> 6), NW = gridDim.x * 8, lane = TID() & 63;
  const float* gain = p.in[I_FNG];
  f32x4 gg[4];
#pragma unroll
  for (int j = 0; j < 4; ++j) gg[j] = *(const f32x4*)(gain + j * 256 + lane * 4);
  for (int r = gw; r < 32768; r += 2 * NW) {
    float* s0 = p.out + (size_t)r * D; float* s1 = p.out + (size_t)(r + NW) * D;
    f32x4 a[4], b[4]; float sa = 0.f, sb = 0.f;
#pragma unroll
    for (int j = 0; j < 4; ++j) { a[j] = *(const f32x4*)(s0 + j * 256 + lane * 4); b[j] = *(const f32x4*)(s1 + j * 256 + lane * 4); }
#pragma unroll
    for (int j = 0; j < 4; ++j) {
      sa += a[j][0] * a[j][0] + a[j][1] * a[j][1] + a[j][2] * a[j][2] + a[j][3] * a[j][3];
      sb += b[j][0] * b[j][0] + b[j][1] * b[j][1] + b[j][2] * b[j][2] + b[j][3] * b[j][3];
    }
    const float ra = rsqrtf(wave_sum(sa) * (1.f / D) + EPS), rb = rsqrtf(wave_sum(sb) * (1.f / D) + EPS);
#pragma unroll
    for (int j = 0; j < 4; ++j) {
      f32x4 ya, yb;
#pragma unroll
      for (int e = 0; e < 4; ++e) { ya[e] = a[j][e] * ra * gg[j][e]; yb[e] = b[j][e] * rb * gg[j][e]; }
      *(f32x4*)(s0 + j * 256 + lane * 4) = ya;
      *(f32x4*)(s1 + j * 256 + lane * 4) = yb;
    }
  }
}

#define XB_TMO      128
#define XB_XCNT(j)  (256  + 64 * (j))
#define XB_XSUB(j)  (1280 + 64 * (j))
#define XB_XGEN(j)  (2304 + 64 * (j))
#define XB_TOP      3328
#define XB_TOPGEN   3392
#define XCD_BAR_WORDS 3456
#define XB_SPIN_CAP (1u << 22)
DEV unsigned xb_ld(unsigned* p) { return __hip_atomic_load(p, __ATOMIC_RELAXED, __HIP_MEMORY_SCOPE_AGENT); }
DEV unsigned xb_add(unsigned* p, unsigned v) { return __hip_atomic_fetch_add(p, v, __ATOMIC_RELAXED, __HIP_MEMORY_SCOPE_AGENT); }
DEV unsigned xb_xcc_id() { return (unsigned)__builtin_amdgcn_s_getreg((3 << 11) | 20) & 0xFu; }
#define XB_SPIN(cond, bar) do { unsigned _sp = 0; while (cond) { __builtin_amdgcn_s_sleep(1); \
    if ((++_sp & 255u) == 0u) { if (xb_ld(&(bar)[XB_TMO])) break; if (_sp > XB_SPIN_CAP) { atomicAdd(&(bar)[XB_TMO], 1u); break; } } } } while (0)
struct XcdBarrier { unsigned* bar; unsigned x; volatile LAS unsigned* st; };
DEV XcdBarrier xcd_barrier_post(unsigned* bar, volatile LAS unsigned* st) {
  XcdBarrier b; b.bar = bar; b.x = xb_xcc_id(); b.st = st;
  if (threadIdx.x == 0) (void)xb_add(&bar[XB_XCNT(b.x)], 1u);
  return b;
}
DEV void xcd_barrier_complete(unsigned* bar, unsigned x, unsigned& nloc, unsigned& nx) {
  const unsigned G = gridDim.x * gridDim.y * gridDim.z;
  unsigned sum, cnt, mine, sp = 0u;
  for (;;) {
    sum = 0u; cnt = 0u; mine = 0u;
#pragma unroll
    for (unsigned j = 0; j < 16; ++j) { const unsigned c = xb_ld(&bar[XB_XCNT(j)]); sum += c; cnt += (c > 0u) ? 1u : 0u; mine = (j == x) ? c : mine; }
    if (sum == G) break;
    __builtin_amdgcn_s_sleep(1);
    if ((++sp & 255u) == 0u) { if (xb_ld(&bar[XB_TMO])) break; if (sp > XB_SPIN_CAP) { atomicAdd(&bar[XB_TMO], 1u); break; } }
  }
  nloc = mine > 0u ? mine : 1u; nx = cnt > 0u ? cnt : 1u;
}
DEV void xcd_barrier(const XcdBarrier& b) {
  asm volatile("s_waitcnt vmcnt(0)" ::: "memory");
  __syncthreads();
  if (threadIdx.x == 0) {
    unsigned* bar = b.bar;
    __builtin_amdgcn_s_waitcnt(0);
    unsigned nloc = b.st[0], nx = b.st[1];
    if (nloc == 0u) { xcd_barrier_complete(bar, b.x, nloc, nx); b.st[0] = nloc; b.st[1] = nx; }
    const unsigned old = xb_add(&bar[XB_XSUB(b.x)], 1u);
    const unsigned gen = old / nloc;
    if (old + 1u == (gen + 1u) * nloc) {
      __builtin_amdgcn_fence(__ATOMIC_RELEASE, "agent");
      asm volatile("s_waitcnt vmcnt(0)" ::: "memory");
      const unsigned og = xb_add(&bar[XB_TOP], 1u);
      const unsigned tg = og / nx;
      if (og + 1u == (tg + 1u) * nx) xb_add(&bar[XB_TOPGEN], 1u);
      else XB_SPIN(xb_ld(&bar[XB_TOPGEN]) == tg, bar);
      __builtin_amdgcn_fence(__ATOMIC_ACQUIRE, "agent");
      xb_add(&bar[XB_XGEN(b.x)], 1u);
      asm volatile("s_waitcnt vmcnt(0)" ::: "memory");
    } else {
      XB_SPIN(xb_ld(&bar[XB_XGEN(b.x)]) == gen, bar);
      __builtin_amdgcn_fence(__ATOMIC_ACQUIRE, "agent");
      asm volatile("s_waitcnt vmcnt(0)" ::: "memory");
    }
  }
  __syncthreads();
}

DEV void run_phase(const P& p, int ph, char* smem) {
#if !defined(ONLY_SUB) || ONLY_SUB == 10
  if (ph == 0) { phase_prep(p, 0, smem); return; }
  if (ph == 21) { phase_prep(p, 1, smem); return; }
#endif
#if !defined(ONLY_SUB) || ONLY_SUB == 11
  if (ph == 42) { phase_final(p); return; }
#endif
  const int l = ph > 21 ? 1 : 0;
  const int q = ph - (l ? 22 : 1);
  const int g = q / 10, sub = q % 10;
  const float* MOD = (const float*)(p.ws + OFF_MOD) + (size_t)l * 9 * 6144;
  switch (sub) {
#if !defined(ONLY_SUB) || ONLY_SUB == 0
    case 0: {
      if (g == 0) { fft_build_tw(smem); for (int c = BID(); c < 512; c += gridDim.x) filtfft_task(p, l, c, smem); }
      const float *srcl, *srcc; float *dl, *dc;
      xs_ptrs(p, l, g, srcl, srcc, dl, dc, true);
      norm_rows(srcl, srcc, p.in[I_N1G] + l * D, MOD + (size_t)(g * NB) * 6144, MOD + (size_t)8 * 6144, 0, (u16*)(p.ws + OFF_HX), RG);
    } break;
#endif
#if !defined(ONLY_SUB) || ONLY_SUB == 1
    case 1: phase_win(p, l, g, smem); break;
#endif
#if !defined(ONLY_SUB) || ONLY_SUB == 2
    case 2: phase_up(p, l, g, smem); break;
#endif
#if !defined(ONLY_SUB) || ONLY_SUB == 3
    case 3: phase_mix(p, l, g, smem); break;
#endif
#if !defined(ONLY_SUB) || ONLY_SUB == 4
    case 4: phase_post(p, l, g, smem); break;
#endif
#if !defined(ONLY_SUB) || ONLY_SUB == 5
    case 5: phase_merge(p, l, g, smem); break;
#endif
#if !defined(ONLY_SUB) || ONLY_SUB == 6
    case 6: phase_resid(p, l, g, smem, true); break;
#endif
#if !defined(ONLY_SUB) || ONLY_SUB == 7
    case 7: {
      const float *srcl, *srcc; float *dl, *dc;
      xs_ptrs(p, l, g, srcl, srcc, dl, dc, false);
      norm_rows(srcl, srcc, p.in[I_N2G] + l * D, MOD + (size_t)(g * NB) * 6144, MOD + (size_t)8 * 6144, 3072, (u16*)(p.ws + OFF_HX), (l == 0) ? RG : RL);
    } break;
#endif
#if !defined(ONLY_SUB) || ONLY_SUB == 8
    case 8: phase_mlp1(p, l, g, smem); break;
#endif
#if !defined(ONLY_SUB) || ONLY_SUB == 9
    case 9: phase_resid(p, l, g, smem, false); break;
#endif
  }
}

__global__ void __launch_bounds__(512) mega(P p) {
  __shared__ __attribute__((aligned(16))) char smem[SMEM_BYTES + 32];
  cg::grid_group grid = cg::this_grid();
  if (threadIdx.x == 0) *(uint4*)(smem + SMEM_BYTES) = make_uint4(0u, 0u, 0u, 0u);
  __syncthreads();
  XcdBarrier xb = xcd_barrier_post((unsigned*)(p.ws + OFF_BAR), (volatile LAS unsigned*)(smem + SMEM_BYTES));
  if (p.ph_hi > 1000) grid.sync();
  for (int ph = p.ph_lo; ph < p.ph_hi; ++ph) {
    run_phase(p, ph, smem);
    if (ph + 1 < p.ph_hi) xcd_barrier(xb);
  }
}

extern "C" void kernel_launch(void* const* d_in, const int* in_sizes, int n_in, void* d_out, int out_size, void* d_ws, size_t ws_size,
                              hipStream_t stream) {
  static int grid_blocks = 0;
  if (!grid_blocks) {
    int dev = 0, cus = 0, per_cu = 0;
    hipGetDevice(&dev);
    hipDeviceGetAttribute(&cus, hipDeviceAttributeMultiprocessorCount, dev);
    hipOccupancyMaxActiveBlocksPerMultiprocessor(&per_cu, mega, NTH, 0);
    per_cu = 1;
    grid_blocks = cus * per_cu;
    if (ws_size < WS_NEED) { fprintf(stderr, "workspace too small: %zu < %zu\n", ws_size, (size_t)WS_NEED); grid_blocks = -1; }
  }
  if (grid_blocks < 0 || n_in != 32) return;
  hipMemsetAsync(d_ws, 0, CTRL_BYTES, stream);
  P p{};
  for (int i = 0; i < 32; ++i) p.in[i] = (const float*)d_in[i];
  p.out = (float*)d_out; p.ws = (char*)d_ws;
#if SINGLE_LAUNCH
  p.ph_lo = 0; p.ph_hi = NPHASE;
  void* args[] = {&p};
  hipError_t e = hipLaunchCooperativeKernel((void*)mega, dim3(grid_blocks), dim3(NTH), args, 0, stream);
  if (e != hipSuccess) fprintf(stderr, "cooperative launch failed: %s (grid %d)\n", hipGetErrorString(e), grid_blocks);
#else
  for (int ph = 0; ph < NPHASE; ++ph) {
    p.ph_lo = ph; p.ph_hi = ph + 1;
    hipLaunchKernelGGL(mega, dim3(grid_blocks), dim3(NTH), 0, stream, p);
  }
#endif
}
```

```cpp
#include <hip/hip_runtime.h>
#include <hip/hip_bf16.h>
#include <hip/hip_cooperative_groups.h>
#include <cstdio>
namespace cg = cooperative_groups;

typedef unsigned short u16;
typedef __attribute__((ext_vector_type(8))) short bf16x8;
typedef __attribute__((ext_vector_type(4))) float f32x4;
#define DEV __device__ __forceinline__
#define GAS __attribute__((address_space(1)))
#define LAS __attribute__((address_space(3)))
typedef unsigned int u32x4 __attribute__((ext_vector_type(4)));
typedef GAS const u32x4 gu4;

#ifndef SINGLE_LAUNCH
#define SINGLE_LAUNCH 1
#endif

constexpr int D = 1024, L = 4096, LC = 256, NB = 4, NGRP = 2;
constexpr int RL = NB * L, RC = NB * LC, RG = RL + RC;
constexpr int NIN = 6656;
constexpr int PK = L + LC;
constexpr int DFF = 4096;
constexpr int KSLD = 4104;
constexpr float EPS = 1e-6f;
constexpr int NPHASE = 43;

constexpr size_t al(size_t x) { return (x + 255) & ~(size_t)255; }
constexpr size_t CTRL_BYTES = 1 << 20;
constexpr size_t OFF_CNT = 0;
constexpr size_t OFF_NORM = 1024;
constexpr size_t OFF_NORMC = OFF_NORM + 2 * 1024 * 4;
constexpr size_t OFF_SSQ = 16384;
constexpr size_t OFF_BAR = 573440;
constexpr size_t OFF_MOD = 587264;
static_assert(OFF_SSQ + (size_t)2 * 2 * 34816 * 4 <= OFF_BAR && OFF_MOD + 2 * 9 * 6144 * 4 <= CTRL_BYTES, "ctrl map");
constexpr size_t OFF_CTXS = CTRL_BYTES;
constexpr size_t OFF_WIN = OFF_CTXS + (size_t)2048 * 1024 * 4;
constexpr size_t OFF_WUQ = OFF_WIN + (size_t)NIN * 1024 * 2;
constexpr size_t OFF_WUKV = OFF_WUQ + (size_t)768 * 256 * 2;
constexpr size_t OFF_WOM = OFF_WUKV + (size_t)1024 * 128 * 2;
constexpr size_t OFF_WOG = OFF_WOM + (size_t)1024 * 512 * 2;
constexpr size_t OFF_WOH = OFF_WOG + (size_t)1024 * 512 * 2;
constexpr size_t OFF_WOUT = OFF_WOH + (size_t)1024 * 512 * 2;
constexpr size_t OFF_W1 = OFF_WOUT + (size_t)1024 * 1024 * 2;
constexpr size_t OFF_W2 = OFF_W1 + (size_t)4096 * 1024 * 2;
constexpr size_t OFF_KS = OFF_W2 + (size_t)4096 * 1024 * 2;
constexpr size_t OFF_KFC = OFF_KS + (size_t)1024 * KSLD * 8;
constexpr size_t OFF_HX = OFF_KFC + (size_t)2 * 2 * 512 * 256 * 4;
constexpr size_t OFF_Q = OFF_HX + (size_t)RG * 1024 * 2;
constexpr size_t OFF_K = OFF_Q + (size_t)NB * 8 * PK * 96 * 2;
constexpr size_t OFF_VT = OFF_K + (size_t)NB * 8 * PK * 96 * 2;
constexpr size_t OFF_YMLA = OFF_VT + (size_t)NB * 8 * 64 * PK * 2;
constexpr size_t OFF_OF = OFF_YMLA + (size_t)RG * 512 * 2;
constexpr size_t OFF_OB = OFF_OF + (size_t)RG * 512 * 2;
constexpr size_t OFF_YHY = OFF_OB + (size_t)RG * 512 * 2;
constexpr size_t OFF_Z = OFF_YHY + (size_t)RG * 512 * 2;
constexpr size_t OFF_ZQ = OFF_Z;
constexpr size_t OFF_ZKV = OFF_ZQ + (size_t)RG * 256 * 2;
constexpr size_t OFF_MISC = OFF_ZKV + (size_t)RG * 128 * 2;
constexpr size_t OFF_GQ = OFF_MISC + (size_t)RG * 64 * 2;
constexpr size_t OFF_GK = OFF_GQ + (size_t)RG * 256 * 2;
constexpr size_t OFF_GV = OFF_GK + (size_t)RG * 256 * 2;
constexpr size_t OFF_GR = OFF_GV + (size_t)RG * 512 * 2;
constexpr size_t OFF_HYT = OFF_GR + (size_t)RG * 512 * 2;
constexpr size_t OFF_HYC = OFF_HYT + (size_t)NB * 2048 * L * 2;
constexpr size_t OFF_GATES = OFF_HYC + (size_t)RC * 1536 * 2;
constexpr size_t OFF_END1 = OFF_GATES + (size_t)RG * 3072 * 2;
constexpr size_t OFF_H = OFF_Z;
constexpr size_t OFF_END2 = OFF_H + (size_t)RG * 4096 * 2;
constexpr size_t WS_NEED = OFF_END1 > OFF_END2 ? OFF_END1 : OFF_END2;
static_assert(WS_NEED <= ((size_t)512 << 20), "workspace over 512 MiB");
static_assert((size_t)2 * 512 * 8192 * 4 <= (size_t)RG * 3072 * 2, "KF alias");

constexpr int SMEM_BYTES = 131072;
constexpr int NTH = 512;

struct P {
  const float* in[32];
  float* out;
  char* ws;
  int ph_lo, ph_hi;
};
enum { I_X = 0, I_C, I_CTX, I_CCTX, I_ADAW, I_ADAB, I_N1G, I_N2G, I_WIN, I_QNORM, I_WUQ, I_KVNORM, I_WUKV, I_WA2, I_BA,
       I_GONORM, I_HSW, I_HSB, I_FW1, I_FB1, I_FW2, I_FB2, I_FW3, I_FB3, I_HYB, I_WOM, I_WOG, I_WOH, I_WOUT, I_FF1, I_FF2, I_FNG };

DEV int TID() { int t = threadIdx.x; asm volatile("" : "+v"(t)); return t; }
DEV int BID() { int b = blockIdx.x; asm volatile("" : "+s"(b)); return b; }
DEV char* WSP(char* w) { asm volatile("" : "+s"(w)); return w; }
typedef __bf16 bf16x2_t __attribute__((ext_vector_type(2)));
typedef float f32x2_t __attribute__((ext_vector_type(2)));
DEV u16 f2bf(float f) { return __builtin_bit_cast(u16, (__bf16)f); }
DEV float bf2f(u16 h) { return __uint_as_float(((unsigned)h) << 16); }
DEV unsigned pk2(float a, float b) { f32x2_t v = {a, b}; bf16x2_t r = __builtin_convertvector(v, bf16x2_t); return __builtin_bit_cast(unsigned, r); }
DEV uint2 pk4(f32x4 v) { return make_uint2(pk2(v[0], v[1]), pk2(v[2], v[3])); }
DEV float wave_sum(float v) {
#pragma unroll
  for (int o = 1; o < 64; o <<= 1) v += __shfl_xor(v, o);
  return v;
}
DEV float sigmoidf(float x) { return 1.f / (1.f + __expf(-x)); }
DEV bf16x8 mk8(uint2 a, uint2 b) {
  union { uint4 u; bf16x8 v; } t; t.u = make_uint4(a.x, a.y, b.x, b.y); return t.v;
}
DEV f32x4 mfma(bf16x8 a, bf16x8 b, f32x4 c) { return __builtin_amdgcn_mfma_f32_16x16x32_bf16(a, b, c, 0, 0, 0); }
DEV void rowinfo(int r, int& b, int& p) {
  if (r < RL) { b = r >> 12; p = LC + (r & (L - 1)); } else { int rc = r - RL; b = rc >> 8; p = rc & (LC - 1); }
}

constexpr int LDT = 72;
constexpr int STG = 128 * LDT;
template <bool SWAP, int TN, bool PERM = false, bool PERMA = false>
DEV void gemm_core(f32x4 (&acc)[TN == 256 ? 8 : 4][4], const u16* __restrict__ A, int lda, const u16* __restrict__ B, int ldb, int K, u16* sm,
                   bool first = true, const u16* nA = nullptr, int nlda = 0, const u16* nB = nullptr, int nldb = 0) {
  constexpr int MI = TN == 256 ? 8 : 4;
  const int tid = TID(), lane = tid & 63, w = tid >> 6, lr = lane & 15, lg = lane >> 4;
  const int wr = TN == 256 ? (w >> 2) : (w >> 1), wc = TN == 256 ? (w & 3) : (w & 1);
  constexpr int OPA = 256 * 32, OPB = TN * 32, STSZ = OPA + OPB;
  const int drow = lane >> 2, dch = lane & 3;
  const int brow = TN == 256 ? w * 32 : w * 16;
  const int pa0 = PERMA ? (w * 32 + 8 * (drow >> 2) + (drow & 3)) : (w * 32 + drow);
  const int pa1 = PERMA ? (pa0 + 4) : (w * 32 + 16 + drow);
  const GAS u16* ga0 = (const GAS u16*)(A + (size_t)pa0 * lda + dch * 8);
  const GAS u16* ga1 = (const GAS u16*)(A + (size_t)pa1 * lda + dch * 8);
  const int pb0 = PERM ? ((TN == 256 ? w * 32 : (w >> 1) * 32) + 8 * (drow >> 2) + (TN == 256 ? 0 : 4 * (w & 1)) + (drow & 3)) : (brow + drow);
  const int pb1 = PERM ? (pb0 + 4) : (brow + 16 + drow);
  const GAS u16* gb0 = (const GAS u16*)(B + (size_t)pb0 * ldb + dch * 8);
  const GAS u16* gb1 = (const GAS u16*)(B + (size_t)pb1 * ldb + dch * 8);
  LAS u16* ls = (LAS u16*)sm;
  const int wofA = __builtin_amdgcn_readfirstlane(w * 32 * 32);
  const int wofB = __builtin_amdgcn_readfirstlane(OPA + brow * 32);
#define ISSUE(kk) do { const int _st = ((kk) & 3) * STSZ; const int _ko = (kk) * 32; \
    __builtin_amdgcn_global_load_lds((const GAS unsigned*)(ga0 + _ko), (LAS unsigned*)(ls + _st + wofA), 16, 0, 0); \
    __builtin_amdgcn_global_load_lds((const GAS unsigned*)(ga1 + _ko), (LAS unsigned*)(ls + _st + wofA + 16 * 32), 16, 0, 0); \
    __builtin_amdgcn_global_load_lds((const GAS unsigned*)(gb0 + _ko), (LAS unsigned*)(ls + _st + wofB), 16, 0, 0); \
    if (TN == 256) __builtin_amdgcn_global_load_lds((const GAS unsigned*)(gb1 + _ko), (LAS unsigned*)(ls + _st + wofB + 16 * 32), 16, 0, 0); } while (0)
#define FRAG(p, i) (*(const bf16x8*)((p) + (i) * 16 * 32))
#define MM(mi, ni, av, bv) acc[mi][ni] = SWAP ? mfma(bv, av, acc[mi][ni]) : mfma(av, bv, acc[mi][ni])
#define MM16(mo, a0, a1, a2, a3, b0, b1, b2, b3) do { \
    MM(mo + 0, 0, a0, b0); MM(mo + 1, 0, a1, b0); MM(mo + 0, 1, a0, b1); MM(mo + 1, 1, a1, b1); \
    MM(mo + 2, 0, a2, b0); MM(mo + 3, 0, a3, b0); MM(mo + 2, 1, a2, b1); MM(mo + 3, 1, a3, b1); \
    MM(mo + 0, 2, a0, b2); MM(mo + 1, 2, a1, b2); MM(mo + 2, 2, a2, b2); MM(mo + 3, 2, a3, b2); \
    MM(mo + 0, 3, a0, b3); MM(mo + 1, 3, a1, b3); MM(mo + 2, 3, a2, b3); MM(mo + 3, 3, a3, b3); } while (0)
  const int nk2 = K >> 6;
  if (first) { __syncthreads(); ISSUE(0); ISSUE(1); }
  const int aoff = (wr * MI * 16 + lr) * 32 + lg * 8, boff = OPA + (wc * 64 + lr) * 32 + lg * 8;
  for (int s2 = 0; s2 < nk2; ++s2) {
    asm volatile("s_waitcnt vmcnt(0)" ::: "memory");
    __builtin_amdgcn_s_barrier();
    __builtin_amdgcn_sched_barrier(0);
    if (s2 + 1 < nk2) { ISSUE(2 * s2 + 2); ISSUE(2 * s2 + 3); }
    const u16* p0 = sm + ((2 * s2) & 3) * STSZ;
    const u16* p1 = sm + ((2 * s2 + 1) & 3) * STSZ;
    const bf16x8 b0 = FRAG(p0 + boff, 0), b1 = FRAG(p0 + boff, 1), b2 = FRAG(p0 + boff, 2), b3 = FRAG(p0 + boff, 3);
    const bf16x8 a0 = FRAG(p0 + aoff, 0), a1 = FRAG(p0 + aoff, 1), a2 = FRAG(p0 + aoff, 2), a3 = FRAG(p0 + aoff, 3);
    if (MI == 8) {
      const bf16x8 a4 = FRAG(p0 + aoff, 4), a5 = FRAG(p0 + aoff, 5), a6 = FRAG(p0 + aoff, 6), a7 = FRAG(p0 + aoff, 7);
      __builtin_amdgcn_sched_barrier(0);
      MM16(0, a0, a1, a2, a3, b0, b1, b2, b3);
      __builtin_amdgcn_sched_barrier(0);
      const bf16x8 d0 = FRAG(p1 + aoff, 0), d1 = FRAG(p1 + aoff, 1), d2 = FRAG(p1 + aoff, 2), d3 = FRAG(p1 + aoff, 3);
      __builtin_amdgcn_sched_barrier(0);
      MM16(MI - 4, a4, a5, a6, a7, b0, b1, b2, b3);
      __builtin_amdgcn_sched_barrier(0);
      const bf16x8 c0 = FRAG(p1 + boff, 0), c1 = FRAG(p1 + boff, 1), c2 = FRAG(p1 + boff, 2), c3 = FRAG(p1 + boff, 3);
      const bf16x8 d4 = FRAG(p1 + aoff, 4), d5 = FRAG(p1 + aoff, 5), d6 = FRAG(p1 + aoff, 6), d7 = FRAG(p1 + aoff, 7);
      __builtin_amdgcn_sched_barrier(0);
      MM16(0, d0, d1, d2, d3, c0, c1, c2, c3);
      __builtin_amdgcn_sched_barrier(0);
      MM16(MI - 4, d4, d5, d6, d7, c0, c1, c2, c3);
    } else {
      const bf16x8 c0 = FRAG(p1 + boff, 0), c1 = FRAG(p1 + boff, 1), c2 = FRAG(p1 + boff, 2), c3 = FRAG(p1 + boff, 3);
      const bf16x8 d0 = FRAG(p1 + aoff, 0), d1 = FRAG(p1 + aoff, 1), d2 = FRAG(p1 + aoff, 2), d3 = FRAG(p1 + aoff, 3);
      __builtin_amdgcn_sched_barrier(0);
      MM16(0, a0, a1, a2, a3, b0, b1, b2, b3);
      __builtin_amdgcn_sched_barrier(0);
      MM16(0, d0, d1, d2, d3, c0, c1, c2, c3);
    }
    __builtin_amdgcn_sched_barrier(0);
  }
  if (nA) {
    ga0 = (const GAS u16*)(nA + (size_t)pa0 * nlda + dch * 8);
    ga1 = (const GAS u16*)(nA + (size_t)pa1 * nlda + dch * 8);
    gb0 = (const GAS u16*)(nB + (size_t)pb0 * nldb + dch * 8);
    gb1 = (const GAS u16*)(nB + (size_t)pb1 * nldb + dch * 8);
    ISSUE(0); ISSUE(1);
  }
#undef MM16
#undef MM
#undef FRAG
#undef ISSUE
}
template <int MI>
DEV void zero_acc(f32x4 (&acc)[MI][4]) {
#pragma unroll
  for (int i = 0; i < MI; ++i)
#pragma unroll
    for (int j = 0; j < 4; ++j) acc[i][j] = f32x4{0.f, 0.f, 0.f, 0.f};
}

DEV int win_orig_col(int j) {
  if (j < 416) return j;
  if (j < 432) return 1952 + (j - 416);
  if (j < 448) return 1968 + (j - 432);
  if (j < 512) return -1;
  if (j < 2048) return 416 + (j - 512);
  return j - 64;
}
DEV void cvt_item(const float* __restrict__ W, int Norig, int K, u16* WT, int n, int k8, int oc, const float* gain) {
  float v[8];
#pragma unroll
  for (int e = 0; e < 8; ++e) {
    int k = k8 * 8 + e;
    float x = (oc >= 0) ? W[(size_t)k * Norig + oc] : 0.f;
    if (gain) x *= gain[k];
    v[e] = x;
  }
  *(uint4*)(WT + (size_t)n * K + k8 * 8) = make_uint4(pk2(v[0], v[1]), pk2(v[2], v[3]), pk2(v[4], v[5]), pk2(v[6], v[7]));
}

DEV void filter_item(const P& p, int l, int item, char* smem) {
  constexpr int NP = 8;
  const bool isc = item >= 512;
  const int Lx = isc ? LC : L;
  const int pos0 = (isc ? item - 512 : item) * NP;
  float* feat = (float*)smem;
  float* h1 = feat + NP * 36;
  float* h2 = h1 + NP * 64;
  const int tid = TID();
  const float* w1 = p.in[I_FW1] + (size_t)l * 33 * 64; const float* b1 = p.in[I_FB1] + l * 64;
  const float* w2 = p.in[I_FW2] + (size_t)l * 64 * 64; const float* b2 = p.in[I_FB2] + l * 64;
  const float* w3 = p.in[I_FW3] + (size_t)l * 64 * 2048; const float* b3 = p.in[I_FB3] + l * 2048;
  __syncthreads();
  for (int e = tid; e < NP * 33; e += NTH) {
    int ps = e / 33, fi = e % 33;
    float pos = (float)(pos0 + ps);
    float v;
    if (fi == 0) v = pos / (float)(Lx - 1);
    else {
      int i = (fi - 1) & 15;
      float f = 1e-4f + (float)i * ((15.f - 1e-4f) / 15.f);
      float ang = (6.283185307179586f / (float)Lx) * pos * f;
      v = (fi <= 16) ? __cosf(ang) : __sinf(ang);
    }
    feat[ps * 36 + fi] = v;
  }
  __syncthreads();
  {
    const int ps = tid >> 6, u = tid & 63;
    float a = b1[u];
#pragma unroll 11
    for (int k = 0; k < 33; ++k) a += feat[ps * 36 + k] * w1[k * 64 + u];
    h1[ps * 64 + u] = __sinf(a);
    __syncthreads();
    a = b2[u];
#pragma unroll 16
    for (int k = 0; k < 64; ++k) a += h1[ps * 64 + k] * w2[k * 64 + u];
    h2[ps * 64 + u] = __sinf(a);
  }
  __syncthreads();
  float* KF = isc ? (float*)(p.ws + OFF_KFC) : (float*)(p.ws + OFF_GATES);
  float* NRM = isc ? (float*)(p.ws + OFF_NORMC) : (float*)(p.ws + OFF_NORM) + l * 1024;
  const float da = logf(1e-2f) / 0.3f, db = logf(1e-2f) / 1.5f;
#pragma unroll 1
  for (int jj = 0; jj < 4; ++jj) {
    const int j = tid + NTH * jj;
    float acc[NP];
#pragma unroll
    for (int q = 0; q < NP; ++q) acc[q] = 0.f;
#pragma unroll 4
    for (int k = 0; k < 64; k += 4) {
      const float w0 = w3[(k + 0) * 2048 + j], w1v = w3[(k + 1) * 2048 + j], w2v = w3[(k + 2) * 2048 + j], w3v = w3[(k + 3) * 2048 + j];
#pragma unroll
      for (int q = 0; q < NP; ++q) {
        const f32x4 h = *(const f32x4*)(h2 + q * 64 + k);
        acc[q] += h[0] * w0 + h[1] * w1v + h[2] * w2v + h[3] * w3v;
      }
    }
    const int dir = j >> 10, n = (j >> 9) & 1, c = j & 511;
    const float delta = fabsf(da + (float)c * ((db - da) / 511.f));
    const float bb = b3[j];
    float s = 0.f;
    float* dst = KF + ((size_t)((n * 2 + dir) * 512 + c)) * Lx + pos0;
#pragma unroll
    for (int q = 0; q < NP; ++q) {
      float t = (float)(pos0 + q) / (float)(Lx - 1);
      float v = (acc[q] + bb) * expf(-t * delta);
      s += fabsf(v);
      dst[q] = v;
    }
    atomicAdd(NRM + n * 512 + c, s);
  }
}

DEV void adaln_item(const P& p, int item, char* smem) {
  float* sc = (float*)smem;
  const int tid = TID();
  const int l2 = item / 96, rem = item % 96, nch = rem >> 3, ks = rem & 7, k0 = ks * 128;
  __syncthreads();
  for (int e = tid; e < 9 * 128; e += NTH) {
    int r = e >> 7, k = k0 + (e & 127);
    float v = (r < 8) ? p.in[I_C][r * 1024 + k] : p.in[I_CCTX][k];
    sc[e] = v / (1.f + expf(-v));
  }
  __syncthreads();
  const int n = nch * 512 + tid;
  const float* W = p.in[I_ADAW] + (size_t)l2 * 1024 * 6144 + (size_t)k0 * 6144;
  float acc[9];
#pragma unroll
  for (int r = 0; r < 9; ++r) acc[r] = 0.f;
#pragma unroll 32
  for (int k = 0; k < 128; ++k) {
    float w = W[(size_t)k * 6144 + n];
#pragma unroll
    for (int r = 0; r < 9; ++r) acc[r] += sc[r * 128 + k] * w;
  }
  const float bb = (ks == 0) ? p.in[I_ADAB][l2 * 6144 + n] : 0.f;
  float* MOD = (float*)(p.ws + OFF_MOD);
#pragma unroll
  for (int r = 0; r < 9; ++r) atomicAdd(MOD + ((size_t)l2 * 9 + r) * 6144 + n, acc[r] + bb);
}

DEV void phase_prep(const P& p, int l, char* smem) {
  const int nfilt = (l == 0) ? 544 : 512;
  for (int it = BID(); it < nfilt; it += gridDim.x) filter_item(p, l, it, smem);
  if (l == 0) for (int it = BID(); it < 192; it += gridDim.x) adaln_item(p, it, smem);
  const long T = (long)gridDim.x * NTH;
  const long gt = (long)BID() * NTH + TID();
  char* ws = WSP(p.ws);
  {
    const float* W = p.in[I_WIN] + (size_t)l * 1024 * 6592;
    for (long i = gt; i < (long)NIN * 128; i += T) { int k8 = (int)(i / NIN), n = (int)(i % NIN); cvt_item(W, 6592, 1024, (u16*)(ws + OFF_WIN), n, k8, win_orig_col(n), nullptr); }
  }
  {
    const float* W = p.in[I_WUQ] + (size_t)l * 256 * 768; const float* g = p.in[I_QNORM] + l * 256;
    for (long i = gt; i < 768L * 32; i += T) {
      int k8 = (int)(i / 768), n = (int)(i % 768);
      int oc = (n < 512) ? (n >> 6) * 96 + (n & 63) : ((n - 512) >> 5) * 96 + 64 + ((n - 512) & 31);
      cvt_item(W, 768, 256, (u16*)(ws + OFF_WUQ), n, k8, oc, g);
    }
  }
  {
    const float* W = p.in[I_WUKV] + (size_t)l * 128 * 1024; const float* g = p.in[I_KVNORM] + l * 128;
    for (long i = gt; i < 1024L * 16; i += T) {
      int k8 = (int)(i / 1024), n = (int)(i % 1024);
      int oc = (n < 512) ? (n >> 6) * 128 + (n & 63) : ((n - 512) >> 6) * 128 + 64 + ((n - 512) & 63);
      cvt_item(W, 1024, 128, (u16*)(ws + OFF_WUKV), n, k8, oc, g);
    }
  }
  for (int m = 0; m < 3; ++m) {
    const float* W = p.in[I_WOM + m] + (size_t)l * 512 * 1024;
    u16* WT = (u16*)(ws + (m == 0 ? OFF_WOM : (m == 1 ? OFF_WOG : OFF_WOH)));
    for (long i = gt; i < 1024L * 64; i += T) { int k8 = (int)(i / 1024), n = (int)(i % 1024); cvt_item(W, 1024, 512, WT, n, k8, n, nullptr); }
  }
  {
    const float* W = p.in[I_WOUT] + (size_t)l * 1024 * 1024;
    for (long i = gt; i < 1024L * 128; i += T) { int k8 = (int)(i / 1024), n = (int)(i % 1024); cvt_item(W, 1024, 1024, (u16*)(ws + OFF_WOUT), n, k8, n, nullptr); }
  }
  {
    const float* W = p.in[I_FF1] + (size_t)l * 1024 * 4096;
    for (long i = gt; i < 4096L * 128; i += T) { int k8 = (int)(i / 4096), n = (int)(i % 4096); cvt_item(W, 4096, 1024, (u16*)(ws + OFF_W1), n, k8, n, nullptr); }
  }
  {
    const float* W = p.in[I_FF2] + (size_t)l * 4096 * 1024;
    for (long i = gt; i < 1024L * 512; i += T) { int k8 = (int)(i / 1024), n = (int)(i % 1024); cvt_item(W, 1024, 4096, (u16*)(ws + OFF_W2), n, k8, n, nullptr); }
  }
}

DEV int PADI(int i) { return i + (i >> 4); }
constexpr int TW_OFF = 90112;
DEV int PADT(int k) { return k + (k >> 3); }
DEV void fft_build_tw(char* smem) {
  float2* tw = (float2*)(smem + TW_OFF);
  __syncthreads();
  for (int k = TID(); k < 4096; k += NTH) {
    const float fr = (float)k * (1.f / 8192.f);
    tw[PADT(k)] = make_float2(__builtin_amdgcn_cosf(fr), __builtin_amdgcn_sinf(fr));
  }
  __syncthreads();
}
template <bool INV>
DEV void bfly(float2& a, float2& b, const float2 w) {
  const float c = w.x, s = w.y;
  if (!INV) {
    float tx = a.x - b.x, ty = a.y - b.y;
    a.x += b.x; a.y += b.y;
    b.x = tx * c + ty * s; b.y = ty * c - tx * s;
  } else {
    float tx = b.x * c - b.y * s, ty = b.x * s + b.y * c;
    b.x = a.x - tx; b.y = a.y - ty;
    a.x += tx; a.y += ty;
  }
}
template <bool INV, bool HALF>
DEV void fft_r8_pass(float2* buf, int q, int lq) {
  const float2* tw = (const float2*)((const char*)buf + TW_OFF);
#pragma unroll 2
  for (int gi = TID(); gi < 1024; gi += NTH) {
    const int pos = gi & (q - 1), base = (gi >> lq) * 8 * q + pos;
    const int fpi = pos << (10 - lq);
    float2 e[8];
#pragma unroll
    for (int m = 0; m < 8; ++m) e[m] = (HALF && !INV && m >= 4) ? make_float2(0.f, 0.f) : buf[PADI(base + m * q)];
    if (!INV) {
      if (HALF) {
#pragma unroll
        for (int m = 0; m < 4; ++m) { const float2 w = tw[PADT(fpi + m * 1024)]; e[m + 4] = make_float2(e[m].x * w.x + e[m].y * w.y, e[m].y * w.x - e[m].x * w.y); }
      } else {
#pragma unroll
        for (int m = 0; m < 4; ++m) bfly<false>(e[m], e[m + 4], tw[PADT(fpi + m * 1024)]);
      }
#pragma unroll
      for (int m = 0; m < 2; ++m) { const float2 w = tw[PADT(2 * fpi + m * 2048)]; bfly<false>(e[m], e[m + 2], w); bfly<false>(e[m + 4], e[m + 6], w); }
      {
        const float2 w = tw[PADT(4 * fpi)];
#pragma unroll
        for (int m = 0; m < 8; m += 2) bfly<false>(e[m], e[m + 1], w);
      }
    } else {
      {
        const float2 w = tw[PADT(4 * fpi)];
#pragma unroll
        for (int m = 0; m < 8; m += 2) bfly<true>(e[m], e[m + 1], w);
      }
#pragma unroll
      for (int m = 0; m < 2; ++m) { const float2 w = tw[PADT(2 * fpi + m * 2048)]; bfly<true>(e[m], e[m + 2], w); bfly<true>(e[m + 4], e[m + 6], w); }
      if (HALF) {
#pragma unroll
        for (int m = 0; m < 4; ++m) { const float2 w = tw[PADT(fpi + m * 1024)]; e[m].x += e[m + 4].x * w.x - e[m + 4].y * w.y; e[m].y += e[m + 4].x * w.y + e[m + 4].y * w.x; }
      } else {
#pragma unroll
        for (int m = 0; m < 4; ++m) bfly<true>(e[m], e[m + 4], tw[PADT(fpi + m * 1024)]);
      }
    }
#pragma unroll
    for (int m = 0; m < 8; ++m) if (!(HALF && INV && m >= 4)) buf[PADI(base + m * q)] = e[m];
  }
  __syncthreads();
}
DEV void fft_r2_last(float2* buf) {
#pragma unroll 4
  for (int gi = TID(); gi < 4096; gi += NTH) {
    float2 a = buf[PADI(2 * gi)], b = buf[PADI(2 * gi + 1)];
    buf[PADI(2 * gi)] = make_float2(a.x + b.x, a.y + b.y);
    buf[PADI(2 * gi + 1)] = make_float2(a.x - b.x, a.y - b.y);
  }
  __syncthreads();
}
template <bool ZHI>
DEV void fft_fwd(float2* buf) {
  fft_r8_pass<false, ZHI>(buf, 1024, 10); fft_r8_pass<false, false>(buf, 128, 7); fft_r8_pass<false, false>(buf, 16, 4); fft_r8_pass<false, false>(buf, 2, 1);
  fft_r2_last(buf);
}
template <bool LOHALF>
DEV void fft_inv(float2* buf) {
  fft_r2_last(buf);
  fft_r8_pass<true, false>(buf, 2, 1); fft_r8_pass<true, false>(buf, 16, 4); fft_r8_pass<true, false>(buf, 128, 7); fft_r8_pass<true, LOHALF>(buf, 1024, 10);
}
DEV int brev13(int f) { return (int)(__brev((unsigned)f) >> 19); }

DEV void filtfft_task(const P& p, int l, int c, char* smem) {
  float2* buf = (float2*)smem;
  const float* KF = (const float*)(p.ws + OFF_GATES);
  const float* NRM = (const float*)(p.ws + OFF_NORM) + l * 1024;
  const int tid = TID();
  __syncthreads();
  for (int i = tid; i < 8192; i += NTH) {
    float a, b;
    if (i < 4096) { a = KF[((size_t)(0 * 2 + 0) * 512 + c) * L + i]; b = KF[((size_t)(1 * 2 + 0) * 512 + c) * L + i]; }
    else if (i == 4096) { a = 0.f; b = 0.f; }
    else { a = KF[((size_t)(0 * 2 + 1) * 512 + c) * L + (8192 - i)]; b = KF[((size_t)(1 * 2 + 1) * 512 + c) * L + (8192 - i)]; }
    buf[PADI(i)] = make_float2(a, b);
  }
  __syncthreads();
  fft_fwd<false>(buf);
  const float s0 = 0.5f / (NRM[c] * 8192.f), s1 = 0.5f / (NRM[512 + c] * 8192.f);
  float2* KS = (float2*)(p.ws + OFF_KS);
  for (int f = tid; f <= 4096; f += NTH) {
    float2 zf = buf[PADI(brev13(f))], zn = buf[PADI(brev13((8192 - f) & 8191))];
    KS[(size_t)(0 * 512 + c) * KSLD + f] = make_float2((zf.x + zn.x) * s0, (zf.y - zn.y) * s0);
    KS[(size_t)(1 * 512 + c) * KSLD + f] = make_float2((zf.y + zn.y) * s1, -(zf.x - zn.x) * s1);
  }
  __syncthreads();
}

DEV void norm_rows(const float* xl, const float* xc, const float* gain, const float* modl, const float* modc, int shoff, u16* HX, int nrows) {
  const int gw = BID() * 8 + (TID() >> 6), NW = gridDim.x * 8, lane = TID() & 63;
  for (int r0 = gw; r0 < nrows; r0 += 2 * NW) {
    const int r1 = r0 + NW; const bool has1 = r1 < nrows;
    const float* s0 = (r0 < RL) ? xl + (size_t)r0 * D : xc + (size_t)(r0 - RL) * D;
    const float* s1 = has1 ? ((r1 < RL) ? xl + (size_t)r1 * D : xc + (size_t)(r1 - RL) * D) : s0;
    f32x4 a[4], b[4];
#pragma unroll
    for (int j = 0; j < 2; ++j) {
      a[2 * j] = *(const f32x4*)(s0 + j * 512 + lane * 8); a[2 * j + 1] = *(const f32x4*)(s0 + j * 512 + lane * 8 + 4);
      b[2 * j] = *(const f32x4*)(s1 + j * 512 + lane * 8); b[2 * j + 1] = *(const f32x4*)(s1 + j * 512 + lane * 8 + 4);
    }
    float sa = 0.f, sb = 0.f;
#pragma unroll
    for (int j = 0; j < 4; ++j) {
      sa += a[j][0] * a[j][0] + a[j][1] * a[j][1] + a[j][2] * a[j][2] + a[j][3] * a[j][3];
      sb += b[j][0] * b[j][0] + b[j][1] * b[j][1] + b[j][2] * b[j][2] + b[j][3] * b[j][3];
    }
    const float ra = rsqrtf(wave_sum(sa) * (1.f / D) + EPS), rb = rsqrtf(wave_sum(sb) * (1.f / D) + EPS);
    const float* m0 = (r0 < RL) ? modl + (size_t)(r0 >> 12) * 6144 : modc;
    const float* m1 = (r1 < RL) ? modl + (size_t)(r1 >> 12) * 6144 : modc;
#pragma unroll
    for (int j = 0; j < 2; ++j) {
      const int c0 = j * 512 + lane * 8;
      f32x4 ya[2], yb[2];
#pragma unroll
      for (int h = 0; h < 2; ++h) {
        const f32x4 g = *(const f32x4*)(gain + c0 + 4 * h);
        const f32x4 sh0 = *(const f32x4*)(m0 + shoff + c0 + 4 * h), sc0 = *(const f32x4*)(m0 + shoff + 1024 + c0 + 4 * h);
        const f32x4 sh1 = *(const f32x4*)(m1 + shoff + c0 + 4 * h), sc1 = *(const f32x4*)(m1 + shoff + 1024 + c0 + 4 * h);
#pragma unroll
        for (int e = 0; e < 4; ++e) {
          ya[h][e] = a[2 * j + h][e] * ra * g[e] * (1.f + sc0[e]) + sh0[e];
          yb[h][e] = b[2 * j + h][e] * rb * g[e] * (1.f + sc1[e]) + sh1[e];
        }
      }
      { const uint2 lo = pk4(ya[0]), hi = pk4(ya[1]); *(uint4*)(HX + (size_t)r0 * D + c0) = make_uint4(lo.x, lo.y, hi.x, hi.y); }
      if (has1) { const uint2 lo = pk4(yb[0]), hi = pk4(yb[1]); *(uint4*)(HX + (size_t)r1 * D + c0) = make_uint4(lo.x, lo.y, hi.x, hi.y); }
    }
  }
}

DEV void rope4(f32x4& v, int pos, int lg) {
#pragma unroll
  for (int j = 0; j < 4; ++j) {
    float pv = __shfl_xor(v[j], 32);
    int i = (lg * 4 + j) & 7;
    float inv = exp2f(-(float)i * (13.287712379549449f / 8.f));
    float ang = (float)pos * inv; float sn = __sinf(ang), cs = __cosf(ang);
    v[j] = (lg < 2) ? v[j] * cs - pv * sn : pv * sn + v[j] * cs;
  }
}

DEV void rope_perm(f32x4& ve, f32x4& vo, int pos, int lg) {
#pragma unroll
  for (int h = 0; h < 2; ++h) {
#pragma unroll
    for (int j = 0; j < 4; ++j) {
      float x = h ? vo[j] : ve[j];
      float pv = __shfl_xor(x, 16);
      int i = h * 4 + j;
      float inv = exp2f(-(float)i * (13.287712379549449f / 8.f));
      float ang = (float)pos * inv; float sn = __sinf(ang), cs = __cosf(ang);
      float y = ((lg & 1) == 0) ? x * cs - pv * sn : pv * sn + x * cs;
      if (h) vo[j] = y; else ve[j] = y;
    }
  }
}

DEV void phase_win(const P& p, int l, int g, char* smem) {
  char* ws = WSP(p.ws);
  const u16* HX = (const u16*)(ws + OFF_HX);
  const u16* WT = (const u16*)(ws + OFF_WIN);
  float* SSQ = (float*)(ws + OFF_SSQ) + (size_t)l * 2 * 34816;
  const int tid = TID(), lane = tid & 63, w = tid >> 6, wr = w >> 2, wc = w & 3, lr = lane & 15, lg = lane >> 4;
  const int NT = 26, ntiles = 68 * NT;
  bool pref = false;
  for (int t = BID(); t < ntiles; t += gridDim.x) {
    const int mt = t / NT, nt = t % NT;
    const int m0 = mt * 256, n0 = nt * 256;
    const bool lat = mt < 64;
    f32x4 acc[8][4]; zero_acc<8>(acc);
    const bool swap = !(nt >= 8 && nt < 14 && lat);
    const int t2 = t + gridDim.x;
    const bool swap2 = !((t2 % NT) >= 8 && (t2 % NT) < 14 && (t2 / NT) < 64);
    const bool hn = t2 < ntiles && swap2 == swap;
    const u16* nA = hn ? HX + (size_t)(t2 / NT) * 256 * D : nullptr; const u16* nB = WT + (size_t)(t2 % NT) * 256 * D;
    if (swap) gemm_core<true, 256, true>(acc, HX + (size_t)m0 * D, D, WT + (size_t)n0 * D, D, D, (u16*)smem, !pref, nA, D, nB, D);
    else gemm_core<false, 256, false, true>(acc, HX + (size_t)m0 * D, D, WT + (size_t)n0 * D, D, D, (u16*)smem, !pref, nA, D, nB, D);
    pref = hn;
    if (!swap) {
      const int b = m0 >> 12, s0 = m0 & (L - 1);
      u16* HYT = (u16*)(ws + OFF_HYT);
#pragma unroll
      for (int mp = 0; mp < 4; ++mp)
#pragma unroll
        for (int ni = 0; ni < 4; ++ni) {
          int ch = n0 - 2048 + wc * 64 + ni * 16 + lr;
          int s = s0 + wr * 128 + mp * 32 + lg * 8;
          const uint2 lo = pk4(acc[2 * mp][ni]), hi = pk4(acc[2 * mp + 1][ni]);
          *(uint4*)(HYT + ((size_t)(b * 2048 + ch)) * L + s) = make_uint4(lo.x, lo.y, hi.x, hi.y);
        }
      continue;
    }
    const int cs = nt * 4 + wc;
    if (cs == 7) continue;
#pragma unroll
    for (int mi = 0; mi < 8; ++mi) {
      const int r = m0 + wr * 128 + mi * 16 + lr;
      if (cs < 6) {
        u16* dst = (cs < 4) ? (u16*)(ws + OFF_ZQ) + (size_t)r * 256 + cs * 64 : (u16*)(ws + OFF_ZKV) + (size_t)r * 128 + (cs - 4) * 64;
        float ss = 0.f;
#pragma unroll
        for (int np = 0; np < 2; ++np) {
          const f32x4 v = acc[mi][2 * np], v2 = acc[mi][2 * np + 1];
          ss += v[0] * v[0] + v[1] * v[1] + v[2] * v[2] + v[3] * v[3] + v2[0] * v2[0] + v2[1] * v2[1] + v2[2] * v2[2] + v2[3] * v2[3];
          const uint2 lo = pk4(v), hi = pk4(v2);
          *(uint4*)(dst + np * 32 + lg * 8) = make_uint4(lo.x, lo.y, hi.x, hi.y);
        }
        ss += __shfl_xor(ss, 16); ss += __shfl_xor(ss, 32);
        if (lg == 0) {
          int grow = (r < RL) ? g * RL + r : 32768 + g * RC + (r - RL);
          atomicAdd(SSQ + (size_t)(cs < 4 ? 0 : 1) * 34816 + grow, ss);
        }
      } else if (cs == 6) {
        int b, pp; rowinfo(r, b, pp);
        u16* Kb = (u16*)(ws + OFF_K);
        u16* MISC = (u16*)(ws + OFF_MISC);
        {
          f32x4 ve = acc[mi][0], vo = acc[mi][1];
          if (r < RL) { int sidx = r & (L - 1); rope_perm(ve, vo, (lg < 2) ? (sidx >> 6) : (sidx & 63), lg); }
          const uint2 lo = pk4(ve), hi = pk4(vo);
          const uint4 pk = make_uint4(lo.x, lo.y, hi.x, hi.y);
#pragma unroll
          for (int h = 0; h < 8; ++h) *(uint4*)(Kb + ((size_t)(b * 8 + h) * PK + pp) * 96 + 64 + lg * 8) = pk;
          *(uint4*)(MISC + (size_t)r * 64 + lg * 8) = pk;
        }
        {
          const uint2 lo = pk4(acc[mi][2]), hi = pk4(acc[mi][3]);
          *(uint4*)(MISC + (size_t)r * 64 + 32 + lg * 8) = make_uint4(lo.x, lo.y, hi.x, hi.y);
        }
      } else if (cs < 56) {
        u16* dst;
        if (cs < 12) dst = (u16*)(ws + OFF_GQ) + (size_t)r * 256 + (cs - 8) * 64;
        else if (cs < 16) dst = (u16*)(ws + OFF_GK) + (size_t)r * 256 + (cs - 12) * 64;
        else if (cs < 24) dst = (u16*)(ws + OFF_GV) + (size_t)r * 512 + (cs - 16) * 64;
        else if (cs < 32) dst = (u16*)(ws + OFF_GR) + (size_t)r * 512 + (cs - 24) * 64;
        else dst = (u16*)(ws + OFF_HYC) + (size_t)(r - RL) * 1536 + (cs - 32) * 64;
#pragma unroll
        for (int np = 0; np < 2; ++np) {
          const uint2 lo = pk4(acc[mi][2 * np]), hi = pk4(acc[mi][2 * np + 1]);
          *(uint4*)(dst + np * 32 + lg * 8) = make_uint4(lo.x, lo.y, hi.x, hi.y);
        }
      } else {
        u16* dst = (u16*)(ws + OFF_GATES) + (size_t)r * 3072 + (cs - 56) * 64;
#pragma unroll
        for (int np = 0; np < 2; ++np) {
          f32x4 v = acc[mi][2 * np], v2 = acc[mi][2 * np + 1];
#pragma unroll
          for (int e = 0; e < 4; ++e) { v[e] = sigmoidf(v[e]); v2[e] = sigmoidf(v2[e]); }
          const uint2 lo = pk4(v), hi = pk4(v2);
          *(uint4*)(dst + np * 32 + lg * 8) = make_uint4(lo.x, lo.y, hi.x, hi.y);
        }
      }
    }
  }
}

DEV void phase_up(const P& p, int l, int g, char* smem) {
  char* ws = WSP(p.ws);
  const float* SSQ = (const float*)(ws + OFF_SSQ) + (size_t)l * 2 * 34816;
  const int tid = TID(), lane = tid & 63, w = tid >> 6, wr = w >> 1, wc = w & 1, lr = lane & 15, lg = lane >> 4;
  const int ntiles = 68 * 14;
  u16* Qb = (u16*)(ws + OFF_Q); u16* Kb = (u16*)(ws + OFF_K); u16* VT = (u16*)(ws + OFF_VT);
  bool pref = false;
  for (int t = BID(); t < ntiles; t += gridDim.x) {
    const int mt = t / 14, nt = t % 14;
    const int m0 = mt * 256;
    f32x4 acc[4][4]; zero_acc<4>(acc);
    const bool isq = nt < 6;
    const int nk = nt - 6;
    const bool vtile = !isq && nk >= 4;
    const u16* A = isq ? (const u16*)(ws + OFF_ZQ) + (size_t)m0 * 256 : (const u16*)(ws + OFF_ZKV) + (size_t)m0 * 128;
    const u16* B = isq ? (const u16*)(ws + OFF_WUQ) + (size_t)nt * 128 * 256 : (const u16*)(ws + OFF_WUKV) + (size_t)nk * 128 * 128;
    const int K = isq ? 256 : 128;
    const int t2 = t + gridDim.x; const bool hn = t2 < ntiles;
    const int mt2 = t2 / 14, nt2 = t2 % 14; const bool isq2 = nt2 < 6;
    const u16* A2 = isq2 ? (const u16*)(ws + OFF_ZQ) + (size_t)mt2 * 256 * 256 : (const u16*)(ws + OFF_ZKV) + (size_t)mt2 * 256 * 128;
    const u16* B2 = isq2 ? (const u16*)(ws + OFF_WUQ) + (size_t)nt2 * 128 * 256 : (const u16*)(ws + OFF_WUKV) + (size_t)(nt2 - 6) * 128 * 128;
    const int K2 = isq2 ? 256 : 128;
    const bool was = pref; pref = hn;
    if (!vtile) {
      gemm_core<true, 128>(acc, A, K, B, K, K, (u16*)smem, !was, hn ? A2 : nullptr, K2, B2, K2);
#pragma unroll
      for (int mi = 0; mi < 4; ++mi) {
        const int r = m0 + wr * 64 + mi * 16 + lr;
        int b, pp; rowinfo(r, b, pp);
        const int grow = (r < RL) ? g * RL + r : 32768 + g * RC + (r - RL);
        const float sc = isq ? rsqrtf(SSQ[grow] * (1.f / 256.f) + EPS) * (0.10206207261596577f * 1.4426950408889634f)
                             : rsqrtf(SSQ[34816 + grow] * (1.f / 128.f) + EPS);
#pragma unroll
        for (int ni = 0; ni < 4; ++ni) {
          f32x4 v = acc[mi][ni];
#pragma unroll
          for (int e = 0; e < 4; ++e) v[e] *= sc;
          if (!isq) {
            const int h = nk * 2 + wc, d = ni * 16 + lg * 4;
            *(uint2*)(Kb + ((size_t)(b * 8 + h) * PK + pp) * 96 + d) = pk4(v);
          } else if (nt < 4) {
            const int h = nt * 2 + wc, d = ni * 16 + lg * 4;
            *(uint2*)(Qb + ((size_t)(b * 8 + h) * PK + pp) * 96 + d) = pk4(v);
          } else {
            const int h = (nt - 4) * 4 + wc * 2 + (ni >> 1), rr = (ni & 1) * 16 + lg * 4;
            if (r < RL) { int s = r & (L - 1); rope4(v, (rr < 16) ? (s >> 6) : (s & 63), lg); }
            *(uint2*)(Qb + ((size_t)(b * 8 + h) * PK + pp) * 96 + 64 + rr) = pk4(v);
          }
        }
      }
    } else {
      gemm_core<false, 128>(acc, A, K, B, K, K, (u16*)smem, !was, hn ? A2 : nullptr, K2, B2, K2);
#pragma unroll
      for (int mi = 0; mi < 4; ++mi) {
        const int r = m0 + wr * 64 + mi * 16 + lg * 4;
        int b, pp; rowinfo(r, b, pp);
        const int grow = (r < RL) ? g * RL + r : 32768 + g * RC + (r - RL);
        float sc[4];
#pragma unroll
        for (int e = 0; e < 4; ++e) sc[e] = rsqrtf(SSQ[34816 + grow + e] * (1.f / 128.f) + EPS);
#pragma unroll
        for (int ni = 0; ni < 4; ++ni) {
          f32x4 v = acc[mi][ni];
#pragma unroll
          for (int e = 0; e < 4; ++e) v[e] *= sc[e];
          const int h = (nk - 4) * 2 + wc, d = ni * 16 + lr;
          *(uint2*)(VT + ((size_t)(b * 8 + h) * 64 + d) * PK + pp) = pk4(v);
        }
      }
    }
  }
}

DEV void attn_task(const P& p, int b, int h, int qb, bool isctx, char* smem) {
  char* ws = WSP(p.ws);
  const int tid = TID(), lane = tid & 63, w = tid >> 6, lr = lane & 15, lg = lane >> 4;
  const int p0 = isctx ? 0 : LC + qb * 256;
  const int nkeys = isctx ? LC : PK;
  const u16* Qb = (const u16*)(ws + OFF_Q) + ((size_t)(b * 8 + h) * PK) * 96;
  const u16* Kb = (const u16*)(ws + OFF_K) + ((size_t)(b * 8 + h) * PK) * 96;
  const u16* VT = (const u16*)(ws + OFF_VT) + ((size_t)(b * 8 + h) * 64) * PK;
  constexpr int KLD = 104, VLD = 136, KSZ = 128 * KLD, VSZ = 64 * VLD;
  u16* sK = (u16*)smem;
  u16* sV = sK + 2 * KSZ;
  bf16x8 qf[2][3];
#pragma unroll
  for (int qs = 0; qs < 2; ++qs)
#pragma unroll
    for (int ks = 0; ks < 3; ++ks)
      qf[qs][ks] = *(const bf16x8*)(Qb + (size_t)(p0 + w * 32 + qs * 16 + lr) * 96 + ks * 32 + lg * 8);
  f32x4 o[4][2];
#pragma unroll
  for (int i = 0; i < 4; ++i) { o[i][0] = f32x4{0, 0, 0, 0}; o[i][1] = f32x4{0, 0, 0, 0}; }
  float mrun[2] = {-1e30f, -1e30f}, lsum[2] = {0.f, 0.f};
  u32x4 rkA0, rkA1, rkA2, rvA0, rvA1, rkB0, rkB1, rkB2, rvB0, rvB1;
  const int kr0 = tid / 12, kc0 = tid % 12, kr1 = (tid + 512) / 12, kc1 = (tid + 512) % 12, kr2 = (tid + 1024) / 12, kc2 = (tid + 1024) % 12;
  const int vd0 = tid >> 4, vd1 = (tid + 512) >> 4, vc0 = tid & 15;
#define AGLD(S, j0) do { rk##S##0 = *(gu4*)(Kb + (size_t)((j0) + kr0) * 96 + kc0 * 8); rk##S##1 = *(gu4*)(Kb + (size_t)((j0) + kr1) * 96 + kc1 * 8); \
    rk##S##2 = *(gu4*)(Kb + (size_t)((j0) + kr2) * 96 + kc2 * 8); \
    rv##S##0 = *(gu4*)(VT + (size_t)vd0 * PK + (j0) + vc0 * 8); rv##S##1 = *(gu4*)(VT + (size_t)vd1 * PK + (j0) + vc0 * 8); } while (0)
#define ASST(S, st) do { *(u32x4*)(sK + (st) * KSZ + kr0 * KLD + kc0 * 8) = rk##S##0; *(u32x4*)(sK + (st) * KSZ + kr1 * KLD + kc1 * 8) = rk##S##1; \
    *(u32x4*)(sK + (st) * KSZ + kr2 * KLD + kc2 * 8) = rk##S##2; \
    *(u32x4*)(sV + (st) * VSZ + vd0 * VLD + vc0 * 8) = rv##S##0; *(u32x4*)(sV + (st) * VSZ + vd1 * VLD + vc0 * 8) = rv##S##1; } while (0)
#define SOFTMAX(S, QS, PF) do { \
      float mx = -1e30f; \
      _Pragma("unroll") for (int kk = 0; kk < 4; ++kk) \
        _Pragma("unroll") for (int e = 0; e < 4; ++e) mx = fmaxf(mx, S[kk][e]); \
      mx = fmaxf(mx, __shfl_xor(mx, 16)); mx = fmaxf(mx, __shfl_xor(mx, 32)); \
        \
      if (__builtin_amdgcn_ballot_w64(mx > mrun[QS] + 8.f) != 0ull) { \
        const float mn = fmaxf(mrun[QS], mx); \
        const float alpha = __builtin_amdgcn_exp2f(mrun[QS] - mn); \
        mrun[QS] = mn; \
        lsum[QS] *= alpha; \
        _Pragma("unroll") for (int ds = 0; ds < 4; ++ds) \
          _Pragma("unroll") for (int e = 0; e < 4; ++e) o[ds][QS][e] *= alpha; \
      } \
      const float mn = mrun[QS]; \
      float ps = 0.f; \
      _Pragma("unroll") for (int kk = 0; kk < 4; ++kk) \
        _Pragma("unroll") for (int e = 0; e < 4; ++e) { float pv = __builtin_amdgcn_exp2f(S[kk][e] - mn); S[kk][e] = pv; ps += pv; } \
      lsum[QS] += ps; \
      PF[0] = mk8(pk4(S[0]), pk4(S[1])); PF[1] = mk8(pk4(S[2]), pk4(S[3])); } while (0)
#define ATILE(st, hh) do { \
    const u16* k_s = sK + (st) * KSZ + (hh) * 64 * KLD; \
    const u16* v_s = sV + (st) * VSZ + (hh) * 64; \
    f32x4 s0[4], s1[4]; bf16x8 pf0[2], pf1[2]; \
      \
    _Pragma("unroll") for (int kk = 0; kk < 4; ++kk) { \
      s0[kk] = f32x4{0, 0, 0, 0}; \
      _Pragma("unroll") for (int ks = 0; ks < 3; ++ks) \
        s0[kk] = mfma(*(const bf16x8*)(k_s + (kk * 16 + lr) * KLD + ks * 32 + lg * 8), qf[0][ks], s0[kk]); \
    } \
      \
    _Pragma("unroll") for (int kk = 0; kk < 4; ++kk) { \
      s1[kk] = f32x4{0, 0, 0, 0}; \
      _Pragma("unroll") for (int ks = 0; ks < 3; ++ks) \
        s1[kk] = mfma(*(const bf16x8*)(k_s + (kk * 16 + lr) * KLD + ks * 32 + lg * 8), qf[1][ks], s1[kk]); \
    } \
    SOFTMAX(s0, 0, pf0); \
      \
    _Pragma("unroll") for (int k2i = 0; k2i < 2; ++k2i) \
      _Pragma("unroll") for (int ds = 0; ds < 4; ++ds) { \
        const u16* vp = v_s + (ds * 16 + lr) * VLD + k2i * 32 + lg * 4; \
        o[ds][0] = mfma(mk8(*(const uint2*)vp, *(const uint2*)(vp + 16)), pf0[k2i], o[ds][0]); \
      } \
    SOFTMAX(s1, 1, pf1); \
      \
    _Pragma("unroll") for (int k2i = 0; k2i < 2; ++k2i) \
      _Pragma("unroll") for (int ds = 0; ds < 4; ++ds) { \
        const u16* vp = v_s + (ds * 16 + lr) * VLD + k2i * 32 + lg * 4; \
        o[ds][1] = mfma(mk8(*(const uint2*)vp, *(const uint2*)(vp + 16)), pf1[k2i], o[ds][1]); \
      } } while (0)
  const int nt = nkeys >> 7;
  AGLD(B, 0);
  AGLD(A, 128);
  __syncthreads();
  ASST(B, 0);
  __syncthreads();
  for (int kt = 0; kt < nt; kt += 2) {
    if (kt + 2 < nt) AGLD(B, (kt + 2) * 128);
    __builtin_amdgcn_sched_barrier(0);
    ATILE(0, 0);
    ATILE(0, 1);
    __builtin_amdgcn_sched_barrier(0);
    ASST(A, 1);
    __syncthreads();
    if (kt + 3 < nt) AGLD(A, (kt + 3) * 128);
    __builtin_amdgcn_sched_barrier(0);
    ATILE(1, 0);
    ATILE(1, 1);
    __builtin_amdgcn_sched_barrier(0);
    if (kt + 2 < nt) ASST(B, 0);
    __syncthreads();
  }
#undef ATILE
#undef SOFTMAX
#undef AGLD
#undef ASST
  u16* Y = (u16*)(ws + OFF_YMLA);
#pragma unroll
  for (int qs = 0; qs < 2; ++qs) {
    float ls = lsum[qs];
    ls += __shfl_xor(ls, 16); ls += __shfl_xor(ls, 32);
    const float inv = 1.f / ls;
    const int pq = p0 + w * 32 + qs * 16 + lr;
    const int r = isctx ? RL + b * LC + pq : b * L + (pq - LC);
#pragma unroll
    for (int ds = 0; ds < 4; ++ds) {
      f32x4 v = o[ds][qs];
#pragma unroll
      for (int e = 0; e < 4; ++e) v[e] *= inv;
      *(uint2*)(Y + (size_t)r * 512 + h * 64 + ds * 16 + lg * 4) = pk4(v);
    }
  }
}

DEV void gla_task(const P& p, int l, int b, int h, int dir, char* smem) {
  char* ws = WSP(p.ws);
  const int tid = TID(), lane = tid & 63, w = tid >> 6, lr = lane & 15, lg = lane >> 4;
  const u16* GQ = (const u16*)(ws + OFF_GQ); const u16* GK = (const u16*)(ws + OFF_GK);
  const u16* GV = (const u16*)(ws + OFF_GV); const u16* MISC = (const u16*)(ws + OFF_MISC);
  u16* OUT = (u16*)(ws + (dir ? OFF_OB : OFF_OF));
  constexpr int LD = 72, TS = 64 * LD;
  u16* sQ = (u16*)smem; u16* sK = sQ + TS; u16* sKLT = sK + TS; u16* sAL = sKLT + TS; u16* sVT = sAL + TS;
  float* sAf = (float*)(sVT + 2 * TS);
  float* sTot = sAf + 64 * 16;
  float* sEG = sTot + 512;
  const int gk = tid & 63, part = tid >> 6;
  float wa[16];
  {
    const float* W = p.in[I_WA2] + ((size_t)(l * 2 + dir) * 16) * 256 + h * 64 + gk;
#pragma unroll
    for (int r = 0; r < 16; ++r) wa[r] = W[r * 256];
  }
  const float ba = p.in[I_BA][(l * 2 + dir) * 256 + h * 64 + gk];
  f32x4 S[4];
#pragma unroll
  for (int i = 0; i < 4; ++i) S[i] = f32x4{0, 0, 0, 0};
  u32x4 rq0, rk0, rv0, rv1, ra;
  const int si0 = tid >> 3, sch = tid & 7;
  const int vi0 = tid >> 4, vi1 = (tid + 512) >> 4, vch = tid & 15;
#define ROWOF(n, i) ((n) < 4 ? (RL + b * LC + (dir ? (LC - 1 - (64 * (n) + (i))) : (64 * (n) + (i)))) \
                             : (b * L + (dir ? (L - 1 - (64 * ((n) - 4) + (i))) : (64 * ((n) - 4) + (i)))))
#define GGLD(n) do { size_t _r0 = (size_t)ROWOF(n, si0); \
    rq0 = *(gu4*)(GQ + _r0 * 256 + h * 64 + sch * 8); rk0 = *(gu4*)(GK + _r0 * 256 + h * 64 + sch * 8); \
    rv0 = *(gu4*)(GV + (size_t)ROWOF(n, vi0) * 512 + h * 128 + vch * 8); rv1 = *(gu4*)(GV + (size_t)ROWOF(n, vi1) * 512 + h * 128 + vch * 8); \
    if (tid < 128) ra = *(gu4*)(MISC + (size_t)ROWOF(n, tid >> 1) * 64 + 32 + dir * 16 + (tid & 1) * 8); } while (0)
#define VTW(rv, i) do { sVT[(vch * 8 + 0) * LD + (i)] = (u16)((rv).x & 0xffff); sVT[(vch * 8 + 1) * LD + (i)] = (u16)((rv).x >> 16); \
    sVT[(vch * 8 + 2) * LD + (i)] = (u16)((rv).y & 0xffff); sVT[(vch * 8 + 3) * LD + (i)] = (u16)((rv).y >> 16); \
    sVT[(vch * 8 + 4) * LD + (i)] = (u16)((rv).z & 0xffff); sVT[(vch * 8 + 5) * LD + (i)] = (u16)((rv).z >> 16); \
    sVT[(vch * 8 + 6) * LD + (i)] = (u16)((rv).w & 0xffff); sVT[(vch * 8 + 7) * LD + (i)] = (u16)((rv).w >> 16); } while (0)
  ra = u32x4{0u, 0u, 0u, 0u};
  GGLD(0);
  for (int n = 0; n < 68; ++n) {
    __syncthreads();
    *(u32x4*)(sQ + si0 * LD + sch * 8) = rq0;
    *(u32x4*)(sK + si0 * LD + sch * 8) = rk0;
    VTW(rv0, vi0); VTW(rv1, vi1);
    if (tid < 128) {
      float* ap = sAf + (tid >> 1) * 16 + (tid & 1) * 8;
      ap[0] = bf2f((u16)(ra.x & 0xffff)); ap[1] = bf2f((u16)(ra.x >> 16)); ap[2] = bf2f((u16)(ra.y & 0xffff)); ap[3] = bf2f((u16)(ra.y >> 16));
      ap[4] = bf2f((u16)(ra.z & 0xffff)); ap[5] = bf2f((u16)(ra.z >> 16)); ap[6] = bf2f((u16)(ra.w & 0xffff)); ap[7] = bf2f((u16)(ra.w >> 16));
    }
    __syncthreads();
    if (n + 1 < 68) GGLD(n + 1);
    __builtin_amdgcn_sched_barrier(0);
    float pre[8]; float run = 0.f;
#pragma unroll
    for (int ii = 0; ii < 8; ++ii) {
      const int i = part * 8 + ii;
      float x = ba;
#pragma unroll
      for (int r = 0; r < 16; ++r) x += sAf[i * 16 + r] * wa[r];
      float ls = fminf(x, 0.f) * 1.4426950408889634f - __builtin_amdgcn_logf(1.f + __builtin_amdgcn_exp2f(-fabsf(x) * 1.4426950408889634f));
      run += ls * (1.f / 16.f);
      pre[ii] = run;
    }
    sTot[part * 64 + gk] = run;
    __syncthreads();
    float off = 0.f, glast = 0.f;
#pragma unroll
    for (int q = 0; q < 8; ++q) { float tv = sTot[q * 64 + gk]; glast += tv; if (q < part) off += tv; }
    const float eglast = __builtin_amdgcn_exp2f(glast);
    if (part == 0) sEG[gk] = eglast;
    {
      float klt[8];
#pragma unroll
      for (int ii = 0; ii < 8; ++ii) {
        const int i = part * 8 + ii;
        const float G = off + pre[ii];
        float qv = bf2f(sQ[i * LD + gk]), kv = bf2f(sK[i * LD + gk]);
        const float eg = __builtin_amdgcn_exp2f(G), egi = __builtin_amdgcn_exp2f(-G);
        sQ[i * LD + gk] = f2bf(qv * 0.125f * eg);
        sK[i * LD + gk] = f2bf(kv * egi);
        klt[ii] = kv * (eglast * egi);
      }
      *(uint4*)(sKLT + gk * LD + part * 8) = make_uint4(pk2(klt[0], klt[1]), pk2(klt[2], klt[3]), pk2(klt[4], klt[5]), pk2(klt[6], klt[7]));
    }
    __syncthreads();
    {
      const int it = w & 3, jt0 = (w >> 2) * 2;
      bf16x8 qb[2];
#pragma unroll
      for (int m = 0; m < 2; ++m) qb[m] = *(const bf16x8*)(sQ + (it * 16 + lr) * LD + m * 32 + lg * 8);
      const int i = it * 16 + lr;
#pragma unroll
      for (int jj = 0; jj < 2; ++jj) {
        const int jt = jt0 + jj;
        f32x4 c = f32x4{0, 0, 0, 0};
#pragma unroll
        for (int m = 0; m < 2; ++m) c = mfma(*(const bf16x8*)(sK + (jt * 16 + lr) * LD + m * 32 + lg * 8), qb[m], c);
#pragma unroll
        for (int e = 0; e < 4; ++e) { int j = jt * 16 + lg * 4 + e; if (j > i) c[e] = 0.f; }
        *(uint2*)(sAL + i * LD + jt * 16 + lg * 4) = pk4(c);
      }
    }
    __syncthreads();
    {
      bf16x8 sa[2];
#pragma unroll
      for (int m = 0; m < 2; ++m) sa[m] = mk8(pk4(S[2 * m]), pk4(S[2 * m + 1]));
      bf16x8 vtf[2];
#pragma unroll
      for (int m = 0; m < 2; ++m) vtf[m] = *(const bf16x8*)(sVT + (w * 16 + lr) * LD + m * 32 + lg * 8);
      const bool store = (n >= 4) || (l == 0);
#pragma unroll
      for (int it = 0; it < 4; ++it) {
        f32x4 oc = f32x4{0, 0, 0, 0};
#pragma unroll
        for (int m = 0; m < 2; ++m) {
          const u16* qp = sQ + (it * 16 + lr) * LD + m * 32 + lg * 4;
          oc = mfma(sa[m], mk8(*(const uint2*)qp, *(const uint2*)(qp + 16)), oc);
          oc = mfma(vtf[m], *(const bf16x8*)(sAL + (it * 16 + lr) * LD + m * 32 + lg * 8), oc);
        }
        if (store) {
          size_t row = (size_t)ROWOF(n, it * 16 + lr);
          *(uint2*)(OUT + row * 512 + h * 128 + w * 16 + lg * 4) = pk4(oc);
        }
      }
#pragma unroll
      for (int kt = 0; kt < 4; ++kt) {
        f32x4 eg = *(const f32x4*)(sEG + kt * 16 + lg * 4);
        f32x4 c;
#pragma unroll
        for (int e = 0; e < 4; ++e) c[e] = S[kt][e] * eg[e];
#pragma unroll
        for (int m = 0; m < 2; ++m) c = mfma(*(const bf16x8*)(sKLT + (kt * 16 + lr) * LD + m * 32 + lg * 8), vtf[m], c);
        S[kt] = c;
      }
    }
  }
}
#undef ROWOF
#undef GGLD
#undef VTW
struct F8 { float v[8]; };
DEV F8 sconv8(const u16* row, int t0, float w0, float w1, float w2, float bb) {
  const u32x4 q = *(gu4*)(row + t0);
  const float lo = (t0 > 0) ? bf2f(row[t0 - 1]) : 0.f;
  const float hi = (t0 + 8 < L) ? bf2f(row[t0 + 8]) : 0.f;
  float u[10];
  u[0] = lo; u[9] = hi;
  u[1] = bf2f((u16)(q.x & 0xffff)); u[2] = bf2f((u16)(q.x >> 16)); u[3] = bf2f((u16)(q.y & 0xffff)); u[4] = bf2f((u16)(q.y >> 16));
  u[5] = bf2f((u16)(q.z & 0xffff)); u[6] = bf2f((u16)(q.z >> 16)); u[7] = bf2f((u16)(q.w & 0xffff)); u[8] = bf2f((u16)(q.w >> 16));
  F8 r;
#pragma unroll
  for (int j = 0; j < 8; ++j) r.v[j] = bb + w0 * u[j] + w1 * u[j + 1] + w2 * u[j + 2];
  return r;
}
DEV F8 ld8bf(const u16* row, int t0) {
  const u32x4 q = *(gu4*)(row + t0);
  F8 r;
  r.v[0] = bf2f((u16)(q.x & 0xffff)); r.v[1] = bf2f((u16)(q.x >> 16)); r.v[2] = bf2f((u16)(q.y & 0xffff)); r.v[3] = bf2f((u16)(q.y >> 16));
  r.v[4] = bf2f((u16)(q.z & 0xffff)); r.v[5] = bf2f((u16)(q.z >> 16)); r.v[6] = bf2f((u16)(q.w & 0xffff)); r.v[7] = bf2f((u16)(q.w >> 16));
  return r;
}
DEV void st8bf(u16* row, int t0, const F8& a) {
  *(uint4*)(row + t0) = make_uint4(pk2(a.v[0], a.v[1]), pk2(a.v[2], a.v[3]), pk2(a.v[4], a.v[5]), pk2(a.v[6], a.v[7]));
}
DEV void spec_mul(float2* buf, const float2* KSr) {
  const int tid = TID();
  float2 kv[8];
#pragma unroll
  for (int m = 0; m < 8; ++m) kv[m] = KSr[tid + NTH * m];
  const float2 klast = KSr[4096];
#pragma unroll
  for (int m = 0; m < 8; ++m) {
    const int f = tid + NTH * m;
    const int i1 = PADI(brev13(f));
    const float2 z = buf[i1];
    buf[i1] = make_float2(z.x * kv[m].x - z.y * kv[m].y, z.x * kv[m].y + z.y * kv[m].x);
    if (f != 0) {
      const int i2 = PADI(brev13(8192 - f));
      const float2 z2 = buf[i2];
      buf[i2] = make_float2(z2.x * kv[m].x + z2.y * kv[m].y, -z2.x * kv[m].y + z2.y * kv[m].x);
    }
  }
  if (tid == 0) {
    const int i1 = PADI(brev13(4096));
    const float2 z = buf[i1];
    buf[i1] = make_float2(z.x * klast.x - z.y * klast.y, z.x * klast.y + z.y * klast.x);
  }
  __syncthreads();
}
DEV void hyena_task(const P& p, int l, int c, int pr, char* smem) {
  char* ws = WSP(p.ws);
  float2* buf = (float2*)smem;
  const int tid = TID(), t0 = tid * 8;
  u16* HYT = (u16*)(ws + OFF_HYT);
  const float2* KS0 = (const float2*)(ws + OFF_KS) + (size_t)(0 * 512 + c) * KSLD;
  const float2* KS1 = (const float2*)(ws + OFF_KS) + (size_t)(1 * 512 + c) * KSLD;
  const float* sw = p.in[I_HSW] + (size_t)l * 3 * 1536; const float* sb = p.in[I_HSB] + l * 1536;
  const float wx1[4] = {sw[c], sw[1536 + c], sw[3072 + c], sb[c]};
  const float wx2[4] = {sw[512 + c], sw[1536 + 512 + c], sw[3072 + 512 + c], sb[512 + c]};
  const float wv[4] = {sw[1024 + c], sw[1536 + 1024 + c], sw[3072 + 1024 + c], sb[1024 + c]};
  const float bias0 = p.in[I_HYB][(l * 2 + 0) * 512 + c], bias1 = p.in[I_HYB][(l * 2 + 1) * 512 + c];
  {
    const int b0 = 2 * pr, b1 = 2 * pr + 1;
    const u16* x1r0 = HYT + ((size_t)(b0 * 2048 + c)) * L; const u16* x1r1 = HYT + ((size_t)(b1 * 2048 + c)) * L;
    const u16* x2r0 = x1r0 + (size_t)512 * L; const u16* x2r1 = x1r1 + (size_t)512 * L;
    const u16* vr0 = x1r0 + (size_t)1024 * L; const u16* vr1 = x1r1 + (size_t)1024 * L;
    u16* st0 = (u16*)(ws + OFF_YHY) + ((size_t)(b0 * 512 + c)) * L; u16* st1 = (u16*)(ws + OFF_YHY) + ((size_t)(b1 * 512 + c)) * L;
    __syncthreads();
    {
      const F8 va = sconv8(vr0, t0, wv[0], wv[1], wv[2], wv[3]), vb = sconv8(vr1, t0, wv[0], wv[1], wv[2], wv[3]);
#pragma unroll
      for (int j = 0; j < 8; ++j) buf[PADI(t0 + j)] = make_float2(va.v[j], vb.v[j]);
    }
    __syncthreads();
    fft_fwd<true>(buf);
    spec_mul(buf, KS0);
    fft_inv<true>(buf);
    {
      const F8 va = sconv8(vr0, t0, wv[0], wv[1], wv[2], wv[3]), vb = sconv8(vr1, t0, wv[0], wv[1], wv[2], wv[3]);
      const F8 ga = sconv8(x1r0, t0, wx1[0], wx1[1], wx1[2], wx1[3]), gb = sconv8(x1r1, t0, wx1[0], wx1[1], wx1[2], wx1[3]);
      F8 ya, yb;
#pragma unroll
      for (int j = 0; j < 8; ++j) {
        const float2 cv = buf[PADI(t0 + j)];
        ya.v[j] = ga.v[j] * (cv.x + bias0 * va.v[j]); yb.v[j] = gb.v[j] * (cv.y + bias0 * vb.v[j]);
        buf[PADI(t0 + j)] = make_float2(ya.v[j], yb.v[j]);
      }
      st8bf(st0, t0, ya); st8bf(st1, t0, yb);
    }
    __syncthreads();
    fft_fwd<true>(buf);
    spec_mul(buf, KS1);
    fft_inv<true>(buf);
    {
      u16* o0 = HYT + ((size_t)(b0 * 2048 + 1536 + c)) * L; u16* o1 = HYT + ((size_t)(b1 * 2048 + 1536 + c)) * L;
      const F8 ga = sconv8(x2r0, t0, wx2[0], wx2[1], wx2[2], wx2[3]), gb = sconv8(x2r1, t0, wx2[0], wx2[1], wx2[2], wx2[3]);
      const F8 sa = ld8bf(st0, t0), sbb = ld8bf(st1, t0);
      F8 oa, ob;
#pragma unroll
      for (int j = 0; j < 8; ++j) {
        const float2 cv = buf[PADI(t0 + j)];
        oa.v[j] = ga.v[j] * (cv.x + bias1 * sa.v[j]); ob.v[j] = gb.v[j] * (cv.y + bias1 * sbb.v[j]);
      }
      st8bf(o0, t0, oa); st8bf(o1, t0, ob);
    }
  }
  __syncthreads();
}

DEV void hyena_ctx_task(const P& p, int c, char* smem) {
  char* ws = WSP(p.ws);
  float* kk0 = (float*)smem; float* kk1 = kk0 + 512;
  float* sv = kk1 + 512;
  float* sy1 = sv + 512;
  const int tid = TID(), t = tid & 255, bs = tid >> 8;
  const float* KFC = (const float*)(ws + OFF_KFC);
  const float* NRM = (const float*)(ws + OFF_NORMC);
  const float in0 = 1.f / NRM[c], in1 = 1.f / NRM[512 + c];
  __syncthreads();
  if (bs == 0) {
    kk0[255 + t] = KFC[((size_t)(0 * 2 + 0) * 512 + c) * LC + t] * in0;
    kk1[255 + t] = KFC[((size_t)(1 * 2 + 0) * 512 + c) * LC + t] * in1;
    if (t > 0) {
      kk0[255 - t] = KFC[((size_t)(0 * 2 + 1) * 512 + c) * LC + t] * in0;
      kk1[255 - t] = KFC[((size_t)(1 * 2 + 1) * 512 + c) * LC + t] * in1;
    }
  }
  const float* sw = p.in[I_HSW]; const float* sb = p.in[I_HSB];
  const float bias0 = p.in[I_HYB][c], bias1 = p.in[I_HYB][512 + c];
  const u16* HYC = (const u16*)(ws + OFF_HYC);
  u16* YHY = (u16*)(ws + OFF_YHY);
  for (int bi = 0; bi < NB / 2; ++bi) {
    const int b = bi * 2 + bs;
    const u16* base = HYC + (size_t)(b * LC) * 1536;
    float u[3];
#pragma unroll
    for (int k = 0; k < 3; ++k) {
      int ch = k * 512 + c;
      float cc = bf2f(base[(size_t)t * 1536 + ch]);
      float a = (t > 0) ? bf2f(base[(size_t)(t - 1) * 1536 + ch]) : 0.f;
      float d = (t < LC - 1) ? bf2f(base[(size_t)(t + 1) * 1536 + ch]) : 0.f;
      u[k] = sb[ch] + sw[ch] * a + sw[1536 + ch] * cc + sw[3072 + ch] * d;
    }
    __syncthreads();
    sv[bs * 256 + t] = u[2];
    __syncthreads();
    float a0 = 0.f;
#pragma unroll 8
    for (int s = 0; s < LC; ++s) a0 += kk0[t + 255 - s] * sv[bs * 256 + s];
    const float y1 = u[0] * (a0 + bias0 * u[2]);
    sy1[bs * 256 + t] = y1;
    __syncthreads();
    float a1 = 0.f;
#pragma unroll 8
    for (int s = 0; s < LC; ++s) a1 += kk1[t + 255 - s] * sy1[bs * 256 + s];
    const float y2 = u[1] * (a1 + bias1 * y1);
    YHY[(size_t)(RL + b * LC + t) * 512 + c] = f2bf(y2);
  }
  __syncthreads();
}

DEV void phase_mix(const P& p, int l, int g, char* smem, int rep = 0) {
  unsigned* cnt = (unsigned*)(p.ws + OFF_CNT) + (rep * 4 + l * 2 + g);
  volatile int* s_taskp = (volatile int*)(smem + SMEM_BYTES + 16);
  const int n_gla = 32, n_hy = 1024, n_hyc = (l == 0) ? 512 : 0, n_at = 512, n_atc = (l == 0) ? 32 : 0;
  const int total = n_gla + n_hy + n_hyc + n_at + n_atc;
  fft_build_tw(smem);
  for (;;) {
    __syncthreads();
    if (TID() == 0) *s_taskp = (int)atomicAdd(cnt, 1u);
    __syncthreads();
    int t = *s_taskp;
    if (t >= total) break;
    if (t < n_gla) { gla_task(p, l, t >> 3, (t >> 1) & 3, t & 1, smem); continue; }
    t -= n_gla;
    if (t < n_at) { attn_task(p, t >> 7, (t >> 4) & 7, t & 15, false, smem); continue; }
    t -= n_at;
    if (t < n_hy) { hyena_task(p, l, t >> 1, t & 1, smem); continue; }
    t -= n_hy;
    if (t < n_atc) { attn_task(p, t >> 3, t & 7, 0, true, smem); continue; }
    t -= n_atc;
    hyena_ctx_task(p, t, smem);
  }
}

DEV void phase_post(const P& p, int l, int g, char* smem) {
  char* ws = WSP(p.ws);
  const int tid = TID();
  {
    u16* tile = (u16*)smem;
    const u16* HYT = (const u16*)(ws + OFF_HYT); u16* YHY = (u16*)(ws + OFF_YHY);
    u32x4 q0, q1;
    const int ecc0 = tid >> 4, ecc1 = (tid + NTH) >> 4, ech = tid & 15;
#define TLOAD(itx) do { const int _b = (itx) >> 8, _ct = ((itx) >> 5) & 7, _tt = (itx) & 31; \
      q0 = *(gu4*)(HYT + ((size_t)(_b * 2048 + 1536 + _ct * 64 + ecc0)) * L + _tt * 128 + ech * 8); \
      q1 = *(gu4*)(HYT + ((size_t)(_b * 2048 + 1536 + _ct * 64 + ecc1)) * L + _tt * 128 + ech * 8); } while (0)
    int it = BID();
    if (it < NB * 8 * 32) TLOAD(it);
    while (it < NB * 8 * 32) {
      const int b = it >> 8, ct = (it >> 5) & 7, tt = it & 31;
      __syncthreads();
      { unsigned* d0 = (unsigned*)(tile + ecc0 * 130 + ech * 8); d0[0] = q0.x; d0[1] = q0.y; d0[2] = q0.z; d0[3] = q0.w;
        unsigned* d1 = (unsigned*)(tile + ecc1 * 130 + ech * 8); d1[0] = q1.x; d1[1] = q1.y; d1[2] = q1.z; d1[3] = q1.w; }
      __syncthreads();
      const int itn = it + gridDim.x;
      if (itn < NB * 8 * 32) TLOAD(itn);
#pragma unroll
      for (int u = 0; u < 2; ++u) { const int e = tid + NTH * u, t2 = e >> 3, c8 = (e & 7) * 8;
        unsigned w0 = (unsigned)tile[(c8 + 0) * 130 + t2] | ((unsigned)tile[(c8 + 1) * 130 + t2] << 16);
        unsigned w1 = (unsigned)tile[(c8 + 2) * 130 + t2] | ((unsigned)tile[(c8 + 3) * 130 + t2] << 16);
        unsigned w2 = (unsigned)tile[(c8 + 4) * 130 + t2] | ((unsigned)tile[(c8 + 5) * 130 + t2] << 16);
        unsigned w3 = (unsigned)tile[(c8 + 6) * 130 + t2] | ((unsigned)tile[(c8 + 7) * 130 + t2] << 16);
        *(uint4*)(YHY + (size_t)(b * L + tt * 128 + t2) * 512 + ct * 64 + c8) = make_uint4(w0, w1, w2, w3); }
      it = itn;
    }
#undef TLOAD
  }
  {
    const int nrows = (l == 0) ? RG : RL;
    const int gw = BID() * 8 + (tid >> 6), NW = gridDim.x * 8, lane = tid & 63;
    u16* OF = (u16*)(ws + OFF_OF); const u16* OB = (const u16*)(ws + OFF_OB); const u16* GR = (const u16*)(ws + OFF_GR);
    const float* gn = p.in[I_GONORM] + l * 128;
    for (int r0 = gw; r0 < nrows; r0 += 2 * NW) {
      const int r1 = (r0 + NW < nrows) ? r0 + NW : r0;
      uint4 A0 = *(const uint4*)(OF + (size_t)r0 * 512 + lane * 8), B0 = *(const uint4*)(OB + (size_t)r0 * 512 + lane * 8), R0 = *(const uint4*)(GR + (size_t)r0 * 512 + lane * 8);
      uint4 A1 = *(const uint4*)(OF + (size_t)r1 * 512 + lane * 8), B1 = *(const uint4*)(OB + (size_t)r1 * 512 + lane * 8), R1 = *(const uint4*)(GR + (size_t)r1 * 512 + lane * 8);
      const int v0 = (lane & 15) * 8;
#pragma unroll
      for (int k = 0; k < 2; ++k) {
        const uint4 a = k ? A1 : A0, bb = k ? B1 : B0, rr = k ? R1 : R0;
        unsigned av[4] = {a.x, a.y, a.z, a.w}, bv[4] = {bb.x, bb.y, bb.z, bb.w}, rv[4] = {rr.x, rr.y, rr.z, rr.w};
        float o[8]; float ss = 0.f;
#pragma unroll
        for (int e = 0; e < 4; ++e) {
          o[2 * e] = bf2f((u16)(av[e] & 0xffff)) + bf2f((u16)(bv[e] & 0xffff));
          o[2 * e + 1] = bf2f((u16)(av[e] >> 16)) + bf2f((u16)(bv[e] >> 16));
          ss += o[2 * e] * o[2 * e] + o[2 * e + 1] * o[2 * e + 1];
        }
        ss += __shfl_xor(ss, 1); ss += __shfl_xor(ss, 2); ss += __shfl_xor(ss, 4); ss += __shfl_xor(ss, 8);
        const float rstd = rsqrtf(ss * (1.f / 128.f) + EPS);
        float y[8];
#pragma unroll
        for (int e = 0; e < 4; ++e) {
          float q0 = bf2f((u16)(rv[e] & 0xffff)), q1 = bf2f((u16)(rv[e] >> 16));
          y[2 * e] = o[2 * e] * rstd * gn[v0 + 2 * e] * (q0 * sigmoidf(q0));
          y[2 * e + 1] = o[2 * e + 1] * rstd * gn[v0 + 2 * e + 1] * (q1 * sigmoidf(q1));
        }
        if (k == 0 || r1 != r0)
          *(uint4*)(OF + (size_t)(k ? r1 : r0) * 512 + lane * 8) = make_uint4(pk2(y[0], y[1]), pk2(y[2], y[3]), pk2(y[4], y[5]), pk2(y[6], y[7]));
      }
    }
  }
}

DEV bool tile_swz8(int i, int MT, int& mt, int& nt) {
  if (gridDim.x != 256) { int t = BID() + i * gridDim.x; mt = t >> 3; nt = t & 7; return t < MT * 8; }
  const int b = BID(), x = b & 7, j = b >> 3, tl = i * 32 + j;
  nt = tl & 7; mt = (tl >> 3) * 8 + x;
  return mt < MT;
}
DEV int tile_swz8_rounds(int MT) { return (gridDim.x != 256) ? (MT * 8 + gridDim.x - 1) / gridDim.x : (((MT + 7) >> 3) * 8 + 31) / 32; }

DEV void phase_merge(const P& p, int l, int g, char* smem) {
  char* ws = WSP(p.ws);
  const int tid = TID(), lane = tid & 63, w = tid >> 6, wr = w >> 1, wc = w & 1, lr = lane & 15, lg = lane >> 4;
  const int MT = (l == 0) ? 68 : 64;
  const u16* GATES = (const u16*)(ws + OFF_GATES);
  u16* M = (u16*)(ws + OFF_HX);
  const int nrounds = tile_swz8_rounds(MT);
  bool first = true;
  for (int it = 0; it < nrounds; ++it) {
    int mt, nt;
    if (!tile_swz8(it, MT, mt, nt)) continue;
    const int m0 = mt * 256, n0 = nt * 128;
    int mt2 = 0, nt2 = 0; bool hn = false;
    for (int i2 = it + 1; i2 < nrounds && !hn; ++i2) hn = tile_swz8(i2, MT, mt2, nt2);
    f32x4 macc[4][4]; zero_acc<4>(macc);
#pragma unroll 1
    for (int br = 0; br < 3; ++br) {
      const u16* Y = (const u16*)(ws + (br == 0 ? OFF_YMLA : (br == 1 ? OFF_OF : OFF_YHY)));
      const u16* W = (const u16*)(ws + (br == 0 ? OFF_WOM : (br == 1 ? OFF_WOG : OFF_WOH)));
      const int nb = (br + 1) % 3;
      const u16* Y2 = (const u16*)(ws + (nb == 0 ? OFF_YMLA : (nb == 1 ? OFF_OF : OFF_YHY)));
      const u16* W2 = (const u16*)(ws + (nb == 0 ? OFF_WOM : (nb == 1 ? OFF_WOG : OFF_WOH)));
      const bool hn2 = (br < 2) || hn;
      const int m2 = (br < 2) ? m0 : mt2 * 256, n2 = (br < 2) ? n0 : nt2 * 128;
      f32x4 acc[4][4]; zero_acc<4>(acc);
      gemm_core<true, 128, true>(acc, Y + (size_t)m0 * 512, 512, W + (size_t)n0 * 512, 512, 512, (u16*)smem, first,
                                 hn2 ? Y2 + (size_t)m2 * 512 : nullptr, 512, W2 + (size_t)n2 * 512, 512);
      first = false;
#pragma unroll
      for (int mi = 0; mi < 4; ++mi) {
        const int r = m0 + wr * 64 + mi * 16 + lr;
#pragma unroll
        for (int np = 0; np < 2; ++np) {
          const uint4 gg = *(const uint4*)(GATES + (size_t)r * 3072 + br * 1024 + n0 + wc * 64 + np * 32 + lg * 8);
          macc[mi][2 * np][0] += acc[mi][2 * np][0] * bf2f((u16)(gg.x & 0xffff));
          macc[mi][2 * np][1] += acc[mi][2 * np][1] * bf2f((u16)(gg.x >> 16));
          macc[mi][2 * np][2] += acc[mi][2 * np][2] * bf2f((u16)(gg.y & 0xffff));
          macc[mi][2 * np][3] += acc[mi][2 * np][3] * bf2f((u16)(gg.y >> 16));
          macc[mi][2 * np + 1][0] += acc[mi][2 * np + 1][0] * bf2f((u16)(gg.z & 0xffff));
          macc[mi][2 * np + 1][1] += acc[mi][2 * np + 1][1] * bf2f((u16)(gg.z >> 16));
          macc[mi][2 * np + 1][2] += acc[mi][2 * np + 1][2] * bf2f((u16)(gg.w & 0xffff));
          macc[mi][2 * np + 1][3] += acc[mi][2 * np + 1][3] * bf2f((u16)(gg.w >> 16));
        }
      }
    }
#pragma unroll
    for (int mi = 0; mi < 4; ++mi) {
      const int r = m0 + wr * 64 + mi * 16 + lr;
#pragma unroll
      for (int np = 0; np < 2; ++np) {
        const uint2 lo = pk4(macc[mi][2 * np]), hi = pk4(macc[mi][2 * np + 1]);
        *(uint4*)(M + (size_t)r * D + n0 + wc * 64 + np * 32 + lg * 8) = make_uint4(lo.x, lo.y, hi.x, hi.y);
      }
    }
  }
}

DEV void xs_ptrs(const P& p, int l, int g, const float*& srcl, const float*& srcc, float*& dstl, float*& dstc, bool first) {
  dstl = p.out + (size_t)g * RL * D;
  dstc = (float*)(p.ws + OFF_CTXS) + (size_t)g * RC * D;
  if (first && l == 0) { srcl = p.in[I_X] + (size_t)g * RL * D; srcc = p.in[I_CTX] + (size_t)g * RC * D; }
  else { srcl = dstl; srcc = dstc; }
}
DEV void phase_resid(const P& p, int l, int g, char* smem, bool isout) {
  char* ws = WSP(p.ws);
  const int tid = TID(), lane = tid & 63, w = tid >> 6, wr = w >> 1, wc = w & 1, lr = lane & 15, lg = lane >> 4;
  const int MT = (l == 0) ? 68 : 64;
  const float *srcl, *srcc; float *dstl, *dstc;
  xs_ptrs(p, l, g, srcl, srcc, dstl, dstc, isout);
  const u16* A = (const u16*)(ws + (isout ? OFF_HX : OFF_H));
  const u16* W = (const u16*)(ws + (isout ? OFF_WOUT : OFF_W2));
  const int K = isout ? 1024 : 4096;
  const float* MOD = (const float*)(ws + OFF_MOD) + (size_t)l * 9 * 6144;
  const int goff = isout ? 2048 : 5120;
  const int nrounds = tile_swz8_rounds(MT);
  bool first = true;
  for (int it = 0; it < nrounds; ++it) {
    int mt, nt;
    if (!tile_swz8(it, MT, mt, nt)) continue;
    const int m0 = mt * 256, n0 = nt * 128;
    int mt2 = 0, nt2 = 0; bool hn = false;
    for (int i2 = it + 1; i2 < nrounds && !hn; ++i2) hn = tile_swz8(i2, MT, mt2, nt2);
    f32x4 acc[4][4]; zero_acc<4>(acc);
    gemm_core<true, 128>(acc, A + (size_t)m0 * K, K, W + (size_t)n0 * K, K, K, (u16*)smem, first,
                         hn ? A + (size_t)mt2 * 256 * K : nullptr, K, W + (size_t)nt2 * 128 * K, K);
    first = false;
    const float* gate = MOD + (size_t)((m0 < RL) ? (g * NB + (m0 >> 12)) : 8) * 6144 + goff + n0 + wc * 64 + lg * 4;
    f32x4 gv[4];
#pragma unroll
    for (int ni = 0; ni < 4; ++ni) gv[ni] = *(const f32x4*)(gate + ni * 16);
    f32x4 xv[4][4];
#pragma unroll
    for (int mi = 0; mi < 4; ++mi) {
      const int r = m0 + wr * 64 + mi * 16 + lr;
      const float* src = (r < RL) ? srcl + (size_t)r * D : srcc + (size_t)(r - RL) * D;
#pragma unroll
      for (int ni = 0; ni < 4; ++ni) xv[mi][ni] = *(const f32x4*)(src + n0 + wc * 64 + ni * 16 + lg * 4);
    }
#pragma unroll
    for (int mi = 0; mi < 4; ++mi) {
      const int r = m0 + wr * 64 + mi * 16 + lr;
      float* dst = (r < RL) ? dstl + (size_t)r * D : dstc + (size_t)(r - RL) * D;
#pragma unroll
      for (int ni = 0; ni < 4; ++ni) {
        f32x4 y;
#pragma unroll
        for (int e = 0; e < 4; ++e) y[e] = xv[mi][ni][e] + gv[ni][e] * acc[mi][ni][e];
        *(f32x4*)(dst + n0 + wc * 64 + ni * 16 + lg * 4) = y;
      }
    }
  }
}
DEV void phase_mlp1(const P& p, int l, int g, char* smem) {
  char* ws = WSP(p.ws);
  const int tid = TID(), lane = tid & 63, w = tid >> 6, wr = w >> 2, wc = w & 3, lr = lane & 15, lg = lane >> 4;
  const int MT = (l == 0) ? 68 : 64, ntiles = MT * 16;
  const u16* A = (const u16*)(ws + OFF_HX); const u16* W = (const u16*)(ws + OFF_W1); u16* H = (u16*)(ws + OFF_H);
  for (int t = BID(); t < ntiles; t += gridDim.x) {
    const int mt = t >> 4, nt = t & 15, m0 = mt * 256, n0 = nt * 256;
    const int t2 = t + gridDim.x; const bool hn = t2 < ntiles;
    f32x4 acc[8][4]; zero_acc<8>(acc);
    gemm_core<true, 256, true>(acc, A + (size_t)m0 * D, D, W + (size_t)n0 * D, D, D, (u16*)smem, t == BID(),
                               hn ? A + (size_t)(t2 >> 4) * 256 * D : nullptr, D, W + (size_t)(t2 & 15) * 256 * D, D);
#pragma unroll
    for (int mi = 0; mi < 8; ++mi) {
      const int r = m0 + wr * 128 + mi * 16 + lr;
#pragma unroll
      for (int np = 0; np < 2; ++np) {
        f32x4 v = acc[mi][2 * np], v2 = acc[mi][2 * np + 1];
#pragma unroll
        for (int e = 0; e < 4; ++e) { float x = fmaxf(v[e], 0.f); v[e] = x * x; float y = fmaxf(v2[e], 0.f); v2[e] = y * y; }
        const uint2 lo = pk4(v), hi = pk4(v2);
        *(uint4*)(H + (size_t)r * DFF + n0 + wc * 64 + np * 32 + lg * 8) = make_uint4(lo.x, lo.y, hi.x, hi.y);
      }
    }
  }
}

DEV void phase_final(const P& p) {
  const int gw = BID() * 8 + (TID() >> 6), NW = gridDim.x * 8, lane = TID() & 63;
  const float* gain = p.in[I_FNG];
  f32x4 gg[4];
#pragma unroll
  for (int j = 0; j < 4; ++j) gg[j] = *(const f32x4*)(gain + j * 256 + lane * 4);
  for (int r = gw; r < 32768; r += 2 * NW) {
    float* s0 = p.out + (size_t)r * D; float* s1 = p.out + (size_t)(r + NW) * D;
    f32x4 a[4], b[4]; float sa = 0.f, sb = 0.f;
#pragma unroll
    for (int j = 0; j < 4; ++j) { a[j] = *(const f32x4*)(s0 + j * 256 + lane * 4); b[j] = *(const f32x4*)(s1 + j * 256 + lane * 4); }
#pragma unroll
    for (int j = 0; j < 4; ++j) {
      sa += a[j][0] * a[j][0] + a[j][1] * a[j][1] + a[j][2] * a[j][2] + a[j][3] * a[j][3];
      sb += b[j][0] * b[j][0] + b[j][1] * b[j][1] + b[j][2] * b[j][2] + b[j][3] * b[j][3];
    }
    const float ra = rsqrtf(wave_sum(sa) * (1.f / D) + EPS), rb = rsqrtf(wave_sum(sb) * (1.f / D) + EPS);
#pragma unroll
    for (int j = 0; j < 4; ++j) {
      f32x4 ya, yb;
#pragma unroll
      for (int e = 0; e < 4; ++e) { ya[e] = a[j][e] * ra * gg[j][e]; yb[e] = b[j][e] * rb * gg[j][e]; }
      *(f32x4*)(s0 + j * 256 + lane * 4) = ya;
      *(f32x4*)(s1 + j * 256 + lane * 4) = yb;
    }
  }
}

#define XB_TMO      128
#define XB_XCNT(j)  (256  + 64 * (j))
#define XB_XSUB(j)  (1280 + 64 * (j))
#define XB_XGEN(j)  (2304 + 64 * (j))
#define XB_TOP      3328
#define XB_TOPGEN   3392
#define XCD_BAR_WORDS 3456
#define XB_SPIN_CAP (1u << 22)
DEV unsigned xb_ld(unsigned* p) { return __hip_atomic_load(p, __ATOMIC_RELAXED, __HIP_MEMORY_SCOPE_AGENT); }
DEV unsigned xb_add(unsigned* p, unsigned v) { return __hip_atomic_fetch_add(p, v, __ATOMIC_RELAXED, __HIP_MEMORY_SCOPE_AGENT); }
DEV unsigned xb_xcc_id() { return (unsigned)__builtin_amdgcn_s_getreg((3 << 11) | 20) & 0xFu; }
#define XB_SPIN(cond, bar) do { unsigned _sp = 0; while (cond) { __builtin_amdgcn_s_sleep(1); \
    if ((++_sp & 255u) == 0u) { if (xb_ld(&(bar)[XB_TMO])) break; if (_sp > XB_SPIN_CAP) { atomicAdd(&(bar)[XB_TMO], 1u); break; } } } } while (0)
struct XcdBarrier { unsigned* bar; unsigned x; volatile LAS unsigned* st; };
DEV XcdBarrier xcd_barrier_post(unsigned* bar, volatile LAS unsigned* st) {
  XcdBarrier b; b.bar = bar; b.x = xb_xcc_id(); b.st = st;
  if (threadIdx.x == 0) (void)xb_add(&bar[XB_XCNT(b.x)], 1u);
  return b;
}
DEV void xcd_barrier_complete(unsigned* bar, unsigned x, unsigned& nloc, unsigned& nx) {
  const unsigned G = gridDim.x * gridDim.y * gridDim.z;
  unsigned sum, cnt, mine, sp = 0u;
  for (;;) {
    sum = 0u; cnt = 0u; mine = 0u;
#pragma unroll
    for (unsigned j = 0; j < 16; ++j) { const unsigned c = xb_ld(&bar[XB_XCNT(j)]); sum += c; cnt += (c > 0u) ? 1u : 0u; mine = (j == x) ? c : mine; }
    if (sum == G) break;
    __builtin_amdgcn_s_sleep(1);
    if ((++sp & 255u) == 0u) { if (xb_ld(&bar[XB_TMO])) break; if (sp > XB_SPIN_CAP) { atomicAdd(&bar[XB_TMO], 1u); break; } }
  }
  nloc = mine > 0u ? mine : 1u; nx = cnt > 0u ? cnt : 1u;
}
DEV void xcd_barrier(const XcdBarrier& b) {
  asm volatile("s_waitcnt vmcnt(0)" ::: "memory");
  __syncthreads();
  if (threadIdx.x == 0) {
    unsigned* bar = b.bar;
    __builtin_amdgcn_s_waitcnt(0);
    unsigned nloc = b.st[0], nx = b.st[1];
    if (nloc == 0u) { xcd_barrier_complete(bar, b.x, nloc, nx); b.st[0] = nloc; b.st[1] = nx; }
    const unsigned old = xb_add(&bar[XB_XSUB(b.x)], 1u);
    const unsigned gen = old / nloc;
    if (old + 1u == (gen + 1u) * nloc) {
      __builtin_amdgcn_fence(__ATOMIC_RELEASE, "agent");
      asm volatile("s_waitcnt vmcnt(0)" ::: "memory");
      const unsigned og = xb_add(&bar[XB_TOP], 1u);
      const unsigned tg = og / nx;
      if (og + 1u == (tg + 1u) * nx) xb_add(&bar[XB_TOPGEN], 1u);
      else XB_SPIN(xb_ld(&bar[XB_TOPGEN]) == tg, bar);
      __builtin_amdgcn_fence(__ATOMIC_ACQUIRE, "agent");
      xb_add(&bar[XB_XGEN(b.x)], 1u);
      asm volatile("s_waitcnt vmcnt(0)" ::: "memory");
    } else {
      XB_SPIN(xb_ld(&bar[XB_XGEN(b.x)]) == gen, bar);
      __builtin_amdgcn_fence(__ATOMIC_ACQUIRE, "agent");
      asm volatile("s_waitcnt vmcnt(0)" ::: "memory");
    }
  }
  __syncthreads();
}

DEV void run_phase(const P& p, int ph, char* smem) {
#if !defined(ONLY_SUB) || ONLY_SUB == 10
  if (ph == 0) { phase_prep(p, 0, smem); return; }
  if (ph == 21) { phase_prep(p, 1, smem); return; }
#endif
#if !defined(ONLY_SUB) || ONLY_SUB == 11
  if (ph == 42) { phase_final(p); return; }
#endif
  const int l = ph > 21 ? 1 : 0;
  const int q = ph - (l ? 22 : 1);
  const int g = q / 10, sub = q % 10;
  const float* MOD = (const float*)(p.ws + OFF_MOD) + (size_t)l * 9 * 6144;
  switch (sub) {
#if !defined(ONLY_SUB) || ONLY_SUB == 0
    case 0: {
      if (g == 0) { fft_build_tw(smem); for (int c = BID(); c < 512; c += gridDim.x) filtfft_task(p, l, c, smem); }
      const float *srcl, *srcc; float *dl, *dc;
      xs_ptrs(p, l, g, srcl, srcc, dl, dc, true);
      norm_rows(srcl, srcc, p.in[I_N1G] + l * D, MOD + (size_t)(g * NB) * 6144, MOD + (size_t)8 * 6144, 0, (u16*)(p.ws + OFF_HX), RG);
    } break;
#endif
#if !defined(ONLY_SUB) || ONLY_SUB == 1
    case 1: phase_win(p, l, g, smem); break;
#endif
#if !defined(ONLY_SUB) || ONLY_SUB == 2
    case 2: phase_up(p, l, g, smem); break;
#endif
#if !defined(ONLY_SUB) || ONLY_SUB == 3
    case 3: phase_mix(p, l, g, smem); break;
#endif
#if !defined(ONLY_SUB) || ONLY_SUB == 4
    case 4: phase_post(p, l, g, smem); break;
#endif
#if !defined(ONLY_SUB) || ONLY_SUB == 5
    case 5: phase_merge(p, l, g, smem); break;
#endif
#if !defined(ONLY_SUB) || ONLY_SUB == 6
    case 6: phase_resid(p, l, g, smem, true); break;
#endif
#if !defined(ONLY_SUB) || ONLY_SUB == 7
    case 7: {
      const float *srcl, *srcc; float *dl, *dc;
      xs_ptrs(p, l, g, srcl, srcc, dl, dc, false);
      norm_rows(srcl, srcc, p.in[I_N2G] + l * D, MOD + (size_t)(g * NB) * 6144, MOD + (size_t)8 * 6144, 3072, (u16*)(p.ws + OFF_HX), (l == 0) ? RG : RL);
    } break;
#endif
#if !defined(ONLY_SUB) || ONLY_SUB == 8
    case 8: phase_mlp1(p, l, g, smem); break;
#endif
#if !defined(ONLY_SUB) || ONLY_SUB == 9
    case 9: phase_resid(p, l, g, smem, false); break;
#endif
  }
}

__global__ void __launch_bounds__(512) mega(P p) {
  __shared__ __attribute__((aligned(16))) char smem[SMEM_BYTES + 32];
  cg::grid_group grid = cg::this_grid();
  if (threadIdx.x == 0) *(uint4*)(smem + SMEM_BYTES) = make_uint4(0u, 0u, 0u, 0u);
  __syncthreads();
  XcdBarrier xb = xcd_barrier_post((unsigned*)(p.ws + OFF_BAR), (volatile LAS unsigned*)(smem + SMEM_BYTES));
  if (p.ph_hi > 1000) grid.sync();
  for (int ph = p.ph_lo; ph < p.ph_hi; ++ph) {
    run_phase(p, ph, smem);
    if (ph + 1 < p.ph_hi) xcd_barrier(xb);
  }
}

extern "C" void kernel_launch(void* const* d_in, const int* in_sizes, int n_in, void* d_out, int out_size, void* d_ws, size_t ws_size,
                              hipStream_t stream) {
  static int grid_blocks = 0;
  if (!grid_blocks) {
    int dev = 0, cus = 0, per_cu = 0;
    hipGetDevice(&dev);
    hipDeviceGetAttribute(&cus, hipDeviceAttributeMultiprocessorCount, dev);
    hipOccupancyMaxActiveBlocksPerMultiprocessor(&per_cu, mega, NTH, 0);
    per_cu = 1;
    grid_blocks = cus * per_cu;
    if (ws_size < WS_NEED) { fprintf(stderr, "workspace too small: %zu < %zu\n", ws_size, (size_t)WS_NEED); grid_blocks = -1; }
  }
  if (grid_blocks < 0 || n_in != 32) return;
  hipMemsetAsync(d_ws, 0, CTRL_BYTES, stream);
  P p{};
  for (int i = 0; i < 32; ++i) p.in[i] = (const float*)d_in[i];
  p.out = (float*)d_out; p.ws = (char*)d_ws;
#if SINGLE_LAUNCH
  p.ph_lo = 0; p.ph_hi = NPHASE;
  void* args[] = {&p};
  hipError_t e = hipLaunchCooperativeKernel((void*)mega, dim3(grid_blocks), dim3(NTH), args, 0, stream);
  if (e != hipSuccess) fprintf(stderr, "cooperative launch failed: %s (grid %d)\n", hipGetErrorString(e), grid_blocks);
#else
  for (int ph = 0; ph < NPHASE; ++ph) {
    p.ph_lo = ph; p.ph_hi = ph + 1;
    hipLaunchKernelGGL(mega, dim3(grid_blocks), dim3(NTH), 0, stream, p);
  }
#endif
}
```

```cpp
#include <hip/hip_runtime.h>
#include <hip/hip_bf16.h>
#include <hip/hip_cooperative_groups.h>
#include <cstdio>
namespace cg = cooperative_groups;

typedef unsigned short u16;
typedef __attribute__((ext_vector_type(8))) short bf16x8;
typedef __attribute__((ext_vector_type(4))) float f32x4;
#define DEV __device__ __forceinline__
#define GAS __attribute__((address_space(1)))
#define LAS __attribute__((address_space(3)))
typedef unsigned int u32x4 __attribute__((ext_vector_type(4)));
typedef GAS const u32x4 gu4;

#ifndef SINGLE_LAUNCH
#define SINGLE_LAUNCH 1
#endif

constexpr int D = 1024, L = 4096, LC = 256, NB = 4, NGRP = 2;
constexpr int RL = NB * L, RC = NB * LC, RG = RL + RC;
constexpr int NIN = 6656;
constexpr int PK = L + LC;
constexpr int DFF = 4096;
constexpr int KSLD = 4104;
constexpr float EPS = 1e-6f;
constexpr int NPHASE = 43;

constexpr size_t al(size_t x) { return (x + 255) & ~(size_t)255; }
constexpr size_t CTRL_BYTES = 1 << 20;
constexpr size_t OFF_CNT = 0;
constexpr size_t OFF_NORM = 1024;
constexpr size_t OFF_NORMC = OFF_NORM + 2 * 1024 * 4;
constexpr size_t OFF_SSQ = 16384;
constexpr size_t OFF_BAR = 573440;
constexpr size_t OFF_MOD = 587264;
static_assert(OFF_SSQ + (size_t)2 * 2 * 34816 * 4 <= OFF_BAR && OFF_MOD + 2 * 9 * 6144 * 4 <= CTRL_BYTES, "ctrl map");
constexpr size_t OFF_CTXS = CTRL_BYTES;
constexpr size_t OFF_WIN = OFF_CTXS + (size_t)2048 * 1024 * 4;
constexpr size_t OFF_WUQ = OFF_WIN + (size_t)NIN * 1024 * 2;
constexpr size_t OFF_WUKV = OFF_WUQ + (size_t)768 * 256 * 2;
constexpr size_t OFF_WOM = OFF_WUKV + (size_t)1024 * 128 * 2;
constexpr size_t OFF_WOG = OFF_WOM + (size_t)1024 * 512 * 2;
constexpr size_t OFF_WOH = OFF_WOG + (size_t)1024 * 512 * 2;
constexpr size_t OFF_WOUT = OFF_WOH + (size_t)1024 * 512 * 2;
constexpr size_t OFF_W1 = OFF_WOUT + (size_t)1024 * 1024 * 2;
constexpr size_t OFF_W2 = OFF_W1 + (size_t)4096 * 1024 * 2;
constexpr size_t OFF_KS = OFF_W2 + (size_t)4096 * 1024 * 2;
constexpr size_t OFF_KFC = OFF_KS + (size_t)1024 * KSLD * 8;
constexpr size_t OFF_HX = OFF_KFC + (size_t)2 * 2 * 512 * 256 * 4;
constexpr size_t OFF_Q = OFF_HX + (size_t)RG * 1024 * 2;
constexpr size_t OFF_K = OFF_Q + (size_t)NB * 8 * PK * 96 * 2;
constexpr size_t OFF_VT = OFF_K + (size_t)NB * 8 * PK * 96 * 2;
constexpr size_t OFF_YMLA = OFF_VT + (size_t)NB * 8 * 64 * PK * 2;
constexpr size_t OFF_OF = OFF_YMLA + (size_t)RG * 512 * 2;
constexpr size_t OFF_OB = OFF_OF + (size_t)RG * 512 * 2;
constexpr size_t OFF_YHY = OFF_OB + (size_t)RG * 512 * 2;
constexpr size_t OFF_Z = OFF_YHY + (size_t)RG * 512 * 2;
constexpr size_t OFF_ZQ = OFF_Z;
constexpr size_t OFF_ZKV = OFF_ZQ + (size_t)RG * 256 * 2;
constexpr size_t OFF_MISC = OFF_ZKV + (size_t)RG * 128 * 2;
constexpr size_t OFF_GQ = OFF_MISC + (size_t)RG * 64 * 2;
constexpr size_t OFF_GK = OFF_GQ + (size_t)RG * 256 * 2;
constexpr size_t OFF_GV = OFF_GK + (size_t)RG * 256 * 2;
constexpr size_t OFF_GR = OFF_GV + (size_t)RG * 512 * 2;
constexpr size_t OFF_HYT = OFF_GR + (size_t)RG * 512 * 2;
constexpr size_t OFF_HYC = OFF_HYT + (size_t)NB * 2048 * L * 2;
constexpr size_t OFF_GATES = OFF_HYC + (size_t)RC * 1536 * 2;
constexpr size_t OFF_END1 = OFF_GATES + (size_t)RG * 3072 * 2;
constexpr size_t OFF_H = OFF_Z;
constexpr size_t OFF_END2 = OFF_H + (size_t)RG * 4096 * 2;
constexpr size_t WS_NEED = OFF_END1 > OFF_END2 ? OFF_END1 : OFF_END2;
static_assert(WS_NEED <= ((size_t)512 << 20), "workspace over 512 MiB");
static_assert((size_t)2 * 512 * 8192 * 4 <= (size_t)RG * 3072 * 2, "KF alias");

constexpr int SMEM_BYTES = 131072;
constexpr int NTH = 512;

struct P {
  const float* in[32];
  float* out;
  char* ws;
  int ph_lo, ph_hi;
};
enum { I_X = 0, I_C, I_CTX, I_CCTX, I_ADAW, I_ADAB, I_N1G, I_N2G, I_WIN, I_QNORM, I_WUQ, I_KVNORM, I_WUKV, I_WA2, I_BA,
       I_GONORM, I_HSW, I_HSB, I_FW1, I_FB1, I_FW2, I_FB2, I_FW3, I_FB3, I_HYB, I_WOM, I_WOG, I_WOH, I_WOUT, I_FF1, I_FF2, I_FNG };

DEV int TID() { int t = threadIdx.x; asm volatile("" : "+v"(t)); return t; }
DEV int BID() { int b = blockIdx.x; asm volatile("" : "+s"(b)); return b; }
DEV char* WSP(char* w) { asm volatile("" : "+s"(w)); return w; }
typedef __bf16 bf16x2_t __attribute__((ext_vector_type(2)));
typedef float f32x2_t __attribute__((ext_vector_type(2)));
DEV u16 f2bf(float f) { return __builtin_bit_cast(u16, (__bf16)f); }
DEV float bf2f(u16 h) { return __uint_as_float(((unsigned)h) << 16); }
DEV unsigned pk2(float a, float b) { f32x2_t v = {a, b}; bf16x2_t r = __builtin_convertvector(v, bf16x2_t); return __builtin_bit_cast(unsigned, r); }
DEV uint2 pk4(f32x4 v) { return make_uint2(pk2(v[0], v[1]), pk2(v[2], v[3])); }
DEV float wave_sum(float v) {
#pragma unroll
  for (int o = 1; o < 64; o <<= 1) v += __shfl_xor(v, o);
  return v;
}
DEV float sigmoidf(float x) { return 1.f / (1.f + __expf(-x)); }
DEV bf16x8 mk8(uint2 a, uint2 b) {
  union { uint4 u; bf16x8 v; } t; t.u = make_uint4(a.x, a.y, b.x, b.y); return t.v;
}
DEV f32x4 mfma(bf16x8 a, bf16x8 b, f32x4 c) { return __builtin_amdgcn_mfma_f32_16x16x32_bf16(a, b, c, 0, 0, 0); }
DEV void rowinfo(int r, int& b, int& p) {
  if (r < RL) { b = r >> 12; p = LC + (r & (L - 1)); } else { int rc = r - RL; b = rc >> 8; p = rc & (LC - 1); }
}

constexpr int LDT = 72;
constexpr int STG = 128 * LDT;
template <bool SWAP, int TN, bool PERM = false, bool PERMA = false>
DEV void gemm_core(f32x4 (&acc)[TN == 256 ? 8 : 4][4], const u16* __restrict__ A, int lda, const u16* __restrict__ B, int ldb, int K, u16* sm,
                   bool first = true, const u16* nA = nullptr, int nlda = 0, const u16* nB = nullptr, int nldb = 0) {
  constexpr int MI = TN == 256 ? 8 : 4;
  const int tid = TID(), lane = tid & 63, w = tid >> 6, lr = lane & 15, lg = lane >> 4;
  const int wr = TN == 256 ? (w >> 2) : (w >> 1), wc = TN == 256 ? (w & 3) : (w & 1);
  constexpr int OPA = 256 * 32, OPB = TN * 32, STSZ = OPA + OPB;
  const int drow = lane >> 2, dch = lane & 3;
  const int brow = TN == 256 ? w * 32 : w * 16;
  const int pa0 = PERMA ? (w * 32 + 8 * (drow >> 2) + (drow & 3)) : (w * 32 + drow);
  const int pa1 = PERMA ? (pa0 + 4) : (w * 32 + 16 + drow);
  const GAS u16* ga0 = (const GAS u16*)(A + (size_t)pa0 * lda + dch * 8);
  const GAS u16* ga1 = (const GAS u16*)(A + (size_t)pa1 * lda + dch * 8);
  const int pb0 = PERM ? ((TN == 256 ? w * 32 : (w >> 1) * 32) + 8 * (drow >> 2) + (TN == 256 ? 0 : 4 * (w & 1)) + (drow & 3)) : (brow + drow);
  const int pb1 = PERM ? (pb0 + 4) : (brow + 16 + drow);
  const GAS u16* gb0 = (const GAS u16*)(B + (size_t)pb0 * ldb + dch * 8);
  const GAS u16* gb1 = (const GAS u16*)(B + (size_t)pb1 * ldb + dch * 8);
  LAS u16* ls = (LAS u16*)sm;
  const int wofA = __builtin_amdgcn_readfirstlane(w * 32 * 32);
  const int wofB = __builtin_amdgcn_readfirstlane(OPA + brow * 32);
#define ISSUE(kk) do { const int _st = ((kk) & 3) * STSZ; const int _ko = (kk) * 32; \
    __builtin_amdgcn_global_load_lds((const GAS unsigned*)(ga0 + _ko), (LAS unsigned*)(ls + _st + wofA), 16, 0, 0); \
    __builtin_amdgcn_global_load_lds((const GAS unsigned*)(ga1 + _ko), (LAS unsigned*)(ls + _st + wofA + 16 * 32), 16, 0, 0); \
    __builtin_amdgcn_global_load_lds((const GAS unsigned*)(gb0 + _ko), (LAS unsigned*)(ls + _st + wofB), 16, 0, 0); \
    if (TN == 256) __builtin_amdgcn_global_load_lds((const GAS unsigned*)(gb1 + _ko), (LAS unsigned*)(ls + _st + wofB + 16 * 32), 16, 0, 0); } while (0)
#define FRAG(p, i) (*(const bf16x8*)((p) + (i) * 16 * 32))
#define MM(mi, ni, av, bv) acc[mi][ni] = SWAP ? mfma(bv, av, acc[mi][ni]) : mfma(av, bv, acc[mi][ni])
#define MM16(mo, a0, a1, a2, a3, b0, b1, b2, b3) do { \
    MM(mo + 0, 0, a0, b0); MM(mo + 1, 0, a1, b0); MM(mo + 0, 1, a0, b1); MM(mo + 1, 1, a1, b1); \
    MM(mo + 2, 0, a2, b0); MM(mo + 3, 0, a3, b0); MM(mo + 2, 1, a2, b1); MM(mo + 3, 1, a3, b1); \
    MM(mo + 0, 2, a0, b2); MM(mo + 1, 2, a1, b2); MM(mo + 2, 2, a2, b2); MM(mo + 3, 2, a3, b2); \
    MM(mo + 0, 3, a0, b3); MM(mo + 1, 3, a1, b3); MM(mo + 2, 3, a2, b3); MM(mo + 3, 3, a3, b3); } while (0)
  const int nk2 = K >> 6;
  if (first) { __syncthreads(); ISSUE(0); ISSUE(1); }
  const int aoff = (wr * MI * 16 + lr) * 32 + lg * 8, boff = OPA + (wc * 64 + lr) * 32 + lg * 8;
  for (int s2 = 0; s2 < nk2; ++s2) {
    asm volatile("s_waitcnt vmcnt(0)" ::: "memory");
    __builtin_amdgcn_s_barrier();
    __builtin_amdgcn_sched_barrier(0);
    if (s2 + 1 < nk2) { ISSUE(2 * s2 + 2); ISSUE(2 * s2 + 3); }
    const u16* p0 = sm + ((2 * s2) & 3) * STSZ;
    const u16* p1 = sm + ((2 * s2 + 1) & 3) * STSZ;
    const bf16x8 b0 = FRAG(p0 + boff, 0), b1 = FRAG(p0 + boff, 1), b2 = FRAG(p0 + boff, 2), b3 = FRAG(p0 + boff, 3);
    const bf16x8 a0 = FRAG(p0 + aoff, 0), a1 = FRAG(p0 + aoff, 1), a2 = FRAG(p0 + aoff, 2), a3 = FRAG(p0 + aoff, 3);
    if (MI == 8) {
      const bf16x8 a4 = FRAG(p0 + aoff, 4), a5 = FRAG(p0 + aoff, 5), a6 = FRAG(p0 + aoff, 6), a7 = FRAG(p0 + aoff, 7);
      __builtin_amdgcn_sched_barrier(0);
      MM16(0, a0, a1, a2, a3, b0, b1, b2, b3);
      __builtin_amdgcn_sched_barrier(0);
      const bf16x8 d0 = FRAG(p1 + aoff, 0), d1 = FRAG(p1 + aoff, 1), d2 = FRAG(p1 + aoff, 2), d3 = FRAG(p1 + aoff, 3);
      __builtin_amdgcn_sched_barrier(0);
      MM16(MI - 4, a4, a5, a6, a7, b0, b1, b2, b3);
      __builtin_amdgcn_sched_barrier(0);
      const bf16x8 c0 = FRAG(p1 + boff, 0), c1 = FRAG(p1 + boff, 1), c2 = FRAG(p1 + boff, 2), c3 = FRAG(p1 + boff, 3);
      const bf16x8 d4 = FRAG(p1 + aoff, 4), d5 = FRAG(p1 + aoff, 5), d6 = FRAG(p1 + aoff, 6), d7 = FRAG(p1 + aoff, 7);
      __builtin_amdgcn_sched_barrier(0);
      MM16(0, d0, d1, d2, d3, c0, c1, c2, c3);
      __builtin_amdgcn_sched_barrier(0);
      MM16(MI - 4, d4, d5, d6, d7, c0, c1, c2, c3);
    } else {
      const bf16x8 c0 = FRAG(p1 + boff, 0), c1 = FRAG(p1 + boff, 1), c2 = FRAG(p1 + boff, 2), c3 = FRAG(p1 + boff, 3);
      const bf16x8 d0 = FRAG(p1 + aoff, 0), d1 = FRAG(p1 + aoff, 1), d2 = FRAG(p1 + aoff, 2), d3 = FRAG(p1 + aoff, 3);
      __builtin_amdgcn_sched_barrier(0);
      MM16(0, a0, a1, a2, a3, b0, b1, b2, b3);
      __builtin_amdgcn_sched_barrier(0);
      MM16(0, d0, d1, d2, d3, c0, c1, c2, c3);
    }
    __builtin_amdgcn_sched_barrier(0);
  }
  if (nA) {
    ga0 = (const GAS u16*)(nA + (size_t)pa0 * nlda + dch * 8);
    ga1 = (const GAS u16*)(nA + (size_t)pa1 * nlda + dch * 8);
    gb0 = (const GAS u16*)(nB + (size_t)pb0 * nldb + dch * 8);
    gb1 = (const GAS u16*)(nB + (size_t)pb1 * nldb + dch * 8);
    ISSUE(0); ISSUE(1);
  }
#undef MM16
#undef MM
#undef FRAG
#undef ISSUE
}
template <int MI>
DEV void zero_acc(f32x4 (&acc)[MI][4]) {
#pragma unroll
  for (int i = 0; i < MI; ++i)
#pragma unroll
    for (int j = 0; j < 4; ++j) acc[i][j] = f32x4{0.f, 0.f, 0.f, 0.f};
}

DEV int win_orig_col(int j) {
  if (j < 416) return j;
  if (j < 432) return 1952 + (j - 416);
  if (j < 448) return 1968 + (j - 432);
  if (j < 512) return -1;
  if (j < 2048) return 416 + (j - 512);
  return j - 64;
}
DEV void cvt_item(const float* __restrict__ W, int Norig, int K, u16* WT, int n, int k8, int oc, const float* gain) {
  float v[8];
#pragma unroll
  for (int e = 0; e < 8; ++e) {
    int k = k8 * 8 + e;
    float x = (oc >= 0) ? W[(size_t)k * Norig + oc] : 0.f;
    if (gain) x *= gain[k];
    v[e] = x;
  }
  *(uint4*)(WT + (size_t)n * K + k8 * 8) = make_uint4(pk2(v[0], v[1]), pk2(v[2], v[3]), pk2(v[4], v[5]), pk2(v[6], v[7]));
}

DEV void filter_item(const P& p, int l, int item, char* smem) {
  constexpr int NP = 8;
  const bool isc = item >= 512;
  const int Lx = isc ? LC : L;
  const int pos0 = (isc ? item - 512 : item) * NP;
  float* feat = (float*)smem;
  float* h1 = feat + NP * 36;
  float* h2 = h1 + NP * 64;
  const int tid = TID();
  const float* w1 = p.in[I_FW1] + (size_t)l * 33 * 64; const float* b1 = p.in[I_FB1] + l * 64;
  const float* w2 = p.in[I_FW2] + (size_t)l * 64 * 64; const float* b2 = p.in[I_FB2] + l * 64;
  const float* w3 = p.in[I_FW3] + (size_t)l * 64 * 2048; const float* b3 = p.in[I_FB3] + l * 2048;
  __syncthreads();
  for (int e = tid; e < NP * 33; e += NTH) {
    int ps = e / 33, fi = e % 33;
    float pos = (float)(pos0 + ps);
    float v;
    if (fi == 0) v = pos / (float)(Lx - 1);
    else {
      int i = (fi - 1) & 15;
      float f = 1e-4f + (float)i * ((15.f - 1e-4f) / 15.f);
      float ang = (6.283185307179586f / (float)Lx) * pos * f;
      v = (fi <= 16) ? __cosf(ang) : __sinf(ang);
    }
    feat[ps * 36 + fi] = v;
  }
  __syncthreads();
  {
    const int ps = tid >> 6, u = tid & 63;
    float a = b1[u];
#pragma unroll 11
    for (int k = 0; k < 33; ++k) a += feat[ps * 36 + k] * w1[k * 64 + u];
    h1[ps * 64 + u] = __sinf(a);
    __syncthreads();
    a = b2[u];
#pragma unroll 16
    for (int k = 0; k < 64; ++k) a += h1[ps * 64 + k] * w2[k * 64 + u];
    h2[ps * 64 + u] = __sinf(a);
  }
  __syncthreads();
  float* KF = isc ? (float*)(p.ws + OFF_KFC) : (float*)(p.ws + OFF_GATES);
  float* NRM = isc ? (float*)(p.ws + OFF_NORMC) : (float*)(p.ws + OFF_NORM) + l * 1024;
  const float da = logf(1e-2f) / 0.3f, db = logf(1e-2f) / 1.5f;
#pragma unroll 1
  for (int jj = 0; jj < 4; ++jj) {
    const int j = tid + NTH * jj;
    float acc[NP];
#pragma unroll
    for (int q = 0; q < NP; ++q) acc[q] = 0.f;
#pragma unroll 4
    for (int k = 0; k < 64; k += 4) {
      const float w0 = w3[(k + 0) * 2048 + j], w1v = w3[(k + 1) * 2048 + j], w2v = w3[(k + 2) * 2048 + j], w3v = w3[(k + 3) * 2048 + j];
#pragma unroll
      for (int q = 0; q < NP; ++q) {
        const f32x4 h = *(const f32x4*)(h2 + q * 64 + k);
        acc[q] += h[0] * w0 + h[1] * w1v + h[2] * w2v + h[3] * w3v;
      }
    }
    const int dir = j >> 10, n = (j >> 9) & 1, c = j & 511;
    const float delta = fabsf(da + (float)c * ((db - da) / 511.f));
    const float bb = b3[j];
    float s = 0.f;
    float* dst = KF + ((size_t)((n * 2 + dir) * 512 + c)) * Lx + pos0;
#pragma unroll
    for (int q = 0; q < NP; ++q) {
      float t = (float)(pos0 + q) / (float)(Lx - 1);
      float v = (acc[q] + bb) * expf(-t * delta);
      s += fabsf(v);
      dst[q] = v;
    }
    atomicAdd(NRM + n * 512 + c, s);
  }
}

DEV void adaln_item(const P& p, int item, char* smem) {
  float* sc = (float*)smem;
  const int tid = TID();
  const int l2 = item / 96, rem = item % 96, nch = rem >> 3, ks = rem & 7, k0 = ks * 128;
  __syncthreads();
  for (int e = tid; e < 9 * 128; e += NTH) {
    int r = e >> 7, k = k0 + (e & 127);
    float v = (r < 8) ? p.in[I_C][r * 1024 + k] : p.in[I_CCTX][k];
    sc[e] = v / (1.f + expf(-v));
  }
  __syncthreads();
  const int n = nch * 512 + tid;
  const float* W = p.in[I_ADAW] + (size_t)l2 * 1024 * 6144 + (size_t)k0 * 6144;
  float acc[9];
#pragma unroll
  for (int r = 0; r < 9; ++r) acc[r] = 0.f;
#pragma unroll 32
  for (int k = 0; k < 128; ++k) {
    float w = W[(size_t)k * 6144 + n];
#pragma unroll
    for (int r = 0; r < 9; ++r) acc[r] += sc[r * 128 + k] * w;
  }
  const float bb = (ks == 0) ? p.in[I_ADAB][l2 * 6144 + n] : 0.f;
  float* MOD = (float*)(p.ws + OFF_MOD);
#pragma unroll
  for (int r = 0; r < 9; ++r) atomicAdd(MOD + ((size_t)l2 * 9 + r) * 6144 + n, acc[r] + bb);
}

DEV void phase_prep(const P& p, int l, char* smem) {
  const int nfilt = (l == 0) ? 544 : 512;
  for (int it = BID(); it < nfilt; it += gridDim.x) filter_item(p, l, it, smem);
  if (l == 0) for (int it = BID(); it < 192; it += gridDim.x) adaln_item(p, it, smem);
  const long T = (long)gridDim.x * NTH;
  const long gt = (long)BID() * NTH + TID();
  char* ws = WSP(p.ws);
  {
    const float* W = p.in[I_WIN] + (size_t)l * 1024 * 6592;
    for (long i = gt; i < (long)NIN * 128; i += T) { int k8 = (int)(i / NIN), n = (int)(i % NIN); cvt_item(W, 6592, 1024, (u16*)(ws + OFF_WIN), n, k8, win_orig_col(n), nullptr); }
  }
  {
    const float* W = p.in[I_WUQ] + (size_t)l * 256 * 768; const float* g = p.in[I_QNORM] + l * 256;
    for (long i = gt; i < 768L * 32; i += T) {
      int k8 = (int)(i / 768), n = (int)(i % 768);
      int oc = (n < 512) ? (n >> 6) * 96 + (n & 63) : ((n - 512) >> 5) * 96 + 64 + ((n - 512) & 31);
      cvt_item(W, 768, 256, (u16*)(ws + OFF_WUQ), n, k8, oc, g);
    }
  }
  {
    const float* W = p.in[I_WUKV] + (size_t)l * 128 * 1024; const float* g = p.in[I_KVNORM] + l * 128;
    for (long i = gt; i < 1024L * 16; i += T) {
      int k8 = (int)(i / 1024), n = (int)(i % 1024);
      int oc = (n < 512) ? (n >> 6) * 128 + (n & 63) : ((n - 512) >> 6) * 128 + 64 + ((n - 512) & 63);
      cvt_item(W, 1024, 128, (u16*)(ws + OFF_WUKV), n, k8, oc, g);
    }
  }
  for (int m = 0; m < 3; ++m) {
    const float* W = p.in[I_WOM + m] + (size_t)l * 512 * 1024;
    u16* WT = (u16*)(ws + (m == 0 ? OFF_WOM : (m == 1 ? OFF_WOG : OFF_WOH)));
    for (long i = gt; i < 1024L * 64; i += T) { int k8 = (int)(i / 1024), n = (int)(i % 1024); cvt_item(W, 1024, 512, WT, n, k8, n, nullptr); }
  }
  {
    const float* W = p.in[I_WOUT] + (size_t)l * 1024 * 1024;
    for (long i = gt; i < 1024L * 128; i += T) { int k8 = (int)(i / 1024), n = (int)(i % 1024); cvt_item(W, 1024, 1024, (u16*)(ws + OFF_WOUT), n, k8, n, nullptr); }
  }
  {
    const float* W = p.in[I_FF1] + (size_t)l * 1024 * 4096;
    for (long i = gt; i < 4096L * 128; i += T) { int k8 = (int)(i / 4096), n = (int)(i % 4096); cvt_item(W, 4096, 1024, (u16*)(ws + OFF_W1), n, k8, n, nullptr); }
  }
  {
    const float* W = p.in[I_FF2] + (size_t)l * 4096 * 1024;
    for (long i = gt; i < 1024L * 512; i += T) { int k8 = (int)(i / 1024), n = (int)(i % 1024); cvt_item(W, 1024, 4096, (u16*)(ws + OFF_W2), n, k8, n, nullptr); }
  }
}

DEV int PADI(int i) { return i + (i >> 4); }
constexpr int TW_OFF = 90112;
DEV int PADT(int k) { return k + (k >> 3); }
DEV void fft_build_tw(char* smem) {
  float2* tw = (float2*)(smem + TW_OFF);
  __syncthreads();
  for (int k = TID(); k < 4096; k += NTH) {
    const float fr = (float)k * (1.f / 8192.f);
    tw[PADT(k)] = make_float2(__builtin_amdgcn_cosf(fr), __builtin_amdgcn_sinf(fr));
  }
  __syncthreads();
}
template <bool INV>
DEV void bfly(float2& a, float2& b, const float2 w) {
  const float c = w.x, s = w.y;
  if (!INV) {
    float tx = a.x - b.x, ty = a.y - b.y;
    a.x += b.x; a.y += b.y;
    b.x = tx * c + ty * s; b.y = ty * c - tx * s;
  } else {
    float tx = b.x * c - b.y * s, ty = b.x * s + b.y * c;
    b.x = a.x - tx; b.y = a.y - ty;
    a.x += tx; a.y += ty;
  }
}
template <bool INV, bool HALF>
DEV void fft_r8_pass(float2* buf, int q, int lq) {
  const float2* tw = (const float2*)((const char*)buf + TW_OFF);
#pragma unroll 2
  for (int gi = TID(); gi < 1024; gi += NTH) {
    const int pos = gi & (q - 1), base = (gi >> lq) * 8 * q + pos;
    const int fpi = pos << (10 - lq);
    float2 e[8];
#pragma unroll
    for (int m = 0; m < 8; ++m) e[m] = (HALF && !INV && m >= 4) ? make_float2(0.f, 0.f) : buf[PADI(base + m * q)];
    if (!INV) {
      if (HALF) {
#pragma unroll
        for (int m = 0; m < 4; ++m) { const float2 w = tw[PADT(fpi + m * 1024)]; e[m + 4] = make_float2(e[m].x * w.x + e[m].y * w.y, e[m].y * w.x - e[m].x * w.y); }
      } else {
#pragma unroll
        for (int m = 0; m < 4; ++m) bfly<false>(e[m], e[m + 4], tw[PADT(fpi + m * 1024)]);
      }
#pragma unroll
      for (int m = 0; m < 2; ++m) { const float2 w = tw[PADT(2 * fpi + m * 2048)]; bfly<false>(e[m], e[m + 2], w); bfly<false>(e[m + 4], e[m + 6], w); }
      {
        const float2 w = tw[PADT(4 * fpi)];
#pragma unroll
        for (int m = 0; m < 8; m += 2) bfly<false>(e[m], e[m + 1], w);
      }
    } else {
      {
        const float2 w = tw[PADT(4 * fpi)];
#pragma unroll
        for (int m = 0; m < 8; m += 2) bfly<true>(e[m], e[m + 1], w);
      }
#pragma unroll
      for (int m = 0; m < 2; ++m) { const float2 w = tw[PADT(2 * fpi + m * 2048)]; bfly<true>(e[m], e[m + 2], w); bfly<true>(e[m + 4], e[m + 6], w); }
      if (HALF) {
#pragma unroll
        for (int m = 0; m < 4; ++m) { const float2 w = tw[PADT(fpi + m * 1024)]; e[m].x += e[m + 4].x * w.x - e[m + 4].y * w.y; e[m].y += e[m + 4].x * w.y + e[m + 4].y * w.x; }
      } else {
#pragma unroll
        for (int m = 0; m < 4; ++m) bfly<true>(e[m], e[m + 4], tw[PADT(fpi + m * 1024)]);
      }
    }
#pragma unroll
    for (int m = 0; m < 8; ++m) if (!(HALF && INV && m >= 4)) buf[PADI(base + m * q)] = e[m];
  }
  __syncthreads();
}
DEV void fft_r2_last(float2* buf) {
#pragma unroll 4
  for (int gi = TID(); gi < 4096; gi += NTH) {
    float2 a = buf[PADI(2 * gi)], b = buf[PADI(2 * gi + 1)];
    buf[PADI(2 * gi)] = make_float2(a.x + b.x, a.y + b.y);
    buf[PADI(2 * gi + 1)] = make_float2(a.x - b.x, a.y - b.y);
  }
  __syncthreads();
}
template <bool ZHI>
DEV void fft_fwd(float2* buf) {
  fft_r8_pass<false, ZHI>(buf, 1024, 10); fft_r8_pass<false, false>(buf, 128, 7); fft_r8_pass<false, false>(buf, 16, 4); fft_r8_pass<false, false>(buf, 2, 1);
  fft_r2_last(buf);
}
template <bool LOHALF>
DEV void fft_inv(float2* buf) {
  fft_r2_last(buf);
  fft_r8_pass<true, false>(buf, 2, 1); fft_r8_pass<true, false>(buf, 16, 4); fft_r8_pass<true, false>(buf, 128, 7); fft_r8_pass<true, LOHALF>(buf, 1024, 10);
}
DEV int brev13(int f) { return (int)(__brev((unsigned)f) >> 19); }

DEV void filtfft_task(const P& p, int l, int c, char* smem) {
  float2* buf = (float2*)smem;
  const float* KF = (const float*)(p.ws + OFF_GATES);
  const float* NRM = (const float*)(p.ws + OFF_NORM) + l * 1024;
  const int tid = TID();
  __syncthreads();
  for (int i = tid; i < 8192; i += NTH) {
    float a, b;
    if (i < 4096) { a = KF[((size_t)(0 * 2 + 0) * 512 + c) * L + i]; b = KF[((size_t)(1 * 2 + 0) * 512 + c) * L + i]; }
    else if (i == 4096) { a = 0.f; b = 0.f; }
    else { a = KF[((size_t)(0 * 2 + 1) * 512 + c) * L + (8192 - i)]; b = KF[((size_t)(1 * 2 + 1) * 512 + c) * L + (8192 - i)]; }
    buf[PADI(i)] = make_float2(a, b);
  }
  __syncthreads();
  fft_fwd<false>(buf);
  const float s0 = 0.5f / (NRM[c] * 8192.f), s1 = 0.5f / (NRM[512 + c] * 8192.f);
  float2* KS = (float2*)(p.ws + OFF_KS);
  for (int f = tid; f <= 4096; f += NTH) {
    float2 zf = buf[PADI(brev13(f))], zn = buf[PADI(brev13((8192 - f) & 8191))];
    KS[(size_t)(0 * 512 + c) * KSLD + f] = make_float2((zf.x + zn.x) * s0, (zf.y - zn.y) * s0);
    KS[(size_t)(1 * 512 + c) * KSLD + f] = make_float2((zf.y + zn.y) * s1, -(zf.x - zn.x) * s1);
  }
  __syncthreads();
}

DEV void norm_rows(const float* xl, const float* xc, const float* gain, const float* modl, const float* modc, int shoff, u16* HX, int nrows) {
  const int gw = BID() * 8 + (TID() >> 6), NW = gridDim.x * 8, lane = TID() & 63;
  for (int r0 = gw; r0 < nrows; r0 += 2 * NW) {
    const int r1 = r0 + NW; const bool has1 = r1 < nrows;
    const float* s0 = (r0 < RL) ? xl + (size_t)r0 * D : xc + (size_t)(r0 - RL) * D;
    const float* s1 = has1 ? ((r1 < RL) ? xl + (size_t)r1 * D : xc + (size_t)(r1 - RL) * D) : s0;
    f32x4 a[4], b[4];
#pragma unroll
    for (int j = 0; j < 2; ++j) {
      a[2 * j] = *(const f32x4*)(s0 + j * 512 + lane * 8); a[2 * j + 1] = *(const f32x4*)(s0 + j * 512 + lane * 8 + 4);
      b[2 * j] = *(const f32x4*)(s1 + j * 512 + lane * 8); b[2 * j + 1] = *(const f32x4*)(s1 + j * 512 + lane * 8 + 4);
    }
    float sa = 0.f, sb = 0.f;
#pragma unroll
    for (int j = 0; j < 4; ++j) {
      sa += a[j][0] * a[j][0] + a[j][1] * a[j][1] + a[j][2] * a[j][2] + a[j][3] * a[j][3];
      sb += b[j][0] * b[j][0] + b[j][1] * b[j][1] + b[j][2] * b[j][2] + b[j][3] * b[j][3];
    }
    const float ra = rsqrtf(wave_sum(sa) * (1.f / D) + EPS), rb = rsqrtf(wave_sum(sb) * (1.f / D) + EPS);
    const float* m0 = (r0 < RL) ? modl + (size_t)(r0 >> 12) * 6144 : modc;
    const float* m1 = (r1 < RL) ? modl + (size_t)(r1 >> 12) * 6144 : modc;
#pragma unroll
    for (int j = 0; j < 2; ++j) {
      const int c0 = j * 512 + lane * 8;
      f32x4 ya[2], yb[2];
#pragma unroll
      for (int h = 0; h < 2; ++h) {
        const f32x4 g = *(const f32x4*)(gain + c0 + 4 * h);
        const f32x4 sh0 = *(const f32x4*)(m0 + shoff + c0 + 4 * h), sc0 = *(const f32x4*)(m0 + shoff + 1024 + c0 + 4 * h);
        const f32x4 sh1 = *(const f32x4*)(m1 + shoff + c0 + 4 * h), sc1 = *(const f32x4*)(m1 + shoff + 1024 + c0 + 4 * h);
#pragma unroll
        for (int e = 0; e < 4; ++e) {
          ya[h][e] = a[2 * j + h][e] * ra * g[e] * (1.f + sc0[e]) + sh0[e];
          yb[h][e] = b[2 * j + h][e] * rb * g[e] * (1.f + sc1[e]) + sh1[e];
        }
      }
      { const uint2 lo = pk4(ya[0]), hi = pk4(ya[1]); *(uint4*)(HX + (size_t)r0 * D + c0) = make_uint4(lo.x, lo.y, hi.x, hi.y); }
      if (has1) { const uint2 lo = pk4(yb[0]), hi = pk4(yb[1]); *(uint4*)(HX + (size_t)r1 * D + c0) = make_uint4(lo.x, lo.y, hi.x, hi.y); }
    }
  }
}

DEV void rope4(f32x4& v, int pos, int lg) {
#pragma unroll
  for (int j = 0; j < 4; ++j) {
    float pv = __shfl_xor(v[j], 32);
    int i = (lg * 4 + j) & 7;
    float inv = exp2f(-(float)i * (13.287712379549449f / 8.f));
    float ang = (float)pos * inv; float sn = __sinf(ang), cs = __cosf(ang);
    v[j] = (lg < 2) ? v[j] * cs - pv * sn : pv * sn + v[j] * cs;
  }
}

DEV void rope_perm(f32x4& ve, f32x4& vo, int pos, int lg) {
#pragma unroll
  for (int h = 0; h < 2; ++h) {
#pragma unroll
    for (int j = 0; j < 4; ++j) {
      float x = h ? vo[j] : ve[j];
      float pv = __shfl_xor(x, 16);
      int i = h * 4 + j;
      float inv = exp2f(-(float)i * (13.287712379549449f / 8.f));
      float ang = (float)pos * inv; float sn = __sinf(ang), cs = __cosf(ang);
      float y = ((lg & 1) == 0) ? x * cs - pv * sn : pv * sn + x * cs;
      if (h) vo[j] = y; else ve[j] = y;
    }
  }
}

DEV void phase_win(const P& p, int l, int g, char* smem) {
  char* ws = WSP(p.ws);
  const u16* HX = (const u16*)(ws + OFF_HX);
  const u16* WT = (const u16*)(ws + OFF_WIN);
  float* SSQ = (float*)(ws + OFF_SSQ) + (size_t)l * 2 * 34816;
  const int tid = TID(), lane = tid & 63, w = tid >> 6, wr = w >> 2, wc = w & 3, lr = lane & 15, lg = lane >> 4;
  const int NT = 26, ntiles = 68 * NT;
  bool pref = false;
  for (int t = BID(); t < ntiles; t += gridDim.x) {
    const int mt = t / NT, nt = t % NT;
    const int m0 = mt * 256, n0 = nt * 256;
    const bool lat = mt < 64;
    f32x4 acc[8][4]; zero_acc<8>(acc);
    const bool swap = !(nt >= 8 && nt < 14 && lat);
    const int t2 = t + gridDim.x;
    const bool swap2 = !((t2 % NT) >= 8 && (t2 % NT) < 14 && (t2 / NT) < 64);
    const bool hn = t2 < ntiles && swap2 == swap;
    const u16* nA = hn ? HX + (size_t)(t2 / NT) * 256 * D : nullptr; const u16* nB = WT + (size_t)(t2 % NT) * 256 * D;
    if (swap) gemm_core<true, 256, true>(acc, HX + (size_t)m0 * D, D, WT + (size_t)n0 * D, D, D, (u16*)smem, !pref, nA, D, nB, D);
    else gemm_core<false, 256, false, true>(acc, HX + (size_t)m0 * D, D, WT + (size_t)n0 * D, D, D, (u16*)smem, !pref, nA, D, nB, D);
    pref = hn;
    if (!swap) {
      const int b = m0 >> 12, s0 = m0 & (L - 1);
      u16* HYT = (u16*)(ws + OFF_HYT);
#pragma unroll
      for (int mp = 0; mp < 4; ++mp)
#pragma unroll
        for (int ni = 0; ni < 4; ++ni) {
          int ch = n0 - 2048 + wc * 64 + ni * 16 + lr;
          int s = s0 + wr * 128 + mp * 32 + lg * 8;
          const uint2 lo = pk4(acc[2 * mp][ni]), hi = pk4(acc[2 * mp + 1][ni]);
          *(uint4*)(HYT + ((size_t)(b * 2048 + ch)) * L + s) = make_uint4(lo.x, lo.y, hi.x, hi.y);
        }
      continue;
    }
    const int cs = nt * 4 + wc;
    if (cs == 7) continue;
#pragma unroll
    for (int mi = 0; mi < 8; ++mi) {
      const int r = m0 + wr * 128 + mi * 16 + lr;
      if (cs < 6) {
        u16* dst = (cs < 4) ? (u16*)(ws + OFF_ZQ) + (size_t)r * 256 + cs * 64 : (u16*)(ws + OFF_ZKV) + (size_t)r * 128 + (cs - 4) * 64;
        float ss = 0.f;
#pragma unroll
        for (int np = 0; np < 2; ++np) {
          const f32x4 v = acc[mi][2 * np], v2 = acc[mi][2 * np + 1];
          ss += v[0] * v[0] + v[1] * v[1] + v[2] * v[2] + v[3] * v[3] + v2[0] * v2[0] + v2[1] * v2[1] + v2[2] * v2[2] + v2[3] * v2[3];
          const uint2 lo = pk4(v), hi = pk4(v2);
          *(uint4*)(dst + np * 32 + lg * 8) = make_uint4(lo.x, lo.y, hi.x, hi.y);
        }
        ss += __shfl_xor(ss, 16); ss += __shfl_xor(ss, 32);
        if (lg == 0) {
          int grow = (r < RL) ? g * RL + r : 32768 + g * RC + (r - RL);
          atomicAdd(SSQ + (size_t)(cs < 4 ? 0 : 1) * 34816 + grow, ss);
        }
      } else if (cs == 6) {
        int b, pp; rowinfo(r, b, pp);
        u16* Kb = (u16*)(ws + OFF_K);
        u16* MISC = (u16*)(ws + OFF_MISC);
        {
          f32x4 ve = acc[mi][0], vo = acc[mi][1];
          if (r < RL) { int sidx = r & (L - 1); rope_perm(ve, vo, (lg < 2) ? (sidx >> 6) : (sidx & 63), lg); }
          const uint2 lo = pk4(ve), hi = pk4(vo);
          const uint4 pk = make_uint4(lo.x, lo.y, hi.x, hi.y);
#pragma unroll
          for (int h = 0; h < 8; ++h) *(uint4*)(Kb + ((size_t)(b * 8 + h) * PK + pp) * 96 + 64 + lg * 8) = pk;
          *(uint4*)(MISC + (size_t)r * 64 + lg * 8) = pk;
        }
        {
          const uint2 lo = pk4(acc[mi][2]), hi = pk4(acc[mi][3]);
          *(uint4*)(MISC + (size_t)r * 64 + 32 + lg * 8) = make_uint4(lo.x, lo.y, hi.x, hi.y);
        }
      } else if (cs < 56) {
        u16* dst;
        if (cs < 12) dst = (u16*)(ws + OFF_GQ) + (size_t)r * 256 + (cs - 8) * 64;
        else if (cs < 16) dst = (u16*)(ws + OFF_GK) + (size_t)r * 256 + (cs - 12) * 64;
        else if (cs < 24) dst = (u16*)(ws + OFF_GV) + (size_t)r * 512 + (cs - 16) * 64;
        else if (cs < 32) dst = (u16*)(ws + OFF_GR) + (size_t)r * 512 + (cs - 24) * 64;
        else dst = (u16*)(ws + OFF_HYC) + (size_t)(r - RL) * 1536 + (cs - 32) * 64;
#pragma unroll
        for (int np = 0; np < 2; ++np) {
          const uint2 lo = pk4(acc[mi][2 * np]), hi = pk4(acc[mi][2 * np + 1]);
          *(uint4*)(dst + np * 32 + lg * 8) = make_uint4(lo.x, lo.y, hi.x, hi.y);
        }
      } else {
        u16* dst = (u16*)(ws + OFF_GATES) + (size_t)r * 3072 + (cs - 56) * 64;
#pragma unroll
        for (int np = 0; np < 2; ++np) {
          f32x4 v = acc[mi][2 * np], v2 = acc[mi][2 * np + 1];
#pragma unroll
          for (int e = 0; e < 4; ++e) { v[e] = sigmoidf(v[e]); v2[e] = sigmoidf(v2[e]); }
          const uint2 lo = pk4(v), hi = pk4(v2);
          *(uint4*)(dst + np * 32 + lg * 8) = make_uint4(lo.x, lo.y, hi.x, hi.y);
        }
      }
    }
  }
}

DEV void phase_up(const P& p, int l, int g, char* smem) {
  char* ws = WSP(p.ws);
  const float* SSQ = (const float*)(ws + OFF_SSQ) + (size_t)l * 2 * 34816;
  const int tid = TID(), lane = tid & 63, w = tid >> 6, wr = w >> 1, wc = w & 1, lr = lane & 15, lg = lane >> 4;
  const int ntiles = 68 * 14;
  u16* Qb = (u16*)(ws + OFF_Q); u16* Kb = (u16*)(ws + OFF_K); u16* VT = (u16*)(ws + OFF_VT);
  bool pref = false;
  for (int t = BID(); t < ntiles; t += gridDim.x) {
    const int mt = t / 14, nt = t % 14;
    const int m0 = mt * 256;
    f32x4 acc[4][4]; zero_acc<4>(acc);
    const bool isq = nt < 6;
    const int nk = nt - 6;
    const bool vtile = !isq && nk >= 4;
    const u16* A = isq ? (const u16*)(ws + OFF_ZQ) + (size_t)m0 * 256 : (const u16*)(ws + OFF_ZKV) + (size_t)m0 * 128;
    const u16* B = isq ? (const u16*)(ws + OFF_WUQ) + (size_t)nt * 128 * 256 : (const u16*)(ws + OFF_WUKV) + (size_t)nk * 128 * 128;
    const int K = isq ? 256 : 128;
    const int t2 = t + gridDim.x; const bool hn = t2 < ntiles;
    const int mt2 = t2 / 14, nt2 = t2 % 14; const bool isq2 = nt2 < 6;
    const u16* A2 = isq2 ? (const u16*)(ws + OFF_ZQ) + (size_t)mt2 * 256 * 256 : (const u16*)(ws + OFF_ZKV) + (size_t)mt2 * 256 * 128;
    const u16* B2 = isq2 ? (const u16*)(ws + OFF_WUQ) + (size_t)nt2 * 128 * 256 : (const u16*)(ws + OFF_WUKV) + (size_t)(nt2 - 6) * 128 * 128;
    const int K2 = isq2 ? 256 : 128;
    const bool was = pref; pref = hn;
    if (!vtile) {
      gemm_core<true, 128>(acc, A, K, B, K, K, (u16*)smem, !was, hn ? A2 : nullptr, K2, B2, K2);
#pragma unroll
      for (int mi = 0; mi < 4; ++mi) {
        const int r = m0 + wr * 64 + mi * 16 + lr;
        int b, pp; rowinfo(r, b, pp);
        const int grow = (r < RL) ? g * RL + r : 32768 + g * RC + (r - RL);
        const float sc = isq ? rsqrtf(SSQ[grow] * (1.f / 256.f) + EPS) * (0.10206207261596577f * 1.4426950408889634f)
                             : rsqrtf(SSQ[34816 + grow] * (1.f / 128.f) + EPS);
#pragma unroll
        for (int ni = 0; ni < 4; ++ni) {
          f32x4 v = acc[mi][ni];
#pragma unroll
          for (int e = 0; e < 4; ++e) v[e] *= sc;
          if (!isq) {
            const int h = nk * 2 + wc, d = ni * 16 + lg * 4;
            *(uint2*)(Kb + ((size_t)(b * 8 + h) * PK + pp) * 96 + d) = pk4(v);
          } else if (nt < 4) {
            const int h = nt * 2 + wc, d = ni * 16 + lg * 4;
            *(uint2*)(Qb + ((size_t)(b * 8 + h) * PK + pp) * 96 + d) = pk4(v);
          } else {
            const int h = (nt - 4) * 4 + wc * 2 + (ni >> 1), rr = (ni & 1) * 16 + lg * 4;
            if (r < RL) { int s = r & (L - 1); rope4(v, (rr < 16) ? (s >> 6) : (s & 63), lg); }
            *(uint2*)(Qb + ((size_t)(b * 8 + h) * PK + pp) * 96 + 64 + rr) = pk4(v);
          }
        }
      }
    } else {
      gemm_core<false, 128>(acc, A, K, B, K, K, (u16*)smem, !was, hn ? A2 : nullptr, K2, B2, K2);
#pragma unroll
      for (int mi = 0; mi < 4; ++mi) {
        const int r = m0 + wr * 64 + mi * 16 + lg * 4;
        int b, pp; rowinfo(r, b, pp);
        const int grow = (r < RL) ? g * RL + r : 32768 + g * RC + (r - RL);
        float sc[4];
#pragma unroll
        for (int e = 0; e < 4; ++e) sc[e] = rsqrtf(SSQ[34816 + grow + e] * (1.f / 128.f) + EPS);
#pragma unroll
        for (int ni = 0; ni < 4; ++ni) {
          f32x4 v = acc[mi][ni];
#pragma unroll
          for (int e = 0; e < 4; ++e) v[e] *= sc[e];
          const int h = (nk - 4) * 2 + wc, d = ni * 16 + lr;
          *(uint2*)(VT + ((size_t)(b * 8 + h) * 64 + d) * PK + pp) = pk4(v);
        }
      }
    }
  }
}

DEV void attn_task(const P& p, int b, int h, int qb, bool isctx, char* smem) {
  char* ws = WSP(p.ws);
  const int tid = TID(), lane = tid & 63, w = tid >> 6, lr = lane & 15, lg = lane >> 4;
  const int p0 = isctx ? 0 : LC + qb * 256;
  const int nkeys = isctx ? LC : PK;
  const u16* Qb = (const u16*)(ws + OFF_Q) + ((size_t)(b * 8 + h) * PK) * 96;
  const u16* Kb = (const u16*)(ws + OFF_K) + ((size_t)(b * 8 + h) * PK) * 96;
  const u16* VT = (const u16*)(ws + OFF_VT) + ((size_t)(b * 8 + h) * 64) * PK;
  constexpr int KLD = 104, VLD = 136, KSZ = 128 * KLD, VSZ = 64 * VLD;
  u16* sK = (u16*)smem;
  u16* sV = sK + 2 * KSZ;
  bf16x8 qf[2][3];
#pragma unroll
  for (int qs = 0; qs < 2; ++qs)
#pragma unroll
    for (int ks = 0; ks < 3; ++ks)
      qf[qs][ks] = *(const bf16x8*)(Qb + (size_t)(p0 + w * 32 + qs * 16 + lr) * 96 + ks * 32 + lg * 8);
  f32x4 o[4][2];
#pragma unroll
  for (int i = 0; i < 4; ++i) { o[i][0] = f32x4{0, 0, 0, 0}; o[i][1] = f32x4{0, 0, 0, 0}; }
  float mrun[2] = {-1e30f, -1e30f}, lsum[2] = {0.f, 0.f};
  u32x4 rkA0, rkA1, rkA2, rvA0, rvA1, rkB0, rkB1, rkB2, rvB0, rvB1;
  const int kr0 = tid / 12, kc0 = tid % 12, kr1 = (tid + 512) / 12, kc1 = (tid + 512) % 12, kr2 = (tid + 1024) / 12, kc2 = (tid + 1024) % 12;
  const int vd0 = tid >> 4, vd1 = (tid + 512) >> 4, vc0 = tid & 15;
#define AGLD(S, j0) do { rk##S##0 = *(gu4*)(Kb + (size_t)((j0) + kr0) * 96 + kc0 * 8); rk##S##1 = *(gu4*)(Kb + (size_t)((j0) + kr1) * 96 + kc1 * 8); \
    rk##S##2 = *(gu4*)(Kb + (size_t)((j0) + kr2) * 96 + kc2 * 8); \
    rv##S##0 = *(gu4*)(VT + (size_t)vd0 * PK + (j0) + vc0 * 8); rv##S##1 = *(gu4*)(VT + (size_t)vd1 * PK + (j0) + vc0 * 8); } while (0)
#define ASST(S, st) do { *(u32x4*)(sK + (st) * KSZ + kr0 * KLD + kc0 * 8) = rk##S##0; *(u32x4*)(sK + (st) * KSZ + kr1 * KLD + kc1 * 8) = rk##S##1; \
    *(u32x4*)(sK + (st) * KSZ + kr2 * KLD + kc2 * 8) = rk##S##2; \
    *(u32x4*)(sV + (st) * VSZ + vd0 * VLD + vc0 * 8) = rv##S##0; *(u32x4*)(sV + (st) * VSZ + vd1 * VLD + vc0 * 8) = rv##S##1; } while (0)
#define SOFTMAX(S, QS, PF) do { \
      float mx = -1e30f; \
      _Pragma("unroll") for (int kk = 0; kk < 4; ++kk) \
        _Pragma("unroll") for (int e = 0; e < 4; ++e) mx = fmaxf(mx, S[kk][e]); \
      mx = fmaxf(mx, __shfl_xor(mx, 16)); mx = fmaxf(mx, __shfl_xor(mx, 32)); \
        \
      if (__builtin_amdgcn_ballot_w64(mx > mrun[QS] + 8.f) != 0ull) { \
        const float mn = fmaxf(mrun[QS], mx); \
        const float alpha = __builtin_amdgcn_exp2f(mrun[QS] - mn); \
        mrun[QS] = mn; \
        lsum[QS] *= alpha; \
        _Pragma("unroll") for (int ds = 0; ds < 4; ++ds) \
          _Pragma("unroll") for (int e = 0; e < 4; ++e) o[ds][QS][e] *= alpha; \
      } \
      const float mn = mrun[QS]; \
      float ps = 0.f; \
      _Pragma("unroll") for (int kk = 0; kk < 4; ++kk) \
        _Pragma("unroll") for (int e = 0; e < 4; ++e) { float pv = __builtin_amdgcn_exp2f(S[kk][e] - mn); S[kk][e] = pv; ps += pv; } \
      lsum[QS] += ps; \
      PF[0] = mk8(pk4(S[0]), pk4(S[1])); PF[1] = mk8(pk4(S[2]), pk4(S[3])); } while (0)
#define ATILE(st, hh) do { \
    const u16* k_s = sK + (st) * KSZ + (hh) * 64 * KLD; \
    const u16* v_s = sV + (st) * VSZ + (hh) * 64; \
    f32x4 s0[4], s1[4]; bf16x8 pf0[2], pf1[2]; \
      \
    _Pragma("unroll") for (int kk = 0; kk < 4; ++kk) { \
      s0[kk] = f32x4{0, 0, 0, 0}; \
      _Pragma("unroll") for (int ks = 0; ks < 3; ++ks) \
        s0[kk] = mfma(*(const bf16x8*)(k_s + (kk * 16 + lr) * KLD + ks * 32 + lg * 8), qf[0][ks], s0[kk]); \
    } \
      \
    _Pragma("unroll") for (int kk = 0; kk < 4; ++kk) { \
      s1[kk] = f32x4{0, 0, 0, 0}; \
      _Pragma("unroll") for (int ks = 0; ks < 3; ++ks) \
        s1[kk] = mfma(*(const bf16x8*)(k_s + (kk * 16 + lr) * KLD + ks * 32 + lg * 8), qf[1][ks], s1[kk]); \
    } \
    SOFTMAX(s0, 0, pf0); \
      \
    _Pragma("unroll") for (int k2i = 0; k2i < 2; ++k2i) \
      _Pragma("unroll") for (int ds = 0; ds < 4; ++ds) { \
        const u16* vp = v_s + (ds * 16 + lr) * VLD + k2i * 32 + lg * 4; \
        o[ds][0] = mfma(mk8(*(const uint2*)vp, *(const uint2*)(vp + 16)), pf0[k2i], o[ds][0]); \
      } \
    SOFTMAX(s1, 1, pf1); \
      \
    _Pragma("unroll") for (int k2i = 0; k2i < 2; ++k2i) \
      _Pragma("unroll") for (int ds = 0; ds < 4; ++ds) { \
        const u16* vp = v_s + (ds * 16 + lr) * VLD + k2i * 32 + lg * 4; \
        o[ds][1] = mfma(mk8(*(const uint2*)vp, *(const uint2*)(vp + 16)), pf1[k2i], o[ds][1]); \
      } } while (0)
  const int nt = nkeys >> 7;
  AGLD(B, 0);
  AGLD(A, 128);
  __syncthreads();
  ASST(B, 0);
  __syncthreads();
  for (int kt = 0; kt < nt; kt += 2) {
    if (kt + 2 < nt) AGLD(B, (kt + 2) * 128);
    __builtin_amdgcn_sched_barrier(0);
    ATILE(0, 0);
    ATILE(0, 1);
    __builtin_amdgcn_sched_barrier(0);
    ASST(A, 1);
    __syncthreads();
    if (kt + 3 < nt) AGLD(A, (kt + 3) * 128);
    __builtin_amdgcn_sched_barrier(0);
    ATILE(1, 0);
    ATILE(1, 1);
    __builtin_amdgcn_sched_barrier(0);
    if (kt + 2 < nt) ASST(B, 0);
    __syncthreads();
  }
#undef ATILE
#undef SOFTMAX
#undef AGLD
#undef ASST
  u16* Y = (u16*)(ws + OFF_YMLA);
#pragma unroll
  for (int qs = 0; qs < 2; ++qs) {
    float ls = lsum[qs];
    ls += __shfl_xor(ls, 16); ls += __shfl_xor(ls, 32);
    const float inv = 1.f / ls;
    const int pq = p0 + w * 32 + qs * 16 + lr;
    const int r = isctx ? RL + b * LC + pq : b * L + (pq - LC);
#pragma unroll
    for (int ds = 0; ds < 4; ++ds) {
      f32x4 v = o[ds][qs];
#pragma unroll
      for (int e = 0; e < 4; ++e) v[e] *= inv;
      *(uint2*)(Y + (size_t)r * 512 + h * 64 + ds * 16 + lg * 4) = pk4(v);
    }
  }
}

DEV void gla_task(const P& p, int l, int b, int h, int dir, char* smem) {
  char* ws = WSP(p.ws);
  const int tid = TID(), lane = tid & 63, w = tid >> 6, lr = lane & 15, lg = lane >> 4;
  const u16* GQ = (const u16*)(ws + OFF_GQ); const u16* GK = (const u16*)(ws + OFF_GK);
  const u16* GV = (const u16*)(ws + OFF_GV); const u16* MISC = (const u16*)(ws + OFF_MISC);
  u16* OUT = (u16*)(ws + (dir ? OFF_OB : OFF_OF));
  constexpr int LD = 72, TS = 64 * LD;
  u16* sQ = (u16*)smem; u16* sK = sQ + TS; u16* sKLT = sK + TS; u16* sAL = sKLT + TS; u16* sVT = sAL + TS;
  float* sAf = (float*)(sVT + 2 * TS);
  float* sTot = sAf + 64 * 16;
  float* sEG = sTot + 512;
  const int gk = tid & 63, part = tid >> 6;
  float wa[16];
  {
    const float* W = p.in[I_WA2] + ((size_t)(l * 2 + dir) * 16) * 256 + h * 64 + gk;
#pragma unroll
    for (int r = 0; r < 16; ++r) wa[r] = W[r * 256];
  }
  const float ba = p.in[I_BA][(l * 2 + dir) * 256 + h * 64 + gk];
  f32x4 S[4];
#pragma unroll
  for (int i = 0; i < 4; ++i) S[i] = f32x4{0, 0, 0, 0};
  u32x4 rq0, rk0, rv0, rv1, ra;
  const int si0 = tid >> 3, sch = tid & 7;
  const int vi0 = tid >> 4, vi1 = (tid + 512) >> 4, vch = tid & 15;
#define ROWOF(n, i) ((n) < 4 ? (RL + b * LC + (dir ? (LC - 1 - (64 * (n) + (i))) : (64 * (n) + (i)))) \
                             : (b * L + (dir ? (L - 1 - (64 * ((n) - 4) + (i))) : (64 * ((n) - 4) + (i)))))
#define GGLD(n) do { size_t _r0 = (size_t)ROWOF(n, si0); \
    rq0 = *(gu4*)(GQ + _r0 * 256 + h * 64 + sch * 8); rk0 = *(gu4*)(GK + _r0 * 256 + h * 64 + sch * 8); \
    rv0 = *(gu4*)(GV + (size_t)ROWOF(n, vi0) * 512 + h * 128 + vch * 8); rv1 = *(gu4*)(GV + (size_t)ROWOF(n, vi1) * 512 + h * 128 + vch * 8); \
    if (tid < 128) ra = *(gu4*)(MISC + (size_t)ROWOF(n, tid >> 1) * 64 + 32 + dir * 16 + (tid & 1) * 8); } while (0)
#define VTW(rv, i) do { sVT[(vch * 8 + 0) * LD + (i)] = (u16)((rv).x & 0xffff); sVT[(vch * 8 + 1) * LD + (i)] = (u16)((rv).x >> 16); \
    sVT[(vch * 8 + 2) * LD + (i)] = (u16)((rv).y & 0xffff); sVT[(vch * 8 + 3) * LD + (i)] = (u16)((rv).y >> 16); \
    sVT[(vch * 8 + 4) * LD + (i)] = (u16)((rv).z & 0xffff); sVT[(vch * 8 + 5) * LD + (i)] = (u16)((rv).z >> 16); \
    sVT[(vch * 8 + 6) * LD + (i)] = (u16)((rv).w & 0xffff); sVT[(vch * 8 + 7) * LD + (i)] = (u16)((rv).w >> 16); } while (0)
  ra = u32x4{0u, 0u, 0u, 0u};
  GGLD(0);
  for (int n = 0; n < 68; ++n) {
    __syncthreads();
    *(u32x4*)(sQ + si0 * LD + sch * 8) = rq0;
    *(u32x4*)(sK + si0 * LD + sch * 8) = rk0;
    VTW(rv0, vi0); VTW(rv1, vi1);
    if (tid < 128) {
      float* ap = sAf + (tid >> 1) * 16 + (tid & 1) * 8;
      ap[0] = bf2f((u16)(ra.x & 0xffff)); ap[1] = bf2f((u16)(ra.x >> 16)); ap[2] = bf2f((u16)(ra.y & 0xffff)); ap[3] = bf2f((u16)(ra.y >> 16));
      ap[4] = bf2f((u16)(ra.z & 0xffff)); ap[5] = bf2f((u16)(ra.z >> 16)); ap[6] = bf2f((u16)(ra.w & 0xffff)); ap[7] = bf2f((u16)(ra.w >> 16));
    }
    __syncthreads();
    if (n + 1 < 68) GGLD(n + 1);
    __builtin_amdgcn_sched_barrier(0);
    float pre[8]; float run = 0.f;
#pragma unroll
    for (int ii = 0; ii < 8; ++ii) {
      const int i = part * 8 + ii;
      float x = ba;
#pragma unroll
      for (int r = 0; r < 16; ++r) x += sAf[i * 16 + r] * wa[r];
      float ls = fminf(x, 0.f) * 1.4426950408889634f - __builtin_amdgcn_logf(1.f + __builtin_amdgcn_exp2f(-fabsf(x) * 1.4426950408889634f));
      run += ls * (1.f / 16.f);
      pre[ii] = run;
    }
    sTot[part * 64 + gk] = run;
    __syncthreads();
    float off = 0.f, glast = 0.f;
#pragma unroll
    for (int q = 0; q < 8; ++q) { float tv = sTot[q * 64 + gk]; glast += tv; if (q < part) off += tv; }
    const float eglast = __builtin_amdgcn_exp2f(glast);
    if (part == 0) sEG[gk] = eglast;
    {
      float klt[8];
#pragma unroll
      for (int ii = 0; ii < 8; ++ii) {
        const int i = part * 8 + ii;
        const float G = off + pre[ii];
        float qv = bf2f(sQ[i * LD + gk]), kv = bf2f(sK[i * LD + gk]);
        const float eg = __builtin_amdgcn_exp2f(G), egi = __builtin_amdgcn_exp2f(-G);
        sQ[i * LD + gk] = f2bf(qv * 0.125f * eg);
        sK[i * LD + gk] = f2bf(kv * egi);
        klt[ii] = kv * (eglast * egi);
      }
      *(uint4*)(sKLT + gk * LD + part * 8) = make_uint4(pk2(klt[0], klt[1]), pk2(klt[2], klt[3]), pk2(klt[4], klt[5]), pk2(klt[6], klt[7]));
    }
    __syncthreads();
    {
      const int it = w & 3, jt0 = (w >> 2) * 2;
      bf16x8 qb[2];
#pragma unroll
      for (int m = 0; m < 2; ++m) qb[m] = *(const bf16x8*)(sQ + (it * 16 + lr) * LD + m * 32 + lg * 8);
      const int i = it * 16 + lr;
#pragma unroll
      for (int jj = 0; jj < 2; ++jj) {
        const int jt = jt0 + jj;
        f32x4 c = f32x4{0, 0, 0, 0};
#pragma unroll
        for (int m = 0; m < 2; ++m) c = mfma(*(const bf16x8*)(sK + (jt * 16 + lr) * LD + m * 32 + lg * 8), qb[m], c);
#pragma unroll
        for (int e = 0; e < 4; ++e) { int j = jt * 16 + lg * 4 + e; if (j > i) c[e] = 0.f; }
        *(uint2*)(sAL + i * LD + jt * 16 + lg * 4) = pk4(c);
      }
    }
    __syncthreads();
    {
      bf16x8 sa[2];
#pragma unroll
      for (int m = 0; m < 2; ++m) sa[m] = mk8(pk4(S[2 * m]), pk4(S[2 * m + 1]));
      bf16x8 vtf[2];
#pragma unroll
      for (int m = 0; m < 2; ++m) vtf[m] = *(const bf16x8*)(sVT + (w * 16 + lr) * LD + m * 32 + lg * 8);
      const bool store = (n >= 4) || (l == 0);
#pragma unroll
      for (int it = 0; it < 4; ++it) {
        f32x4 oc = f32x4{0, 0, 0, 0};
#pragma unroll
        for (int m = 0; m < 2; ++m) {
          const u16* qp = sQ + (it * 16 + lr) * LD + m * 32 + lg * 4;
          oc = mfma(sa[m], mk8(*(const uint2*)qp, *(const uint2*)(qp + 16)), oc);
          oc = mfma(vtf[m], *(const bf16x8*)(sAL + (it * 16 + lr) * LD + m * 32 + lg * 8), oc);
        }
        if (store) {
          size_t row = (size_t)ROWOF(n, it * 16 + lr);
          *(uint2*)(OUT + row * 512 + h * 128 + w * 16 + lg * 4) = pk4(oc);
        }
      }
#pragma unroll
      for (int kt = 0; kt < 4; ++kt) {
        f32x4 eg = *(const f32x4*)(sEG + kt * 16 + lg * 4);
        f32x4 c;
#pragma unroll
        for (int e = 0; e < 4; ++e) c[e] = S[kt][e] * eg[e];
#pragma unroll
        for (int m = 0; m < 2; ++m) c = mfma(*(const bf16x8*)(sKLT + (kt * 16 + lr) * LD + m * 32 + lg * 8), vtf[m], c);
        S[kt] = c;
      }
    }
  }
}
#undef ROWOF
#undef GGLD
#undef VTW
struct F8 { float v[8]; };
DEV F8 sconv8(const u16* row, int t0, float w0, float w1, float w2, float bb) {
  const u32x4 q = *(gu4*)(row + t0);
  const float lo = (t0 > 0) ? bf2f(row[t0 - 1]) : 0.f;
  const float hi = (t0 + 8 < L) ? bf2f(row[t0 + 8]) : 0.f;
  float u[10];
  u[0] = lo; u[9] = hi;
  u[1] = bf2f((u16)(q.x & 0xffff)); u[2] = bf2f((u16)(q.x >> 16)); u[3] = bf2f((u16)(q.y & 0xffff)); u[4] = bf2f((u16)(q.y >> 16));
  u[5] = bf2f((u16)(q.z & 0xffff)); u[6] = bf2f((u16)(q.z >> 16)); u[7] = bf2f((u16)(q.w & 0xffff)); u[8] = bf2f((u16)(q.w >> 16));
  F8 r;
#pragma unroll
  for (int j = 0; j < 8; ++j) r.v[j] = bb + w0 * u[j] + w1 * u[j + 1] + w2 * u[j + 2];
  return r;
}
DEV F8 ld8bf(const u16* row, int t0) {
  const u32x4 q = *(gu4*)(row + t0);
  F8 r;
  r.v[0] = bf2f((u16)(q.x & 0xffff)); r.v[1] = bf2f((u16)(q.x >> 16)); r.v[2] = bf2f((u16)(q.y & 0xffff)); r.v[3] = bf2f((u16)(q.y >> 16));
  r.v[4] = bf2f((u16)(q.z & 0xffff)); r.v[5] = bf2f((u16)(q.z >> 16)); r.v[6] = bf2f((u16)(q.w & 0xffff)); r.v[7] = bf2f((u16)(q.w >> 16));
  return r;
}
DEV void st8bf(u16* row, int t0, const F8& a) {
  *(uint4*)(row + t0) = make_uint4(pk2(a.v[0], a.v[1]), pk2(a.v[2], a.v[3]), pk2(a.v[4], a.v[5]), pk2(a.v[6], a.v[7]));
}
DEV void spec_mul(float2* buf, const float2* KSr) {
  const int tid = TID();
  float2 kv[8];
#pragma unroll
  for (int m = 0; m < 8; ++m) kv[m] = KSr[tid + NTH * m];
  const float2 klast = KSr[4096];
#pragma unroll
  for (int m = 0; m < 8; ++m) {
    const int f = tid + NTH * m;
    const int i1 = PADI(brev13(f));
    const float2 z = buf[i1];
    buf[i1] = make_float2(z.x * kv[m].x - z.y * kv[m].y, z.x * kv[m].y + z.y * kv[m].x);
    if (f != 0) {
      const int i2 = PADI(brev13(8192 - f));
      const float2 z2 = buf[i2];
      buf[i2] = make_float2(z2.x * kv[m].x + z2.y * kv[m].y, -z2.x * kv[m].y + z2.y * kv[m].x);
    }
  }
  if (tid == 0) {
    const int i1 = PADI(brev13(4096));
    const float2 z = buf[i1];
    buf[i1] = make_float2(z.x * klast.x - z.y * klast.y, z.x * klast.y + z.y * klast.x);
  }
  __syncthreads();
}
DEV void hyena_task(const P& p, int l, int c, int pr, char* smem) {
  char* ws = WSP(p.ws);
  float2* buf = (float2*)smem;
  const int tid = TID(), t0 = tid * 8;
  u16* HYT = (u16*)(ws + OFF_HYT);
  const float2* KS0 = (const float2*)(ws + OFF_KS) + (size_t)(0 * 512 + c) * KSLD;
  const float2* KS1 = (const float2*)(ws + OFF_KS) + (size_t)(1 * 512 + c) * KSLD;
  const float* sw = p.in[I_HSW] + (size_t)l * 3 * 1536; const float* sb = p.in[I_HSB] + l * 1536;
  const float wx1[4] = {sw[c], sw[1536 + c], sw[3072 + c], sb[c]};
  const float wx2[4] = {sw[512 + c], sw[1536 + 512 + c], sw[3072 + 512 + c], sb[512 + c]};
  const float wv[4] = {sw[1024 + c], sw[1536 + 1024 + c], sw[3072 + 1024 + c], sb[1024 + c]};
  const float bias0 = p.in[I_HYB][(l * 2 + 0) * 512 + c], bias1 = p.in[I_HYB][(l * 2 + 1) * 512 + c];
  {
    const int b0 = 2 * pr, b1 = 2 * pr + 1;
    const u16* x1r0 = HYT + ((size_t)(b0 * 2048 + c)) * L; const u16* x1r1 = HYT + ((size_t)(b1 * 2048 + c)) * L;
    const u16* x2r0 = x1r0 + (size_t)512 * L; const u16* x2r1 = x1r1 + (size_t)512 * L;
    const u16* vr0 = x1r0 + (size_t)1024 * L; const u16* vr1 = x1r1 + (size_t)1024 * L;
    u16* st0 = (u16*)(ws + OFF_YHY) + ((size_t)(b0 * 512 + c)) * L; u16* st1 = (u16*)(ws + OFF_YHY) + ((size_t)(b1 * 512 + c)) * L;
    __syncthreads();
    {
      const F8 va = sconv8(vr0, t0, wv[0], wv[1], wv[2], wv[3]), vb = sconv8(vr1, t0, wv[0], wv[1], wv[2], wv[3]);
#pragma unroll
      for (int j = 0; j < 8; ++j) buf[PADI(t0 + j)] = make_float2(va.v[j], vb.v[j]);
    }
    __syncthreads();
    fft_fwd<true>(buf);
    spec_mul(buf, KS0);
    fft_inv<true>(buf);
    {
      const F8 va = sconv8(vr0, t0, wv[0], wv[1], wv[2], wv[3]), vb = sconv8(vr1, t0, wv[0], wv[1], wv[2], wv[3]);
      const F8 ga = sconv8(x1r0, t0, wx1[0], wx1[1], wx1[2], wx1[3]), gb = sconv8(x1r1, t0, wx1[0], wx1[1], wx1[2], wx1[3]);
      F8 ya, yb;
#pragma unroll
      for (int j = 0; j < 8; ++j) {
        const float2 cv = buf[PADI(t0 + j)];
        ya.v[j] = ga.v[j] * (cv.x + bias0 * va.v[j]); yb.v[j] = gb.v[j] * (cv.y + bias0 * vb.v[j]);
        buf[PADI(t0 + j)] = make_float2(ya.v[j], yb.v[j]);
      }
      st8bf(st0, t0, ya); st8bf(st1, t0, yb);
    }
    __syncthreads();
    fft_fwd<true>(buf);
    spec_mul(buf, KS1);
    fft_inv<true>(buf);
    {
      u16* o0 = HYT + ((size_t)(b0 * 2048 + 1536 + c)) * L; u16* o1 = HYT + ((size_t)(b1 * 2048 + 1536 + c)) * L;
      const F8 ga = sconv8(x2r0, t0, wx2[0], wx2[1], wx2[2], wx2[3]), gb = sconv8(x2r1, t0, wx2[0], wx2[1], wx2[2], wx2[3]);
      const F8 sa = ld8bf(st0, t0), sbb = ld8bf(st1, t0);
      F8 oa, ob;
#pragma unroll
      for (int j = 0; j < 8; ++j) {
        const float2 cv = buf[PADI(t0 + j)];
        oa.v[j] = ga.v[j] * (cv.x + bias1 * sa.v[j]); ob.v[j] = gb.v[j] * (cv.y + bias1 * sbb.v[j]);
      }
      st8bf(o0, t0, oa); st8bf(o1, t0, ob);
    }
  }
  __syncthreads();
}

DEV void hyena_ctx_task(const P& p, int c, char* smem) {
  char* ws = WSP(p.ws);
  float* kk0 = (float*)smem; float* kk1 = kk0 + 512;
  float* sv = kk1 + 512;
  float* sy1 = sv + 512;
  const int tid = TID(), t = tid & 255, bs = tid >> 8;
  const float* KFC = (const float*)(ws + OFF_KFC);
  const float* NRM = (const float*)(ws + OFF_NORMC);
  const float in0 = 1.f / NRM[c], in1 = 1.f / NRM[512 + c];
  __syncthreads();
  if (bs == 0) {
    kk0[255 + t] = KFC[((size_t)(0 * 2 + 0) * 512 + c) * LC + t] * in0;
    kk1[255 + t] = KFC[((size_t)(1 * 2 + 0) * 512 + c) * LC + t] * in1;
    if (t > 0) {
      kk0[255 - t] = KFC[((size_t)(0 * 2 + 1) * 512 + c) * LC + t] * in0;
      kk1[255 - t] = KFC[((size_t)(1 * 2 + 1) * 512 + c) * LC + t] * in1;
    }
  }
  const float* sw = p.in[I_HSW]; const float* sb = p.in[I_HSB];
  const float bias0 = p.in[I_HYB][c], bias1 = p.in[I_HYB][512 + c];
  const u16* HYC = (const u16*)(ws + OFF_HYC);
  u16* YHY = (u16*)(ws + OFF_YHY);
  for (int bi = 0; bi < NB / 2; ++bi) {
    const int b = bi * 2 + bs;
    const u16* base = HYC + (size_t)(b * LC) * 1536;
    float u[3];
#pragma unroll
    for (int k = 0; k < 3; ++k) {
      int ch = k * 512 + c;
      float cc = bf2f(base[(size_t)t * 1536 + ch]);
      float a = (t > 0) ? bf2f(base[(size_t)(t - 1) * 1536 + ch]) : 0.f;
      float d = (t < LC - 1) ? bf2f(base[(size_t)(t + 1) * 1536 + ch]) : 0.f;
      u[k] = sb[ch] + sw[ch] * a + sw[1536 + ch] * cc + sw[3072 + ch] * d;
    }
    __syncthreads();
    sv[bs * 256 + t] = u[2];
    __syncthreads();
    float a0 = 0.f;
#pragma unroll 4
    for (int s = 0; s < LC; s += 4) {
      const f32x4 v4 = *(const f32x4*)(sv + bs * 256 + s);
      const float* kp = kk0 + t + 252 - s;
      a0 += kp[3] * v4[0] + kp[2] * v4[1] + kp[1] * v4[2] + kp[0] * v4[3];
    }
    const float y1 = u[0] * (a0 + bias0 * u[2]);
    sy1[bs * 256 + t] = y1;
    __syncthreads();
    float a1 = 0.f;
#pragma unroll 4
    for (int s = 0; s < LC; s += 4) {
      const f32x4 v4 = *(const f32x4*)(sy1 + bs * 256 + s);
      const float* kp = kk1 + t + 252 - s;
      a1 += kp[3] * v4[0] + kp[2] * v4[1] + kp[1] * v4[2] + kp[0] * v4[3];
    }
    const float y2 = u[1] * (a1 + bias1 * y1);
    YHY[(size_t)(RL + b * LC + t) * 512 + c] = f2bf(y2);
  }
  __syncthreads();
}

DEV void phase_mix(const P& p, int l, int g, char* smem, int rep = 0) {
  unsigned* cnt = (unsigned*)(p.ws + OFF_CNT) + (rep * 4 + l * 2 + g);
  volatile int* s_taskp = (volatile int*)(smem + SMEM_BYTES + 16);
  const int n_gla = 32, n_hy = 1024, n_hyc = (l == 0) ? 512 : 0, n_at = 512, n_atc = (l == 0) ? 32 : 0;
  const int total = n_gla + n_hy + n_hyc + n_at + n_atc;
  fft_build_tw(smem);
  for (;;) {
    __syncthreads();
    if (TID() == 0) *s_taskp = (int)atomicAdd(cnt, 1u);
    __syncthreads();
    int t = *s_taskp;
    if (t >= total) break;
    if (t < n_gla) { gla_task(p, l, t >> 3, (t >> 1) & 3, t & 1, smem); continue; }
    t -= n_gla;
    if (t < n_at) { attn_task(p, t >> 7, (t >> 4) & 7, t & 15, false, smem); continue; }
    t -= n_at;
    if (t < n_hy) { hyena_task(p, l, t >> 1, t & 1, smem); continue; }
    t -= n_hy;
    if (t < n_atc) { attn_task(p, t >> 3, t & 7, 0, true, smem); continue; }
    t -= n_atc;
    hyena_ctx_task(p, t, smem);
  }
}

DEV void phase_post(const P& p, int l, int g, char* smem) {
  char* ws = WSP(p.ws);
  const int tid = TID();
  {
    u16* tile = (u16*)smem;
    const u16* HYT = (const u16*)(ws + OFF_HYT); u16* YHY = (u16*)(ws + OFF_YHY);
    u32x4 q0, q1;
    const int ecc0 = tid >> 4, ecc1 = (tid + NTH) >> 4, ech = tid & 15;
#define TLOAD(itx) do { const int _b = (itx) >> 8, _ct = ((itx) >> 5) & 7, _tt = (itx) & 31; \
      q0 = *(gu4*)(HYT + ((size_t)(_b * 2048 + 1536 + _ct * 64 + ecc0)) * L + _tt * 128 + ech * 8); \
      q1 = *(gu4*)(HYT + ((size_t)(_b * 2048 + 1536 + _ct * 64 + ecc1)) * L + _tt * 128 + ech * 8); } while (0)
    int it = BID();
    if (it < NB * 8 * 32) TLOAD(it);
    while (it < NB * 8 * 32) {
      const int b = it >> 8, ct = (it >> 5) & 7, tt = it & 31;
      __syncthreads();
      { unsigned* d0 = (unsigned*)(tile + ecc0 * 130 + ech * 8); d0[0] = q0.x; d0[1] = q0.y; d0[2] = q0.z; d0[3] = q0.w;
        unsigned* d1 = (unsigned*)(tile + ecc1 * 130 + ech * 8); d1[0] = q1.x; d1[1] = q1.y; d1[2] = q1.z; d1[3] = q1.w; }
      __syncthreads();
      const int itn = it + gridDim.x;
      if (itn < NB * 8 * 32) TLOAD(itn);
#pragma unroll
      for (int u = 0; u < 2; ++u) { const int e = tid + NTH * u, t2 = e >> 3, c8 = (e & 7) * 8;
        unsigned w0 = (unsigned)tile[(c8 + 0) * 130 + t2] | ((unsigned)tile[(c8 + 1) * 130 + t2] << 16);
        unsigned w1 = (unsigned)tile[(c8 + 2) * 130 + t2] | ((unsigned)tile[(c8 + 3) * 130 + t2] << 16);
        unsigned w2 = (unsigned)tile[(c8 + 4) * 130 + t2] | ((unsigned)tile[(c8 + 5) * 130 + t2] << 16);
        unsigned w3 = (unsigned)tile[(c8 + 6) * 130 + t2] | ((unsigned)tile[(c8 + 7) * 130 + t2] << 16);
        *(uint4*)(YHY + (size_t)(b * L + tt * 128 + t2) * 512 + ct * 64 + c8) = make_uint4(w0, w1, w2, w3); }
      it = itn;
    }
#undef TLOAD
  }
  {
    const int nrows = (l == 0) ? RG : RL;
    const int gw = BID() * 8 + (tid >> 6), NW = gridDim.x * 8, lane = tid & 63;
    u16* OF = (u16*)(ws + OFF_OF); const u16* OB = (const u16*)(ws + OFF_OB); const u16* GR = (const u16*)(ws + OFF_GR);
    const float* gn = p.in[I_GONORM] + l * 128;
    for (int r0 = gw; r0 < nrows; r0 += 2 * NW) {
      const int r1 = (r0 + NW < nrows) ? r0 + NW : r0;
      uint4 A0 = *(const uint4*)(OF + (size_t)r0 * 512 + lane * 8), B0 = *(const uint4*)(OB + (size_t)r0 * 512 + lane * 8), R0 = *(const uint4*)(GR + (size_t)r0 * 512 + lane * 8);
      uint4 A1 = *(const uint4*)(OF + (size_t)r1 * 512 + lane * 8), B1 = *(const uint4*)(OB + (size_t)r1 * 512 + lane * 8), R1 = *(const uint4*)(GR + (size_t)r1 * 512 + lane * 8);
      const int v0 = (lane & 15) * 8;
#pragma unroll
      for (int k = 0; k < 2; ++k) {
        const uint4 a = k ? A1 : A0, bb = k ? B1 : B0, rr = k ? R1 : R0;
        unsigned av[4] = {a.x, a.y, a.z, a.w}, bv[4] = {bb.x, bb.y, bb.z, bb.w}, rv[4] = {rr.x, rr.y, rr.z, rr.w};
        float o[8]; float ss = 0.f;
#pragma unroll
        for (int e = 0; e < 4; ++e) {
          o[2 * e] = bf2f((u16)(av[e] & 0xffff)) + bf2f((u16)(bv[e] & 0xffff));
          o[2 * e + 1] = bf2f((u16)(av[e] >> 16)) + bf2f((u16)(bv[e] >> 16));
          ss += o[2 * e] * o[2 * e] + o[2 * e + 1] * o[2 * e + 1];
        }
        ss += __shfl_xor(ss, 1); ss += __shfl_xor(ss, 2); ss += __shfl_xor(ss, 4); ss += __shfl_xor(ss, 8);
        const float rstd = rsqrtf(ss * (1.f / 128.f) + EPS);
        float y[8];
#pragma unroll
        for (int e = 0; e < 4; ++e) {
          float q0 = bf2f((u16)(rv[e] & 0xffff)), q1 = bf2f((u16)(rv[e] >> 16));
          y[2 * e] = o[2 * e] * rstd * gn[v0 + 2 * e] * (q0 * sigmoidf(q0));
          y[2 * e + 1] = o[2 * e + 1] * rstd * gn[v0 + 2 * e + 1] * (q1 * sigmoidf(q1));
        }
        if (k == 0 || r1 != r0)
          *(uint4*)(OF + (size_t)(k ? r1 : r0) * 512 + lane * 8) = make_uint4(pk2(y[0], y[1]), pk2(y[2], y[3]), pk2(y[4], y[5]), pk2(y[6], y[7]));
      }
    }
  }
}

DEV bool tile_swz8(int i, int MT, int& mt, int& nt) {
  if (gridDim.x != 256) { int t = BID() + i * gridDim.x; mt = t >> 3; nt = t & 7; return t < MT * 8; }
  const int b = BID(), x = b & 7, j = b >> 3, tl = i * 32 + j;
  nt = tl & 7; mt = (tl >> 3) * 8 + x;
  return mt < MT;
}
DEV int tile_swz8_rounds(int MT) { return (gridDim.x != 256) ? (MT * 8 + gridDim.x - 1) / gridDim.x : (((MT + 7) >> 3) * 8 + 31) / 32; }

DEV void phase_merge(const P& p, int l, int g, char* smem) {
  char* ws = WSP(p.ws);
  const int tid = TID(), lane = tid & 63, w = tid >> 6, wr = w >> 1, wc = w & 1, lr = lane & 15, lg = lane >> 4;
  const int MT = (l == 0) ? 68 : 64;
  const u16* GATES = (const u16*)(ws + OFF_GATES);
  u16* M = (u16*)(ws + OFF_HX);
  const int nrounds = tile_swz8_rounds(MT);
  bool first = true;
  for (int it = 0; it < nrounds; ++it) {
    int mt, nt;
    if (!tile_swz8(it, MT, mt, nt)) continue;
    const int m0 = mt * 256, n0 = nt * 128;
    int mt2 = 0, nt2 = 0; bool hn = false;
    for (int i2 = it + 1; i2 < nrounds && !hn; ++i2) hn = tile_swz8(i2, MT, mt2, nt2);
    f32x4 macc[4][4]; zero_acc<4>(macc);
#pragma unroll 1
    for (int br = 0; br < 3; ++br) {
      const u16* Y = (const u16*)(ws + (br == 0 ? OFF_YMLA : (br == 1 ? OFF_OF : OFF_YHY)));
      const u16* W = (const u16*)(ws + (br == 0 ? OFF_WOM : (br == 1 ? OFF_WOG : OFF_WOH)));
      const int nb = (br + 1) % 3;
      const u16* Y2 = (const u16*)(ws + (nb == 0 ? OFF_YMLA : (nb == 1 ? OFF_OF : OFF_YHY)));
      const u16* W2 = (const u16*)(ws + (nb == 0 ? OFF_WOM : (nb == 1 ? OFF_WOG : OFF_WOH)));
      const bool hn2 = (br < 2) || hn;
      const int m2 = (br < 2) ? m0 : mt2 * 256, n2 = (br < 2) ? n0 : nt2 * 128;
      f32x4 acc[4][4]; zero_acc<4>(acc);
      gemm_core<true, 128, true>(acc, Y + (size_t)m0 * 512, 512, W + (size_t)n0 * 512, 512, 512, (u16*)smem, first,
                                 hn2 ? Y2 + (size_t)m2 * 512 : nullptr, 512, W2 + (size_t)n2 * 512, 512);
      first = false;
#pragma unroll
      for (int mi = 0; mi < 4; ++mi) {
        const int r = m0 + wr * 64 + mi * 16 + lr;
#pragma unroll
        for (int np = 0; np < 2; ++np) {
          const uint4 gg = *(const uint4*)(GATES + (size_t)r * 3072 + br * 1024 + n0 + wc * 64 + np * 32 + lg * 8);
          macc[mi][2 * np][0] += acc[mi][2 * np][0] * bf2f((u16)(gg.x & 0xffff));
          macc[mi][2 * np][1] += acc[mi][2 * np][1] * bf2f((u16)(gg.x >> 16));
          macc[mi][2 * np][2] += acc[mi][2 * np][2] * bf2f((u16)(gg.y & 0xffff));
          macc[mi][2 * np][3] += acc[mi][2 * np][3] * bf2f((u16)(gg.y >> 16));
          macc[mi][2 * np + 1][0] += acc[mi][2 * np + 1][0] * bf2f((u16)(gg.z & 0xffff));
          macc[mi][2 * np + 1][1] += acc[mi][2 * np + 1][1] * bf2f((u16)(gg.z >> 16));
          macc[mi][2 * np + 1][2] += acc[mi][2 * np + 1][2] * bf2f((u16)(gg.w & 0xffff));
          macc[mi][2 * np + 1][3] += acc[mi][2 * np + 1][3] * bf2f((u16)(gg.w >> 16));
        }
      }
    }
#pragma unroll
    for (int mi = 0; mi < 4; ++mi) {
      const int r = m0 + wr * 64 + mi * 16 + lr;
#pragma unroll
      for (int np = 0; np < 2; ++np) {
        const uint2 lo = pk4(macc[mi][2 * np]), hi = pk4(macc[mi][2 * np + 1]);
        *(uint4*)(M + (size_t)r * D + n0 + wc * 64 + np * 32 + lg * 8) = make_uint4(lo.x, lo.y, hi.x, hi.y);
      }
    }
  }
}

DEV void xs_ptrs(const P& p, int l, int g, const float*& srcl, const float*& srcc, float*& dstl, float*& dstc, bool first) {
  dstl = p.out + (size_t)g * RL * D;
  dstc = (float*)(p.ws + OFF_CTXS) + (size_t)g * RC * D;
  if (first && l == 0) { srcl = p.in[I_X] + (size_t)g * RL * D; srcc = p.in[I_CTX] + (size_t)g * RC * D; }
  else { srcl = dstl; srcc = dstc; }
}
DEV void phase_resid(const P& p, int l, int g, char* smem, bool isout) {
  char* ws = WSP(p.ws);
  const int tid = TID(), lane = tid & 63, w = tid >> 6, wr = w >> 1, wc = w & 1, lr = lane & 15, lg = lane >> 4;
  const int MT = (l == 0) ? 68 : 64;
  const float *srcl, *srcc; float *dstl, *dstc;
  xs_ptrs(p, l, g, srcl, srcc, dstl, dstc, isout);
  const u16* A = (const u16*)(ws + (isout ? OFF_HX : OFF_H));
  const u16* W = (const u16*)(ws + (isout ? OFF_WOUT : OFF_W2));
  const int K = isout ? 1024 : 4096;
  const float* MOD = (const float*)(ws + OFF_MOD) + (size_t)l * 9 * 6144;
  const int goff = isout ? 2048 : 5120;
  const int nrounds = tile_swz8_rounds(MT);
  bool first = true;
  for (int it = 0; it < nrounds; ++it) {
    int mt, nt;
    if (!tile_swz8(it, MT, mt, nt)) continue;
    const int m0 = mt * 256, n0 = nt * 128;
    int mt2 = 0, nt2 = 0; bool hn = false;
    for (int i2 = it + 1; i2 < nrounds && !hn; ++i2) hn = tile_swz8(i2, MT, mt2, nt2);
    f32x4 acc[4][4]; zero_acc<4>(acc);
    gemm_core<true, 128>(acc, A + (size_t)m0 * K, K, W + (size_t)n0 * K, K, K, (u16*)smem, first,
                         hn ? A + (size_t)mt2 * 256 * K : nullptr, K, W + (size_t)nt2 * 128 * K, K);
    first = false;
    const float* gate = MOD + (size_t)((m0 < RL) ? (g * NB + (m0 >> 12)) : 8) * 6144 + goff + n0 + wc * 64 + lg * 4;
    f32x4 gv[4];
#pragma unroll
    for (int ni = 0; ni < 4; ++ni) gv[ni] = *(const f32x4*)(gate + ni * 16);
    f32x4 xv[4][4];
#pragma unroll
    for (int mi = 0; mi < 4; ++mi) {
      const int r = m0 + wr * 64 + mi * 16 + lr;
      const float* src = (r < RL) ? srcl + (size_t)r * D : srcc + (size_t)(r - RL) * D;
#pragma unroll
      for (int ni = 0; ni < 4; ++ni) xv[mi][ni] = *(const f32x4*)(src + n0 + wc * 64 + ni * 16 + lg * 4);
    }
#pragma unroll
    for (int mi = 0; mi < 4; ++mi) {
      const int r = m0 + wr * 64 + mi * 16 + lr;
      float* dst = (r < RL) ? dstl + (size_t)r * D : dstc + (size_t)(r - RL) * D;
#pragma unroll
      for (int ni = 0; ni < 4; ++ni) {
        f32x4 y;
#pragma unroll
        for (int e = 0; e < 4; ++e) y[e] = xv[mi][ni][e] + gv[ni][e] * acc[mi][ni][e];
        *(f32x4*)(dst + n0 + wc * 64 + ni * 16 + lg * 4) = y;
      }
    }
  }
}
DEV void phase_mlp1(const P& p, int l, int g, char* smem) {
  char* ws = WSP(p.ws);
  const int tid = TID(), lane = tid & 63, w = tid >> 6, wr = w >> 2, wc = w & 3, lr = lane & 15, lg = lane >> 4;
  const int MT = (l == 0) ? 68 : 64, ntiles = MT * 16;
  const u16* A = (const u16*)(ws + OFF_HX); const u16* W = (const u16*)(ws + OFF_W1); u16* H = (u16*)(ws + OFF_H);
  for (int t = BID(); t < ntiles; t += gridDim.x) {
    const int mt = t >> 4, nt = t & 15, m0 = mt * 256, n0 = nt * 256;
    const int t2 = t + gridDim.x; const bool hn = t2 < ntiles;
    f32x4 acc[8][4]; zero_acc<8>(acc);
    gemm_core<true, 256, true>(acc, A + (size_t)m0 * D, D, W + (size_t)n0 * D, D, D, (u16*)smem, t == BID(),
                               hn ? A + (size_t)(t2 >> 4) * 256 * D : nullptr, D, W + (size_t)(t2 & 15) * 256 * D, D);
#pragma unroll
    for (int mi = 0; mi < 8; ++mi) {
      const int r = m0 + wr * 128 + mi * 16 + lr;
#pragma unroll
      for (int np = 0; np < 2; ++np) {
        f32x4 v = acc[mi][2 * np], v2 = acc[mi][2 * np + 1];
#pragma unroll
        for (int e = 0; e < 4; ++e) { float x = fmaxf(v[e], 0.f); v[e] = x * x; float y = fmaxf(v2[e], 0.f); v2[e] = y * y; }
        const uint2 lo = pk4(v), hi = pk4(v2);
        *(uint4*)(H + (size_t)r * DFF + n0 + wc * 64 + np * 32 + lg * 8) = make_uint4(lo.x, lo.y, hi.x, hi.y);
      }
    }
  }
}

DEV void phase_final(const P& p) {
  const int gw = BID() * 8 + (TID() >> 6), NW = gridDim.x * 8, lane = TID() & 63;
  const float* gain = p.in[I_FNG];
  f32x4 gg[4];
#pragma unroll
  for (int j = 0; j < 4; ++j) gg[j] = *(const f32x4*)(gain + j * 256 + lane * 4);
  for (int r = gw; r < 32768; r += 2 * NW) {
    float* s0 = p.out + (size_t)r * D; float* s1 = p.out + (size_t)(r + NW) * D;
    f32x4 a[4], b[4]; float sa = 0.f, sb = 0.f;
#pragma unroll
    for (int j = 0; j < 4; ++j) { a[j] = *(const f32x4*)(s0 + j * 256 + lane * 4); b[j] = *(const f32x4*)(s1 + j * 256 + lane * 4); }
#pragma unroll
    for (int j = 0; j < 4; ++j) {
      sa += a[j][0] * a[j][0] + a[j][1] * a[j][1] + a[j][2] * a[j][2] + a[j][3] * a[j][3];
      sb += b[j][0] * b[j][0] + b[j][1] * b[j][1] + b[j][2] * b[j][2] + b[j][3] * b[j][3];
    }
    const float ra = rsqrtf(wave_sum(sa) * (1.f / D) + EPS), rb = rsqrtf(wave_sum(sb) * (1.f / D) + EPS);
#pragma unroll
    for (int j = 0; j < 4; ++j) {
      f32x4 ya, yb;
#pragma unroll
      for (int e = 0; e < 4; ++e) { ya[e] = a[j][e] * ra * gg[j][e]; yb[e] = b[j][e] * rb * gg[j][e]; }
      *(f32x4*)(s0 + j * 256 + lane * 4) = ya;
      *(f32x4*)(s1 + j * 256 + lane * 4) = yb;
    }
  }
}

#define XB_TMO      128
#define XB_XCNT(j)  (256  + 64 * (j))
#define XB_XSUB(j)  (1280 + 64 * (j))
#define XB_XGEN(j)  (2304 + 64 * (j))
#define XB_TOP      3328
#define XB_TOPGEN   3392
#define XCD_BAR_WORDS 3456
#define XB_SPIN_CAP (1u << 22)
DEV unsigned xb_ld(unsigned* p) { return __hip_atomic_load(p, __ATOMIC_RELAXED, __HIP_MEMORY_SCOPE_AGENT); }
DEV unsigned xb_add(unsigned* p, unsigned v) { return __hip_atomic_fetch_add(p, v, __ATOMIC_RELAXED, __HIP_MEMORY_SCOPE_AGENT); }
DEV unsigned xb_xcc_id() { return (unsigned)__builtin_amdgcn_s_getreg((3 << 11) | 20) & 0xFu; }
#define XB_SPIN(cond, bar) do { unsigned _sp = 0; while (cond) { __builtin_amdgcn_s_sleep(1); \
    if ((++_sp & 255u) == 0u) { if (xb_ld(&(bar)[XB_TMO])) break; if (_sp > XB_SPIN_CAP) { atomicAdd(&(bar)[XB_TMO], 1u); break; } } } } while (0)
struct XcdBarrier { unsigned* bar; unsigned x; volatile LAS unsigned* st; };
DEV XcdBarrier xcd_barrier_post(unsigned* bar, volatile LAS unsigned* st) {
  XcdBarrier b; b.bar = bar; b.x = xb_xcc_id(); b.st = st;
  if (threadIdx.x == 0) (void)xb_add(&bar[XB_XCNT(b.x)], 1u);
  return b;
}
DEV void xcd_barrier_complete(unsigned* bar, unsigned x, unsigned& nloc, unsigned& nx) {
  const unsigned G = gridDim.x * gridDim.y * gridDim.z;
  unsigned sum, cnt, mine, sp = 0u;
  for (;;) {
    sum = 0u; cnt = 0u; mine = 0u;
#pragma unroll
    for (unsigned j = 0; j < 16; ++j) { const unsigned c = xb_ld(&bar[XB_XCNT(j)]); sum += c; cnt += (c > 0u) ? 1u : 0u; mine = (j == x) ? c : mine; }
    if (sum == G) break;
    __builtin_amdgcn_s_sleep(1);
    if ((++sp & 255u) == 0u) { if (xb_ld(&bar[XB_TMO])) break; if (sp > XB_SPIN_CAP) { atomicAdd(&bar[XB_TMO], 1u); break; } }
  }
  nloc = mine > 0u ? mine : 1u; nx = cnt > 0u ? cnt : 1u;
}
DEV void xcd_barrier(const XcdBarrier& b) {
  asm volatile("s_waitcnt vmcnt(0)" ::: "memory");
  __syncthreads();
  if (threadIdx.x == 0) {
    unsigned* bar = b.bar;
    __builtin_amdgcn_s_waitcnt(0);
    unsigned nloc = b.st[0], nx = b.st[1];
    if (nloc == 0u) { xcd_barrier_complete(bar, b.x, nloc, nx); b.st[0] = nloc; b.st[1] = nx; }
    const unsigned old = xb_add(&bar[XB_XSUB(b.x)], 1u);
    const unsigned gen = old / nloc;
    if (old + 1u == (gen + 1u) * nloc) {
      __builtin_amdgcn_fence(__ATOMIC_RELEASE, "agent");
      asm volatile("s_waitcnt vmcnt(0)" ::: "memory");
      const unsigned og = xb_add(&bar[XB_TOP], 1u);
      const unsigned tg = og / nx;
      if (og + 1u == (tg + 1u) * nx) xb_add(&bar[XB_TOPGEN], 1u);
      else XB_SPIN(xb_ld(&bar[XB_TOPGEN]) == tg, bar);
      __builtin_amdgcn_fence(__ATOMIC_ACQUIRE, "agent");
      xb_add(&bar[XB_XGEN(b.x)], 1u);
      asm volatile("s_waitcnt vmcnt(0)" ::: "memory");
    } else {
      XB_SPIN(xb_ld(&bar[XB_XGEN(b.x)]) == gen, bar);
      __builtin_amdgcn_fence(__ATOMIC_ACQUIRE, "agent");
      asm volatile("s_waitcnt vmcnt(0)" ::: "memory");
    }
  }
  __syncthreads();
}

DEV void run_phase(const P& p, int ph, char* smem) {
#if !defined(ONLY_SUB) || ONLY_SUB == 10
  if (ph == 0) { phase_prep(p, 0, smem); return; }
  if (ph == 21) { phase_prep(p, 1, smem); return; }
#endif
#if !defined(ONLY_SUB) || ONLY_SUB == 11
  if (ph == 42) { phase_final(p); return; }
#endif
  const int l = ph > 21 ? 1 : 0;
  const int q = ph - (l ? 22 : 1);
  const int g = q / 10, sub = q % 10;
  const float* MOD = (const float*)(p.ws + OFF_MOD) + (size_t)l * 9 * 6144;
  switch (sub) {
#if !defined(ONLY_SUB) || ONLY_SUB == 0
    case 0: {
      if (g == 0) { fft_build_tw(smem); for (int c = BID(); c < 512; c += gridDim.x) filtfft_task(p, l, c, smem); }
      const float *srcl, *srcc; float *dl, *dc;
      xs_ptrs(p, l, g, srcl, srcc, dl, dc, true);
      norm_rows(srcl, srcc, p.in[I_N1G] + l * D, MOD + (size_t)(g * NB) * 6144, MOD + (size_t)8 * 6144, 0, (u16*)(p.ws + OFF_HX), RG);
    } break;
#endif
#if !defined(ONLY_SUB) || ONLY_SUB == 1
    case 1: phase_win(p, l, g, smem); break;
#endif
#if !defined(ONLY_SUB) || ONLY_SUB == 2
    case 2: phase_up(p, l, g, smem); break;
#endif
#if !defined(ONLY_SUB) || ONLY_SUB == 3
    case 3: phase_mix(p, l, g, smem); break;
#endif
#if !defined(ONLY_SUB) || ONLY_SUB == 4
    case 4: phase_post(p, l, g, smem); break;
#endif
#if !defined(ONLY_SUB) || ONLY_SUB == 5
    case 5: phase_merge(p, l, g, smem); break;
#endif
#if !defined(ONLY_SUB) || ONLY_SUB == 6
    case 6: phase_resid(p, l, g, smem, true); break;
#endif
#if !defined(ONLY_SUB) || ONLY_SUB == 7
    case 7: {
      const float *srcl, *srcc; float *dl, *dc;
      xs_ptrs(p, l, g, srcl, srcc, dl, dc, false);
      norm_rows(srcl, srcc, p.in[I_N2G] + l * D, MOD + (size_t)(g * NB) * 6144, MOD + (size_t)8 * 6144, 3072, (u16*)(p.ws + OFF_HX), (l == 0) ? RG : RL);
    } break;
#endif
#if !defined(ONLY_SUB) || ONLY_SUB == 8
    case 8: phase_mlp1(p, l, g, smem); break;
#endif
#if !defined(ONLY_SUB) || ONLY_SUB == 9
    case 9: phase_resid(p, l, g, smem, false); break;
#endif
  }
}

__global__ void __launch_bounds__(512) mega(P p) {
  __shared__ __attribute__((aligned(16))) char smem[SMEM_BYTES + 32];
  cg::grid_group grid = cg::this_grid();
  if (threadIdx.x == 0) *(uint4*)(smem + SMEM_BYTES) = make_uint4(0u, 0u, 0u, 0u);
  __syncthreads();
  XcdBarrier xb = xcd_barrier_post((unsigned*)(p.ws + OFF_BAR), (volatile LAS unsigned*)(smem + SMEM_BYTES));
  if (p.ph_hi > 1000) grid.sync();
  for (int ph = p.ph_lo; ph < p.ph_hi; ++ph) {
    run_phase(p, ph, smem);
    if (ph + 1 < p.ph_hi) xcd_barrier(xb);
  }
}

extern "C" void kernel_launch(void* const* d_in, const int* in_sizes, int n_in, void* d_out, int out_size, void* d_ws, size_t ws_size,
                              hipStream_t stream) {
  static int grid_blocks = 0;
  if (!grid_blocks) {
    int dev = 0, cus = 0, per_cu = 0;
    hipGetDevice(&dev);
    hipDeviceGetAttribute(&cus, hipDeviceAttributeMultiprocessorCount, dev);
    hipOccupancyMaxActiveBlocksPerMultiprocessor(&per_cu, mega, NTH, 0);
    per_cu = 1;
    grid_blocks = cus * per_cu;
    if (ws_size < WS_NEED) { fprintf(stderr, "workspace too small: %zu < %zu\n", ws_size, (size_t)WS_NEED); grid_blocks = -1; }
  }
  if (grid_blocks < 0 || n_in != 32) return;
  hipMemsetAsync(d_ws, 0, CTRL_BYTES, stream);
  P p{};
  for (int i = 0; i < 32; ++i) p.in[i] = (const float*)d_in[i];
  p.out = (float*)d_out; p.ws = (char*)d_ws;
#if SINGLE_LAUNCH
  p.ph_lo = 0; p.ph_hi = NPHASE;
  void* args[] = {&p};
  hipError_t e = hipLaunchCooperativeKernel((void*)mega, dim3(grid_blocks), dim3(NTH), args, 0, stream);
  if (e != hipSuccess) fprintf(stderr, "cooperative launch failed: %s (grid %d)\n", hipGetErrorString(e), grid_blocks);
#else
  for (int ph = 0; ph < NPHASE; ++ph) {
    p.ph_lo = ph; p.ph_hi = ph + 1;
    hipLaunchKernelGGL(mega, dim3(grid_blocks), dim3(NTH), 0, stream, p);
  }
#endif
}
```
